# Optimizing an MI355X kernel written in HIP

```python
import math
import jax, jax.numpy as jnp
from jax import lax
import numpy as np

D_MODEL = 1024
BATCH = 16
SEQ = 4096
DEPTH = 2

D_PLE = 256
D_FF = 2816
D_CONV = 512
CONV_W = 3
H_M = 4
DQK_M = 128
DV_M = 256
D_MV = H_M * DV_M
CHUNK = 64
H_A = 8
DH_A = 64
H_IDX = 4
D_IDX = 64
TOPK_MAX = 256
Q_BLOCK = 128
EPS = 1e-6

IN_SPLITS = (
    D_CONV, D_CONV, D_CONV,
    H_M * DQK_M, H_M * DQK_M, D_MV, D_MV,
    H_M, H_M,
    H_A * DH_A, DH_A, DH_A,
    H_IDX * D_IDX, D_IDX, H_IDX,
    3 * D_MODEL,
)
N_IN = sum(IN_SPLITS)
IN_OFFSETS = tuple(int(o) for o in np.cumsum(IN_SPLITS)[:-1])

kernel_name = "hybrid_conv_mlstm_dsa_macaron"


def rms_norm(x, g):
    xf = x.astype(jnp.float32)
    y = xf * lax.rsqrt(jnp.mean(xf * xf, axis=-1, keepdims=True) + EPS)
    return (y * g.astype(jnp.float32)).astype(x.dtype)


def swiglu(h, w_gu, w_down):
    g, u = jnp.split(h @ w_gu, 2, axis=-1)
    return (jax.nn.silu(g) * u) @ w_down


def short_conv_mixer(b_gate, c_gate, xc, conv_w, w_out):
    u = c_gate * xc
    S = u.shape[1]
    up = jnp.pad(u, ((0, 0), (CONV_W - 1, 0), (0, 0)))
    y = up[:, 0:S] * conv_w[0]
    for j in range(1, CONV_W):
        y = y + up[:, j:j + S] * conv_w[j]
    return (b_gate * y) @ w_out


def mlstm_chunkwise(q, k, v, i_pre, f_pre):
    B, S, H, dqk = q.shape
    dv = v.shape[-1]
    nc = S // CHUNK
    f32 = jnp.float32
    qf = q.astype(f32)
    kf = k.astype(f32) * (dqk ** -0.5)
    vf = v.astype(f32)
    ig = i_pre.astype(f32)
    lf = jax.nn.log_sigmoid(f_pre.astype(f32))

    def to_chunks(a):
        a = a.reshape((B, nc, CHUNK, H) + a.shape[3:])
        return jnp.moveaxis(a, (1, 3), (0, 2))

    causal = jnp.tril(jnp.ones((CHUNK, CHUNK), dtype=bool))

    def step(carry, inp):
        C, n, m = carry
        qc, kc, vc, ic, lfc = inp
        b = jnp.cumsum(lfc, axis=-1)
        Dlog = jnp.where(causal, b[..., :, None] - b[..., None, :] + ic[..., None, :], -jnp.inf)
        inter = b + m[..., None]
        m_t = jnp.maximum(inter, jnp.max(Dlog, axis=-1))
        sc = jnp.einsum('bhtd,bhsd->bhts', qc, kc) * jnp.exp(Dlog - m_t[..., None])
        w_inter = jnp.exp(inter - m_t)
        num = w_inter[..., None] * jnp.einsum('bhvd,bhtd->bhtv', C, qc) + jnp.einsum('bhts,bhsv->bhtv', sc, vc)
        den = w_inter * jnp.einsum('bhd,bhtd->bht', n, qc) + jnp.sum(sc, axis=-1)
        h = num / jnp.maximum(jnp.abs(den), jnp.exp(-m_t))[..., None]
        bL = b[..., -1]
        g = bL[..., None] - b + ic
        m_new = jnp.maximum(bL + m, jnp.max(g, axis=-1))
        wk = jnp.exp(g - m_new[..., None])
        decay = jnp.exp(bL + m - m_new)
        C_new = decay[..., None, None] * C + jnp.einsum('bhs,bhsv,bhsd->bhvd', wk, vc, kc)
        n_new = decay[..., None] * n + jnp.einsum('bhs,bhsd->bhd', wk, kc)
        return (C_new, n_new, m_new), h

    init = (jnp.zeros((B, H, dv, dqk), f32), jnp.zeros((B, H, dqk), f32), jnp.zeros((B, H), f32))
    _, h = lax.scan(step, init, (to_chunks(qf), to_chunks(kf), to_chunks(vf), to_chunks(ig), to_chunks(lf)))
    h = jnp.moveaxis(h, (0, 2), (1, 3))
    return h.reshape(B, S, H, dv)


def dsa_sparse_attention(q, k, v, q_idx, k_idx, w_idx):
    B, S = q.shape[:2]
    n_sel = min(TOPK_MAX, S // 4)
    nb = S // Q_BLOCK
    f32 = jnp.float32
    kf, vf, kif = k.astype(f32), v.astype(f32), k_idx.astype(f32)
    wf = w_idx.astype(f32) * (H_IDX ** -0.5) * (D_IDX ** -0.5)
    key_pos = jnp.arange(S)
    gather = jax.vmap(lambda a, i: a[i])

    def blocks(a):
        return jnp.moveaxis(a.reshape((B, nb, Q_BLOCK) + a.shape[2:]), 1, 0)

    def attend_block(inp):
        qb, qib, wb, t0 = inp
        qpos = t0 + jnp.arange(Q_BLOCK)
        logits = jnp.einsum('bqhd,bsd->bqhs', qib.astype(f32), kif)
        score = jnp.einsum('bqh,bqhs->bqs', wb, jax.nn.relu(logits))
        visible = key_pos[None, :] <= qpos[:, None]
        score = jnp.where(visible[None], score, -jnp.inf)
        _, idx = lax.top_k(score, n_sel)
        k_sel = gather(kf, idx)
        v_sel = gather(vf, idx)
        s = jnp.einsum('bqhd,bqkd->bqhk', qb.astype(f32), k_sel) * (DH_A ** -0.5)
        valid = idx <= qpos[None, :, None]
        s = jnp.where(valid[:, :, None, :], s, -jnp.inf)
        pr = jax.nn.softmax(s, axis=-1)
        return jnp.einsum('bqhk,bqkd->bqhd', pr, v_sel)

    out = lax.map(attend_block, (blocks(q), blocks(q_idx), blocks(wf), jnp.arange(nb) * Q_BLOCK))
    return jnp.moveaxis(out, 0, 1).reshape(B, S, H_A * DH_A)


def hybrid_mixer(h, w_in, conv_w, conv_w_out, mlstm_b_i, mlstm_b_f, mlstm_norm, mlstm_w_out, attn_w_out, w_o):
    B, S, _ = h.shape
    proj = h @ w_in
    (cb, cc, cx, mq, mk, mv, mo, mi, mf, aq, ak, av, iq, ik, iw, gates) = jnp.split(proj, IN_OFFSETS, axis=-1)
    y_a = short_conv_mixer(cb, cc, cx, conv_w, conv_w_out)
    hm = mlstm_chunkwise(mq.reshape(B, S, H_M, DQK_M), mk.reshape(B, S, H_M, DQK_M),
                         mv.reshape(B, S, H_M, DV_M), mi + mlstm_b_i, mf + mlstm_b_f)
    hm = hm * lax.rsqrt(jnp.mean(hm * hm, axis=-1, keepdims=True) + EPS)
    hm = hm.reshape(B, S, D_MV) * mlstm_norm.astype(jnp.float32)
    y_m = (jax.nn.sigmoid(mo) * hm.astype(h.dtype)) @ mlstm_w_out
    ha = dsa_sparse_attention(aq.reshape(B, S, H_A, DH_A), ak, av,
                              iq.reshape(B, S, H_IDX, D_IDX), ik, iw)
    y_c = ha.astype(h.dtype) @ attn_w_out
    g = jax.nn.sigmoid(gates).reshape(B, S, 3, D_MODEL)
    merged = g[:, :, 0] * y_a + g[:, :, 1] * y_m + g[:, :, 2] * y_c
    return merged @ w_o


def setup_inputs(seed: int = 0) -> dict:
    key = jax.random.key(seed)
    ks = iter(jax.random.split(key, 32))
    f32 = jnp.float32

    def nrm(shape, fan_in):
        return jax.random.normal(next(ks), shape, f32) * (fan_in ** -0.5)

    def gain(shape):
        return 1.0 + 0.02 * jax.random.normal(next(ks), shape, f32)

    return {
        "x": jax.random.normal(next(ks), (BATCH, SEQ, D_MODEL), f32),
        "p": jax.random.normal(next(ks), (DEPTH, BATCH, SEQ, D_PLE), f32),
        "norm_ffn1": gain((DEPTH, D_MODEL)),
        "ffn1_w_gu": nrm((DEPTH, D_MODEL, 2 * D_FF), D_MODEL),
        "ffn1_w_down": nrm((DEPTH, D_FF, D_MODEL), D_FF),
        "norm_mix": gain((DEPTH, D_MODEL)),
        "w_in": nrm((DEPTH, D_MODEL, N_IN), D_MODEL),
        "conv_w": nrm((DEPTH, CONV_W, D_CONV), CONV_W),
        "conv_w_out": nrm((DEPTH, D_CONV, D_MODEL), D_CONV),
        "mlstm_b_i": 0.1 * jax.random.normal(next(ks), (DEPTH, H_M), f32),
        "mlstm_b_f": jnp.linspace(3.0, 6.0, H_M, dtype=f32)[None, :] + 0.1 * jax.random.normal(next(ks), (DEPTH, H_M), f32),
        "mlstm_norm": gain((DEPTH, D_MV)),
        "mlstm_w_out": nrm((DEPTH, D_MV, D_MODEL), D_MV),
        "attn_w_out": nrm((DEPTH, H_A * DH_A, D_MODEL), H_A * DH_A),
        "w_o": nrm((DEPTH, D_MODEL, D_MODEL), D_MODEL),
        "norm_ffn2": gain((DEPTH, D_MODEL)),
        "ffn2_w_gu": nrm((DEPTH, D_MODEL, 2 * D_FF), D_MODEL),
        "ffn2_w_down": nrm((DEPTH, D_FF, D_MODEL), D_FF),
        "norm_ple": gain((DEPTH, D_MODEL)),
        "ple_w_gate": nrm((DEPTH, D_MODEL, D_MODEL), D_MODEL),
        "ple_w_proj": nrm((DEPTH, D_PLE, D_MODEL), D_PLE),
        "final_norm": gain((D_MODEL,)),
    }


def reference(x, p, norm_ffn1, ffn1_w_gu, ffn1_w_down, norm_mix, w_in, conv_w, conv_w_out,
              mlstm_b_i, mlstm_b_f, mlstm_norm, mlstm_w_out, attn_w_out, w_o,
              norm_ffn2, ffn2_w_gu, ffn2_w_down, norm_ple, ple_w_gate, ple_w_proj, final_norm):
    for l in range(DEPTH):
        x = x + 0.5 * swiglu(rms_norm(x, norm_ffn1[l]), ffn1_w_gu[l], ffn1_w_down[l])
        x = x + hybrid_mixer(rms_norm(x, norm_mix[l]), w_in[l], conv_w[l], conv_w_out[l],
                             mlstm_b_i[l], mlstm_b_f[l], mlstm_norm[l], mlstm_w_out[l],
                             attn_w_out[l], w_o[l])
        x = x + 0.5 * swiglu(rms_norm(x, norm_ffn2[l]), ffn2_w_gu[l], ffn2_w_down[l])
        gate = jax.nn.sigmoid(rms_norm(x, norm_ple[l]) @ ple_w_gate[l])
        x = x + gate * (p[l] @ ple_w_proj[l])
    return rms_norm(x, final_norm)
```

```cpp
#include <hip/hip_runtime.h>
#include <cstdio>
#include <cstdint>

#ifndef MK_N_LAUNCHES
#define MK_N_LAUNCHES 1
#endif

constexpr int BATCH = 16, SEQ = 4096, DM = 1024, DEPTH = 2, DPLE = 256, DFF = 2816, DCONV = 512;
constexpr int MTOK = BATCH * SEQ;
constexpr int NGRP = 2, GB = BATCH / NGRP, MG = GB * SEQ;
constexpr int LDP = 8704;
constexpr int O_CC = 0, O_CX = 512, O_MQ = 1024, O_MK = 1536, O_MV = 2048, O_CB = 3072, O_MO = 3584, O_AQ = 4608, O_G = 5120, O_AK = 8192, O_AV = 8256,
              O_IQ = 8320, O_IK = 8576, O_MI = 8640, O_MF = 8644, O_IW = 8648;
constexpr int LDS_ = 512, O_SIDE = 8192;
constexpr float EPS = 1e-6f;

constexpr size_t W_GU1 = 0, W_DN1 = W_GU1 + (size_t)5632 * 1024, W_IN = W_DN1 + (size_t)1024 * 2816, W_MRG = W_IN + (size_t)LDP * 1024,
                 W_O = W_MRG + (size_t)1024 * 2048, W_GU2 = W_O + (size_t)1024 * 1024,
                 W_DN2 = W_GU2 + (size_t)5632 * 1024, W_PG = W_DN2 + (size_t)1024 * 2816, W_PP = W_PG + (size_t)1024 * 1024, W_END = W_PP + (size_t)1024 * 256;

constexpr size_t MiB = 1u << 20;
constexpr size_t WS_CTL = 0, CTL_ZERO_BYTES = 64 * 1024;
constexpr size_t WS_W = 1 * MiB;
constexpr size_t WS_XB = 65 * MiB;
constexpr size_t WS_SS0 = 193 * MiB, WS_SS1 = 194 * MiB;
constexpr size_t WS_SCR = 198 * MiB;
constexpr size_t WS_BIG = 206 * MiB;
constexpr size_t WS_PROJ = WS_BIG;
constexpr size_t WS_GCAT = WS_BIG + 544 * MiB;
constexpr size_t WS_SIDE = WS_GCAT + 64 * MiB;
constexpr size_t WS_HID = WS_BIG;
constexpr size_t WS_PB = WS_BIG + 640 * MiB;
constexpr size_t WS_PP = WS_BIG + 384 * MiB;
constexpr size_t WS_KC = WS_BIG + 672 * MiB;
constexpr size_t WS_KCL = WS_BIG + 736 * MiB;
constexpr size_t WS_END = WS_BIG + 800 * MiB;
static_assert(W_END * 2 <= 64 * MiB, "weights fit");
constexpr int CW_BAR = 4096;
constexpr int CW_Q = 8192;

constexpr int RING_BYTES = 131072, LDSCTL_OFF = RING_BYTES, MISC_OFF = LDSCTL_OFF + 320, LDS_BYTES = 147456;
constexpr int NWAVES = 8, NTHR = 512;

#define GAS __attribute__((address_space(1)))
#define LAS __attribute__((address_space(3)))
typedef unsigned short bf16_t;
typedef short bf16x8 __attribute__((ext_vector_type(8)));
typedef short bf16x4 __attribute__((ext_vector_type(4)));
typedef float f32x4 __attribute__((ext_vector_type(4)));
typedef float f32x16 __attribute__((ext_vector_type(16)));
typedef unsigned u32x4 __attribute__((ext_vector_type(4)));
typedef unsigned u32x2 __attribute__((ext_vector_type(2)));
typedef __bf16 bf2_t __attribute__((ext_vector_type(2)));

__device__ __forceinline__ unsigned pk2(float lo, float hi) { bf2_t v = {(__bf16)lo, (__bf16)hi}; return __builtin_bit_cast(unsigned, v); }
__device__ __forceinline__ bf16_t f2bf(float x) { __bf16 v = (__bf16)x; return __builtin_bit_cast(bf16_t, v); }
__device__ __forceinline__ float bf2f(bf16_t b) { return __uint_as_float(((unsigned)b) << 16); }
__device__ __forceinline__ float bflo(unsigned w) { return __uint_as_float(w << 16); }
__device__ __forceinline__ float bfhi(unsigned w) { return __uint_as_float(w & 0xffff0000u); }
__device__ __forceinline__ float fsigmoid(float x) { return __builtin_amdgcn_rcpf(1.0f + __expf(-x)); }
__device__ __forceinline__ float rstd_from(const f32x4 p) { return __builtin_amdgcn_rsqf(((p[0] + p[1]) + (p[2] + p[3])) * (1.0f / DM) + EPS); }
__device__ __forceinline__ void rstd8(const float* ss, int row0, float mul, float (&rs)[8]) {
    f32x4 t[8];
#pragma unroll
    for (int i = 0; i < 8; ++i) t[i] = *(const f32x4*)(ss + (size_t)(row0 + (i >> 2) * 128 + (i & 3) * 16) * 4);
    asm volatile("" : "+v"(t[0]), "+v"(t[1]), "+v"(t[2]), "+v"(t[3]), "+v"(t[4]), "+v"(t[5]), "+v"(t[6]), "+v"(t[7]));
#pragma unroll
    for (int i = 0; i < 8; ++i) rs[i] = rstd_from(t[i]) * mul;
}
__device__ __forceinline__ float rstd_of(const float* ss4) { const f32x4 p = *(const f32x4*)ss4; return 1.0f / sqrtf(((p[0] + p[1]) + (p[2] + p[3])) * (1.0f / DM) + EPS); }
constexpr int LDS_SSQ = RING_BYTES + 1024;
__device__ __forceinline__ float wave_sum(float v) {
#pragma unroll
    for (int o = 1; o < 64; o <<= 1) v += __shfl_xor(v, o);
    return v;
}

namespace pg8 {
#ifndef PG8_ALIGN
#define PG8_ALIGN 1
#endif
constexpr bool ALIGN_EPI = PG8_ALIGN;
constexpr int BM = 256, BK = 64, HALF = 128, HTB = HALF * BK * 2, STAGE_BYTES = 8 * HTB, NXCD = 8, WGM = 8;
__host__ __device__ __forceinline__ int lds_byte(int r, int c) { const int st = (r >> 4) * 2 + (c >> 5), rr = r & 15, cc = c & 31, ob = rr * 64 + cc * 2; return st * 1024 + (ob ^ (((ob >> 9) & 1) << 5)); }
__host__ __device__ __forceinline__ void stage_rc(int b, int& R, int& C) { const int st = b / 1024, sb = b % 1024, swz = sb ^ (((sb >> 9) & 1) << 5); R = (st >> 1) * 16 + swz / 64; C = (st & 1) * 32 + (swz % 64) / 2; }
__host__ __device__ __forceinline__ int perm32(int rho) { const int n = rho >> 4, i = rho & 15; return 8 * (i >> 2) + 4 * n + (i & 3); }
struct Unit { int pm, pn; };
struct Gemm { const bf16_t* A; const bf16_t* Bt; int lda, M, N, K; };
struct StaticOrder {
    int nM, nN, nwg, G, c;
    __host__ __device__ void init(int M, int N, int G_, int c_) { nM = M / BM; nN = N / BM; nwg = nM * nN; G = G_; c = c_; }
    __host__ __device__ bool next(int i, Unit& u) const {
        const long L = (long)i * G + c; if (L >= nwg) return false;
        int wgid = (int)L; { const int q = nwg / NXCD, r = nwg % NXCD, xcd = wgid % NXCD, off = wgid / NXCD; wgid = (xcd < r ? xcd * (q + 1) : r * (q + 1) + (xcd - r) * q) + off; }
        const int nig = WGM * nN, gid = wgid / nig, fm = gid * WGM, gsz = (nM - fm) < WGM ? (nM - fm) : WGM;
        u.pm = fm + ((wgid % nig) % gsz); u.pn = (wgid % nig) / gsz; return true;
    }
};
typedef f32x4 Acc[2][2][4][2];

struct EpiSwiglu {
    bf16_t* H; const float* ss;
    __device__ __forceinline__ void operator()(const Acc& acc, const Unit& u, int wr, int wc, int fr, int fq) const {
        const int row0 = u.pm * BM + wr * 64 + fr, col0 = u.pn * 128 + wc * 32 + 8 * fq;
        float rs[8]; rstd8(ss, row0, 1.0f, rs);
#pragma unroll
        for (int ai = 0; ai < 2; ++ai)
#pragma unroll
            for (int m = 0; m < 4; ++m) { const int row = row0 + ai * HALF + m * 16; const float r = rs[ai * 4 + m];
                float h[8];
#pragma unroll
                for (int n = 0; n < 2; ++n)
#pragma unroll
                    for (int j = 0; j < 4; ++j) { const float g = acc[ai][0][m][n][j] * r, uu = acc[ai][1][m][n][j] * r; h[n * 4 + j] = g * fsigmoid(g) * uu; }
                u32x4 w; w.x = pk2(h[0], h[1]); w.y = pk2(h[2], h[3]); w.z = pk2(h[4], h[5]); w.w = pk2(h[6], h[7]);
                *(u32x4*)(H + (size_t)row * DFF + col0) = w; }
    }
};
struct EpiResid {
    const float* Xin; float* X; bf16_t* XB; float scale; float* SS; LAS float* lq;
    __device__ __forceinline__ void operator()(const Acc& acc, const Unit& u, int wr, int wc, int fr, int fq) const {
        const int row0 = u.pm * BM + wr * 64 + fr, col0 = u.pn * BM + wc * 32 + 8 * fq;
#pragma unroll
        for (int ai = 0; ai < 2; ++ai)
#pragma unroll
            for (int m = 0; m < 4; ++m) { const int row = row0 + ai * HALF + m * 16; const size_t off = (size_t)row * DM + col0; float sq = 0.f;
#pragma unroll
                for (int bj = 0; bj < 2; ++bj) { float* xp = X + off + bj * HALF; const float* xi = Xin + off + bj * HALF;
                    f32x4 a = *(const f32x4*)xi, b = *(const f32x4*)(xi + 4);
                    a = a + acc[ai][bj][m][0] * scale; b = b + acc[ai][bj][m][1] * scale;
                    *(f32x4*)xp = a; *(f32x4*)(xp + 4) = b;
                    sq += (a[0] * a[0] + a[1] * a[1]) + (a[2] * a[2] + a[3] * a[3]) + (b[0] * b[0] + b[1] * b[1]) + (b[2] * b[2] + b[3] * b[3]);
                    u32x4 w; w.x = pk2(a[0], a[1]); w.y = pk2(a[2], a[3]); w.z = pk2(b[0], b[1]); w.w = pk2(b[2], b[3]);
                    *(u32x4*)(XB + off + bj * HALF) = w; }
                sq += __shfl_xor(sq, 16); sq += __shfl_xor(sq, 32);
                if (fq == 0) lq[wc * 256 + (ai * HALF + wr * 64 + m * 16 + fr)] = sq;
                asm volatile("" ::: "memory"); }
        asm volatile("s_waitcnt lgkmcnt(0)" ::: "memory"); __builtin_amdgcn_s_barrier(); asm volatile("" ::: "memory");
        if (wr == 0) { const int rr = wc * 64 + fq * 16 + fr;
            SS[(size_t)(u.pm * BM + rr) * 4 + u.pn] = (lq[rr] + lq[256 + rr]) + (lq[512 + rr] + lq[768 + rr]); }
    }
};
struct EpiBf16 {
    bf16_t* O; int ldc; const float* rs;
    __device__ __forceinline__ void operator()(const Acc& acc, const Unit& u, int wr, int wc, int fr, int fq) const {
        const int row0 = u.pm * BM + wr * 64 + fr, col0 = u.pn * BM + wc * 32 + 8 * fq;
#pragma unroll
        for (int ai = 0; ai < 2; ++ai)
#pragma unroll
            for (int m = 0; m < 4; ++m) { const int row = row0 + ai * HALF + m * 16; const float r = rs ? rs[row] : 1.0f;
#pragma unroll
                for (int bj = 0; bj < 2; ++bj) { const f32x4 a = acc[ai][bj][m][0] * r, b = acc[ai][bj][m][1] * r;
                    u32x4 w; w.x = pk2(a[0], a[1]); w.y = pk2(a[2], a[3]); w.z = pk2(b[0], b[1]); w.w = pk2(b[2], b[3]);
                    *(u32x4*)(O + (size_t)row * ldc + col0 + bj * HALF) = w; } }
    }
};
constexpr float AQ_SCALE = 0.125f * 1.4426950408889634f;
struct EpiProj {
    bf16_t* O; const float* ss; bf16_t* SIDE;
    __device__ __forceinline__ void operator()(const Acc& acc, const Unit& u, int wr, int wc, int fr, int fq) const {
        const int row0 = u.pm * BM + wr * 64 + fr; int col0 = u.pn * BM + wc * 32 + 8 * fq;
        const bool sg = (u.pn >= O_G / BM) && (u.pn < O_AK / BM);
        const float qs = (u.pn >= O_AQ / BM && u.pn < O_G / BM) ? AQ_SCALE : 1.0f;
        bf16_t* base = O; int ldc = LDP;
        if (u.pn >= O_SIDE / BM) { base = SIDE; ldc = LDS_; col0 -= O_SIDE; }
        float rs[8]; rstd8(ss, row0, qs, rs);
#pragma unroll
        for (int ai = 0; ai < 2; ++ai)
#pragma unroll
            for (int m = 0; m < 4; ++m) { const int row = row0 + ai * HALF + m * 16; const float r = rs[ai * 4 + m];
#pragma unroll
                for (int bj = 0; bj < 2; ++bj) { f32x4 a = acc[ai][bj][m][0] * r, b = acc[ai][bj][m][1] * r;
                    if (sg) {
#pragma unroll
                        for (int j = 0; j < 4; ++j) { a[j] = fmaxf(fsigmoid(a[j]), 1e-10f); b[j] = fmaxf(fsigmoid(b[j]), 1e-10f); } }
                    u32x4 w; w.x = pk2(a[0], a[1]); w.y = pk2(a[2], a[3]); w.z = pk2(b[0], b[1]); w.w = pk2(b[2], b[3]);
                    *(u32x4*)(base + (size_t)row * ldc + col0 + bj * HALF) = w; } }
    }
};
struct MergeHook {
    static constexpr bool ON = true;
    const bf16_t* S;
    __device__ __forceinline__ void operator()(Acc& acc, const Unit& u, int t, int wr, int wc, int fr, int fq) const {
        if (t != 8 && t != 24) return;
        int row0 = u.pm * BM + wr * 64 + fr, col0 = u.pn * BM + wc * 32 + 8 * fq + ((t == 8) ? 0 : DM);
        asm volatile("" : "+v"(row0), "+v"(col0));
#pragma unroll
        for (int ai = 0; ai < 2; ++ai) {
            u32x4 nv[4][2], dv[4][2];
#pragma unroll
            for (int m = 0; m < 4; ++m)
#pragma unroll
                for (int bj = 0; bj < 2; ++bj) { const bf16_t* gp = S + (size_t)(row0 + ai * HALF + m * 16) * LDP + col0 + bj * HALF; nv[m][bj] = *(const u32x4*)gp; dv[m][bj] = *(const u32x4*)(gp + DM); }
            asm volatile("" : "+v"(nv[0][0]), "+v"(nv[0][1]), "+v"(nv[1][0]), "+v"(nv[1][1]), "+v"(nv[2][0]), "+v"(nv[2][1]), "+v"(nv[3][0]), "+v"(nv[3][1]),
                              "+v"(dv[0][0]), "+v"(dv[0][1]), "+v"(dv[1][0]), "+v"(dv[1][1]), "+v"(dv[2][0]), "+v"(dv[2][1]), "+v"(dv[3][0]), "+v"(dv[3][1]));
#pragma unroll
            for (int m = 0; m < 4; ++m)
#pragma unroll
                for (int bj = 0; bj < 2; ++bj) { const u32x4 n = nv[m][bj], d = dv[m][bj];
                    f32x4 ra, rb;
                    ra[0] = bflo(n.x) * __builtin_amdgcn_rcpf(bflo(d.x)); ra[1] = bfhi(n.x) * __builtin_amdgcn_rcpf(bfhi(d.x)); ra[2] = bflo(n.y) * __builtin_amdgcn_rcpf(bflo(d.y)); ra[3] = bfhi(n.y) * __builtin_amdgcn_rcpf(bfhi(d.y));
                    rb[0] = bflo(n.z) * __builtin_amdgcn_rcpf(bflo(d.z)); rb[1] = bfhi(n.z) * __builtin_amdgcn_rcpf(bfhi(d.z)); rb[2] = bflo(n.w) * __builtin_amdgcn_rcpf(bflo(d.w)); rb[3] = bfhi(n.w) * __builtin_amdgcn_rcpf(bfhi(d.w));
                    acc[ai][bj][m][0] *= ra; acc[ai][bj][m][1] *= rb; }
            asm volatile("" ::: "memory"); }
    }
};
struct NoHook { static constexpr bool ON = false; __device__ __forceinline__ void operator()(Acc&, const Unit&, int, int, int, int, int) const {} };
struct EpiMerge {
    bf16_t* O; const bf16_t* S2;
    __device__ __forceinline__ void operator()(const Acc& acc, const Unit& u, int wr, int wc, int fr, int fq) const {
        const int row0 = u.pm * BM + wr * 64 + fr, col0 = u.pn * BM + wc * 32 + 8 * fq;
#pragma unroll
        for (int ai = 0; ai < 2; ++ai)
#pragma unroll
            for (int m = 0; m < 4; ++m) { const int row = row0 + ai * HALF + m * 16;
#pragma unroll
                for (int bj = 0; bj < 2; ++bj) { const u32x4 g = *(const u32x4*)(S2 + (size_t)row * LDP + col0 + bj * HALF);
                    const f32x4 a = acc[ai][bj][m][0], b = acc[ai][bj][m][1];
                    u32x4 w;
                    w.x = pk2(a[0] * bflo(g.x), a[1] * bfhi(g.x)); w.y = pk2(a[2] * bflo(g.y), a[3] * bfhi(g.y));
                    w.z = pk2(b[0] * bflo(g.z), b[1] * bfhi(g.z)); w.w = pk2(b[2] * bflo(g.w), b[3] * bfhi(g.w));
                    *(u32x4*)(O + (size_t)row * DM + col0 + bj * HALF) = w; }
                asm volatile("" ::: "memory"); }
    }
};
struct EpiPle {
    float* X; bf16_t* XB; const bf16_t* PP; const float* ss; float* SSout; LAS float* lq; int wxb;
    __device__ __forceinline__ void operator()(const Acc& acc, const Unit& u, int wr, int wc, int fr, int fq) const {
        const int row0 = u.pm * BM + wr * 64 + fr, col0 = u.pn * BM + wc * 32 + 8 * fq;
#pragma unroll
        for (int ai = 0; ai < 2; ++ai)
#pragma unroll
            for (int m = 0; m < 4; ++m) { const int row = row0 + ai * HALF + m * 16; const float r = rstd_of(ss + (size_t)row * 4); const size_t off = (size_t)row * DM + col0; float sq = 0.f;
#pragma unroll
                for (int bj = 0; bj < 2; ++bj) { float* xp = X + off + bj * HALF;
                    f32x4 a = *(const f32x4*)xp, b = *(const f32x4*)(xp + 4); const u32x4 p = *(const u32x4*)(PP + off + bj * HALF);
                    const f32x4 ga = acc[ai][bj][m][0] * r, gb = acc[ai][bj][m][1] * r;
                    a[0] += fsigmoid(ga[0]) * bflo(p.x); a[1] += fsigmoid(ga[1]) * bfhi(p.x); a[2] += fsigmoid(ga[2]) * bflo(p.y); a[3] += fsigmoid(ga[3]) * bfhi(p.y);
                    b[0] += fsigmoid(gb[0]) * bflo(p.z); b[1] += fsigmoid(gb[1]) * bfhi(p.z); b[2] += fsigmoid(gb[2]) * bflo(p.w); b[3] += fsigmoid(gb[3]) * bfhi(p.w);
                    *(f32x4*)xp = a; *(f32x4*)(xp + 4) = b;
                    sq += (a[0] * a[0] + a[1] * a[1]) + (a[2] * a[2] + a[3] * a[3]) + (b[0] * b[0] + b[1] * b[1]) + (b[2] * b[2] + b[3] * b[3]);
                    u32x4 w; w.x = pk2(a[0], a[1]); w.y = pk2(a[2], a[3]); w.z = pk2(b[0], b[1]); w.w = pk2(b[2], b[3]);
                    if (wxb) *(u32x4*)(XB + off + bj * HALF) = w; }
                sq += __shfl_xor(sq, 16); sq += __shfl_xor(sq, 32);
                if (fq == 0) lq[wc * 256 + (ai * HALF + wr * 64 + m * 16 + fr)] = sq;
                asm volatile("" ::: "memory"); }
        asm volatile("s_waitcnt lgkmcnt(0)" ::: "memory"); __builtin_amdgcn_s_barrier(); asm volatile("" ::: "memory");
        if (wr == 0) { const int rr = wc * 64 + fq * 16 + fr;
            SSout[(size_t)(u.pm * BM + rr) * 4 + u.pn] = (lq[rr] + lq[256 + rr]) + (lq[512 + rr] + lq[768 + rr]); }
    }
};

template <class Epi, class Hook = NoHook>
__device__ __forceinline__ void gemm_phase(LAS unsigned char* lds, const Gemm g, const StaticOrder& S, const Epi& E, const Hook H = Hook()) {
    int tid = threadIdx.x; asm volatile("" : "+v"(tid));
    const int wid = __builtin_amdgcn_readfirstlane(tid >> 6), lane = tid & 63, wr = wid >> 2, wc = wid & 3, fr = lane & 15, fq = lane >> 4;
    const int K = g.K, nt = K / BK, lda = g.lda;
    unsigned voffA[2], voffB[2];
#pragma unroll
    for (int i = 0; i < 2; ++i) { int R, C; stage_rc(tid * 16 + i * 8192, R, C); const int Rb = (R & ~31) + perm32(R & 31);
        voffA[i] = (unsigned)(R * lda + C) * 2u; voffB[i] = (unsigned)(Rb * K + C) * 2u; }
    const size_t kstep = (size_t)(BK * 2);
    const size_t hstepA = (size_t)HALF * lda * 2, tstepA = 2 * hstepA;
    const size_t hstepB = (size_t)HALF * K * 2, tstepB = 2 * hstepB;
    const unsigned ldsw = (unsigned)wid * 1024u;
    const int aoff = lds_byte(wr * 64 + fr, fq * 8), boff = lds_byte(wc * 32 + fr, fq * 8);
#define PG8_SA(b, h) (((b) * 2 + (h)) * HTB)
#define PG8_SB(b, h) ((4 + (b) * 2 + (h)) * HTB)
#define PG8_STAGE(bufoff, gbase, voff) do { _Pragma("unroll") for (int _i = 0; _i < 2; ++_i) \
        __builtin_amdgcn_global_load_lds((const unsigned*)((const char*)(gbase) + (voff)[_i]), (LAS unsigned*)(lds + (bufoff) + ldsw + _i * 8192), 16, 0, 0); } while (0)
#define PG8_LDA(dst, b, h) do { _Pragma("unroll") for (int m = 0; m < 4; ++m) _Pragma("unroll") for (int k = 0; k < 2; ++k) dst[m][k] = *(const LAS bf16x8*)(lds + PG8_SA(b, h) + aoff + m * 2048 + k * 1024); } while (0)
#define PG8_LDB(dst, b, h) do { _Pragma("unroll") for (int n = 0; n < 2; ++n) _Pragma("unroll") for (int k = 0; k < 2; ++k) dst[n][k] = *(const LAS bf16x8*)(lds + PG8_SB(b, h) + boff + n * 2048 + k * 1024); } while (0)
#define PG8_MMA(ai, bj, At, Bt) do { __builtin_amdgcn_s_setprio(1); _Pragma("unroll") for (int m = 0; m < 4; ++m) _Pragma("unroll") for (int n = 0; n < 2; ++n) _Pragma("unroll") for (int k = 0; k < 2; ++k) \
        acc[ai][bj][m][n] = __builtin_amdgcn_mfma_f32_16x16x32_bf16(Bt[n][k], At[m][k], acc[ai][bj][m][n], 0, 0, 0); __builtin_amdgcn_s_setprio(0); } while (0)
#define PG8_WAIT_V(n) asm volatile("s_waitcnt vmcnt(" #n ")" ::: "memory")
#define PG8_WAIT_L(n) asm volatile("s_waitcnt lgkmcnt(" #n ")" ::: "memory")
#define PG8_BAR __builtin_amdgcn_s_barrier()
#define PG8_SCHED __builtin_amdgcn_sched_barrier(0)
    Unit cur, nxt; int ui = 0;
    if (!S.next(0, cur)) return;
    Acc acc;
#pragma unroll
    for (int a = 0; a < 2; ++a)
#pragma unroll
        for (int b = 0; b < 2; ++b)
#pragma unroll
            for (int m = 0; m < 4; ++m)
#pragma unroll
                for (int n = 0; n < 2; ++n) acc[a][b][m][n] = (f32x4){0.f, 0.f, 0.f, 0.f};
    bf16x8 At[4][2], B0[2][2], B1[2][2];
    const char* cA = (const char*)g.A + (size_t)cur.pm * tstepA; const char* cB = (const char*)g.Bt + (size_t)cur.pn * tstepB;
    PG8_STAGE(PG8_SB(0, 0), cB, voffB); PG8_STAGE(PG8_SB(0, 1), cB + hstepB, voffB); PG8_STAGE(PG8_SA(0, 0), cA, voffA); PG8_STAGE(PG8_SA(0, 1), cA + hstepA, voffA);
    if (wr == 1) PG8_BAR;
    PG8_WAIT_V(2); PG8_BAR;
    PG8_STAGE(PG8_SB(1, 0), cB + kstep, voffB); PG8_STAGE(PG8_SA(1, 0), cA + kstep, voffA); PG8_STAGE(PG8_SB(1, 1), cB + hstepB + kstep, voffB);
    PG8_WAIT_V(6); PG8_BAR;
    for (;;) {
        const bool has_next = S.next(ui + 1, nxt);
        const char* nA = has_next ? (const char*)g.A + (size_t)nxt.pm * tstepA : cA; const char* nB = has_next ? (const char*)g.Bt + (size_t)nxt.pn * tstepB : cB;
#pragma unroll 1
        for (int t = 0; t < nt; t += 2) {
            const bool last = (t == nt - 2);
            const char* a1 = cA + (size_t)(t + 1) * kstep;
            const char* a2 = last ? nA : cA + (size_t)(t + 2) * kstep; const char* b2 = last ? nB : cB + (size_t)(t + 2) * kstep;
            const char* a3 = a2 + kstep; const char* b3 = b2 + kstep;
            if constexpr (Hook::ON) H(acc, cur, t, wr, wc, fr, fq);
            PG8_LDB(B0, 0, 0); PG8_LDB(B1, 0, 1); PG8_SCHED; PG8_LDA(At, 0, 0); PG8_STAGE(PG8_SA(1, 1), a1 + hstepA, voffA);
            PG8_WAIT_V(8); PG8_WAIT_L(0); PG8_BAR; PG8_MMA(0, 0, At, B0); PG8_MMA(0, 1, At, B1); PG8_BAR; PG8_SCHED;
            PG8_LDA(At, 0, 1); PG8_STAGE(PG8_SB(0, 0), b2, voffB); PG8_STAGE(PG8_SB(0, 1), b2 + hstepB, voffB); PG8_STAGE(PG8_SA(0, 0), a2, voffA);
            PG8_WAIT_V(8); PG8_WAIT_L(0); PG8_BAR; PG8_MMA(1, 0, At, B0); PG8_MMA(1, 1, At, B1); PG8_BAR; PG8_SCHED;
            PG8_LDB(B0, 1, 0); PG8_LDB(B1, 1, 1); PG8_SCHED; PG8_LDA(At, 1, 0); PG8_STAGE(PG8_SA(0, 1), a2 + hstepA, voffA);
            PG8_WAIT_V(8); PG8_WAIT_L(0); PG8_BAR; PG8_MMA(0, 0, At, B0); PG8_MMA(0, 1, At, B1); PG8_BAR; PG8_SCHED;
            PG8_LDA(At, 1, 1); PG8_STAGE(PG8_SB(1, 0), b3, voffB); PG8_STAGE(PG8_SB(1, 1), b3 + hstepB, voffB); PG8_STAGE(PG8_SA(1, 0), a3, voffA);
            PG8_WAIT_V(8); PG8_WAIT_L(0); PG8_BAR; PG8_MMA(1, 0, At, B0); PG8_MMA(1, 1, At, B1); PG8_BAR; PG8_SCHED;
        }
        if (ALIGN_EPI) { if (wr == 0) PG8_BAR; }
        E(acc, cur, wr, wc, fr, fq);
        if (!has_next) break;
#pragma unroll
        for (int a = 0; a < 2; ++a)
#pragma unroll
            for (int b = 0; b < 2; ++b)
#pragma unroll
                for (int m = 0; m < 4; ++m)
#pragma unroll
                    for (int n = 0; n < 2; ++n) acc[a][b][m][n] = (f32x4){0.f, 0.f, 0.f, 0.f};
        cur = nxt; cA = nA; cB = nB; ++ui;
        if (ALIGN_EPI) { if (wr == 1) PG8_BAR; }
    }
    PG8_WAIT_V(0);
    if (!ALIGN_EPI) { if (wr == 0) PG8_BAR; }
    PG8_BAR;
#undef PG8_SA
#undef PG8_SB
#undef PG8_STAGE
#undef PG8_LDA
#undef PG8_LDB
#undef PG8_MMA
#undef PG8_WAIT_V
#undef PG8_WAIT_L
#undef PG8_BAR
#undef PG8_SCHED
}
}

#define XB_TMO      128
#define XB_XCNT(j)  (256  + 64 * (j))
#define XB_XSUB(j)  (1280 + 64 * (j))
#define XB_XGEN(j)  (2304 + 64 * (j))
#define XB_TOP      3328
#define XB_TOPGEN   3392
#define XCD_BAR_WORDS 3456
#define XB_SPIN_CAP (1u << 18)
__device__ __forceinline__ unsigned xb_ld(unsigned* p)              { return __hip_atomic_load(p, __ATOMIC_RELAXED, __HIP_MEMORY_SCOPE_AGENT); }
__device__ __forceinline__ unsigned xb_add(unsigned* p, unsigned v) { return __hip_atomic_fetch_add(p, v, __ATOMIC_RELAXED, __HIP_MEMORY_SCOPE_AGENT); }
__device__ __forceinline__ unsigned xb_xcc_id() { return (unsigned)__builtin_amdgcn_s_getreg((3 << 11) | 20) & 0xFu; }
#define XB_SPIN(cond, bar) do { unsigned _sp = 0; while (cond) { __builtin_amdgcn_s_sleep(1); \
    if ((++_sp & 255u) == 0u) { if (xb_ld(&(bar)[XB_TMO])) break; if (_sp > XB_SPIN_CAP) { atomicAdd(&(bar)[XB_TMO], 1u); break; } } } } while (0)
struct XcdBarrier { unsigned* bar; unsigned x; volatile LAS unsigned* st; };
__device__ __forceinline__ XcdBarrier xcd_barrier_post(unsigned* bar, volatile LAS unsigned* st) {
    XcdBarrier b; b.bar = bar; b.x = xb_xcc_id(); b.st = st;
    if (threadIdx.x == 0) (void)xb_add(&bar[XB_XCNT(b.x)], 1u);
    return b;
}
__device__ __forceinline__ void xcd_barrier_complete(unsigned* bar, unsigned x, unsigned& nloc, unsigned& nx) {
    const unsigned G = gridDim.x * gridDim.y * gridDim.z;
    unsigned sum, cnt, mine, sp = 0u;
    for (;;) {
        sum = 0u; cnt = 0u; mine = 0u;
#pragma unroll
        for (unsigned j = 0; j < 16; ++j) { const unsigned c = xb_ld(&bar[XB_XCNT(j)]); sum += c; cnt += (c > 0u) ? 1u : 0u; mine = (j == x) ? c : mine; }
        if (sum == G) break;
        __builtin_amdgcn_s_sleep(1);
        if ((++sp & 255u) == 0u) { if (xb_ld(&bar[XB_TMO])) break; if (sp > XB_SPIN_CAP) { atomicAdd(&bar[XB_TMO], 1u); break; } }
    }
    nloc = mine > 0u ? mine : 1u; nx = cnt > 0u ? cnt : 1u;
}
__device__ __forceinline__ void xcd_barrier(const XcdBarrier& b) {
    asm volatile("s_waitcnt vmcnt(0)" ::: "memory");
    __syncthreads();
    if (threadIdx.x == 0) {
        unsigned* bar = b.bar;
        __builtin_amdgcn_s_waitcnt(0);
        unsigned nloc = b.st[0], nx = b.st[1];
        if (nloc == 0u) { xcd_barrier_complete(bar, b.x, nloc, nx); b.st[0] = nloc; b.st[1] = nx; }
        const unsigned old = xb_add(&bar[XB_XSUB(b.x)], 1u);
        const unsigned gen = old / nloc;
        if (old + 1u == (gen + 1u) * nloc) {
            __builtin_amdgcn_fence(__ATOMIC_RELEASE, "agent");
            asm volatile("s_waitcnt vmcnt(0)" ::: "memory");
            const unsigned og = xb_add(&bar[XB_TOP], 1u);
            const unsigned tg = og / nx;
            if (og + 1u == (tg + 1u) * nx) xb_add(&bar[XB_TOPGEN], 1u);
            else XB_SPIN(xb_ld(&bar[XB_TOPGEN]) == tg, bar);
            __builtin_amdgcn_fence(__ATOMIC_ACQUIRE, "agent");
            xb_add(&bar[XB_XGEN(b.x)], 1u);
            asm volatile("s_waitcnt vmcnt(0)" ::: "memory");
        } else {
            XB_SPIN(xb_ld(&bar[XB_XGEN(b.x)]) == gen, bar);
            __builtin_amdgcn_fence(__ATOMIC_ACQUIRE, "agent");
            asm volatile("s_waitcnt vmcnt(0)" ::: "memory");
        }
    }
    __syncthreads();
}

struct Args { const float* in[22]; float* out; unsigned char* ws; int ph_lo, ph_hi; };
struct Ctx { LAS unsigned char* lds; int G, bid; };
#define TID_SETUP() int tid = threadIdx.x; asm volatile("" : "+v"(tid)); const int lane = tid & 63, wave = __builtin_amdgcn_readfirstlane(tid >> 6); (void)lane; (void)wave
typedef const __attribute__((address_space(4))) Args* ArgsP;
__device__ __forceinline__ ArgsP args_ptr() { ArgsP p = (ArgsP)__builtin_amdgcn_kernarg_segment_ptr(); asm volatile("" : "+s"(p)); return p; }
#define WSP(T, off) ((T*)(A->ws + (off)))

struct MapId { __device__ __forceinline__ int operator()(int n) const { return n; } };
struct MapGU { __device__ __forceinline__ int operator()(int n) const { const int t = n >> 8, w = n & 255; return w < 128 ? 128 * t + w : DFF + 128 * t + (w - 128); } };
struct MapIn { __device__ __forceinline__ int operator()(int n) const {
    if (n < 3072) return n + 512; if (n < 3584) return n - 3072; if (n < 4608) return n; if (n < 5120) return n + 8; if (n < 8192) return n + 460; if (n < 8640) return n - 3064;
    if (n < 8644) return 4608 + (n - 8640); if (n < 8648) return 4612 + (n - 8644); if (n < 8652) return 5576 + (n - 8648); return -1; } };
template <class Map>
__device__ __forceinline__ void conv_item(const float* W, int K, int N, bf16_t* WT, int ldt, int koff, const float* gain, LAS float* scr, int item, int nblk, int lane, Map map) {
    const int kb = item / nblk, nb = item % nblk, k0 = 64 * kb, n0 = 32 * nb;
    const int c = map(n0 + (lane & 31));
    float wv[32];
#pragma unroll
    for (int i = 0; i < 32; ++i) { const int kk = 2 * i + (lane >> 5); wv[i] = (c >= 0) ? W[(size_t)(k0 + kk) * N + c] : 0.f; }
#pragma unroll
    for (int i = 0; i < 32; ++i) { const int kk = 2 * i + (lane >> 5); float v = wv[i]; if (gain) v *= gain[k0 + kk]; scr[kk * 33 + (lane & 31)] = v; }
    asm volatile("s_waitcnt lgkmcnt(0)" ::: "memory");
    const int c8 = lane & 7;
#pragma unroll
    for (int j = 0; j < 4; ++j) { const int n = (lane >> 3) + 8 * j; const LAS float* s = scr + (8 * c8) * 33 + n;
        u32x4 o; o.x = pk2(s[0 * 33], s[1 * 33]); o.y = pk2(s[2 * 33], s[3 * 33]); o.z = pk2(s[4 * 33], s[5 * 33]); o.w = pk2(s[6 * 33], s[7 * 33]);
        *(u32x4*)(WT + (size_t)(n0 + n) * ldt + koff + k0 + 8 * c8) = o; }
    asm volatile("s_waitcnt lgkmcnt(0)" ::: "memory");
}
__device__ __forceinline__ void phase_convert(const Ctx& C, int l) {
    TID_SETUP(); ArgsP A = args_ptr(); const int gw = C.bid * NWAVES + wave, NGW = C.G * NWAVES;
    LAS float* scr = (LAS float*)(C.lds + wave * 16384);
    bf16_t* W = WSP(bf16_t, WS_W);
    constexpr int I_GU = 16 * 176, I_DN = 44 * 32, I_IN = 16 * 272, I_CO = 8 * 32, I_MO = 16 * 32, I_AO = 8 * 32, I_O = 16 * 32, I_PG = 16 * 32, I_PP = 4 * 32;
    constexpr int NIT = 2 * I_GU + 2 * I_DN + I_IN + I_CO + I_MO + I_AO + I_O + I_PG + I_PP;
    for (int it = gw; it < NIT; it += NGW) {
        int r = it;
        if (r < I_GU) { conv_item(A->in[3] + (size_t)l * DM * 2 * DFF, DM, 2 * DFF, W + W_GU1, DM, 0, A->in[2] + (size_t)l * DM, scr, r, 176, lane, MapGU()); continue; } r -= I_GU;
        if (r < I_GU) { conv_item(A->in[16] + (size_t)l * DM * 2 * DFF, DM, 2 * DFF, W + W_GU2, DM, 0, A->in[15] + (size_t)l * DM, scr, r, 176, lane, MapGU()); continue; } r -= I_GU;
        if (r < I_DN) { conv_item(A->in[4] + (size_t)l * DFF * DM, DFF, DM, W + W_DN1, DFF, 0, nullptr, scr, r, 32, lane, MapId()); continue; } r -= I_DN;
        if (r < I_DN) { conv_item(A->in[17] + (size_t)l * DFF * DM, DFF, DM, W + W_DN2, DFF, 0, nullptr, scr, r, 32, lane, MapId()); continue; } r -= I_DN;
        if (r < I_IN) { conv_item(A->in[6] + (size_t)l * DM * 8652, DM, 8652, W + W_IN, DM, 0, A->in[5] + (size_t)l * DM, scr, r, 272, lane, MapIn()); continue; } r -= I_IN;
        if (r < I_CO) { conv_item(A->in[8] + (size_t)l * DCONV * DM, DCONV, DM, W + W_MRG, 2048, 0, nullptr, scr, r, 32, lane, MapId()); continue; } r -= I_CO;
        if (r < I_MO) { conv_item(A->in[12] + (size_t)l * DM * DM, DM, DM, W + W_MRG, 2048, 512, nullptr, scr, r, 32, lane, MapId()); continue; } r -= I_MO;
        if (r < I_AO) { conv_item(A->in[13] + (size_t)l * 512 * DM, 512, DM, W + W_MRG, 2048, 1536, nullptr, scr, r, 32, lane, MapId()); continue; } r -= I_AO;
        if (r < I_O) { conv_item(A->in[14] + (size_t)l * DM * DM, DM, DM, W + W_O, DM, 0, nullptr, scr, r, 32, lane, MapId()); continue; } r -= I_O;
        if (r < I_PG) { conv_item(A->in[19] + (size_t)l * DM * DM, DM, DM, W + W_PG, DM, 0, A->in[18] + (size_t)l * DM, scr, r, 32, lane, MapId()); continue; } r -= I_PG;
        conv_item(A->in[20] + (size_t)l * DPLE * DM, DPLE, DM, W + W_PP, DPLE, 0, nullptr, scr, r, 32, lane, MapId());
    }
}
__device__ __forceinline__ void phase_init_rows(const Ctx& C) {
    TID_SETUP(); ArgsP A = args_ptr(); const int gw = C.bid * NWAVES + wave, NGW = C.G * NWAVES;
    const float* x = A->in[0]; bf16_t* XB = WSP(bf16_t, WS_XB); float* SS0 = WSP(float, WS_SS0);
    for (int m0 = 4 * gw; m0 < MTOK; m0 += 4 * NGW) {
        f32x4 v[4][4];
#pragma unroll
        for (int k = 0; k < 4; ++k) { const int m = m0 + k; const f32x4* xr = (const f32x4*)(x + (size_t)m * DM) + lane;
#pragma unroll
            for (int j = 0; j < 4; ++j) v[k][j] = xr[64 * j]; }
#pragma unroll
        for (int k = 0; k < 4; ++k) { const int m = m0 + k;
            { u32x2* bo = (u32x2*)(XB + (size_t)m * DM) + lane; float s = 0.f;
#pragma unroll
                for (int j = 0; j < 4; ++j) { const f32x4 t = v[k][j]; u32x2 w; w.x = pk2(t[0], t[1]); w.y = pk2(t[2], t[3]); bo[64 * j] = w; s += (t[0] * t[0] + t[1] * t[1]) + (t[2] * t[2] + t[3] * t[3]); }
                s = wave_sum(s);
                if (lane == 0) *(f32x4*)(SS0 + (size_t)m * 4) = (f32x4){s, 0.f, 0.f, 0.f}; } }
    }
}
__device__ __forceinline__ void phase_pb(const Ctx& C, int l) {
    TID_SETUP(); ArgsP A = args_ptr();
    const f32x4* p = (const f32x4*)(A->in[1] + (size_t)l * MTOK * DPLE); u32x2* o = WSP(u32x2, WS_PB);
    const size_t n4 = (size_t)MTOK * DPLE / 4;
    for (size_t i = (size_t)C.bid * NTHR + tid; i < n4; i += (size_t)C.G * NTHR) { const f32x4 v = p[i]; u32x2 w; w.x = pk2(v[0], v[1]); w.y = pk2(v[2], v[3]); o[i] = w; }
}
__device__ __forceinline__ void phase_final(const Ctx& C) {
    TID_SETUP(); ArgsP A = args_ptr(); const int gw = C.bid * NWAVES + wave, NGW = C.G * NWAVES;
    const f32x4* gn = (const f32x4*)A->in[21] + lane; float* X = A->out; const float* SS = WSP(float, WS_SS0);
    f32x4 g4[4];
#pragma unroll
    for (int j = 0; j < 4; ++j) g4[j] = gn[64 * j];
    for (int m0 = 4 * gw; m0 < MTOK; m0 += 4 * NGW) {
        f32x4 v[4][4]; float r[4];
#pragma unroll
        for (int k = 0; k < 4; ++k) { const int m = m0 + k; const f32x4* xr = (const f32x4*)(X + (size_t)m * DM) + lane;
#pragma unroll
            for (int j = 0; j < 4; ++j) v[k][j] = xr[64 * j];
            r[k] = rstd_of(SS + (size_t)m * 4); }
#pragma unroll
        for (int k = 0; k < 4; ++k) { const int m = m0 + k;
            { f32x4* xr = (f32x4*)(X + (size_t)m * DM) + lane;
#pragma unroll
                for (int j = 0; j < 4; ++j) xr[64 * j] = v[k][j] * r[k] * g4[j]; } }
    }
}

__device__ __forceinline__ void prep_conv(const Ctx& C, int l, int b, int part, int nparts, int dry) {
    TID_SETUP(); ArgsP A = args_ptr();
    const float* cw = A->in[7] + (size_t)l * 3 * DCONV; bf16_t* PROJ = WSP(bf16_t, WS_PROJ);
    const int nit = SEQ * 64;
    for (int i = part * NTHR + tid; i < nit; i += nparts * NTHR) {
        const int ts = i >> 6, ch = (i & 63) * 8, tok = b * SEQ + ts;
        bf16_t* row = PROJ + (size_t)tok * LDP;
        const u32x4 b = *(const u32x4*)(row + O_CB + ch);
        float u[3][8];
#pragma unroll
        for (int d = 0; d < 3; ++d) {
            const int back = 2 - d;
            if (ts >= back) { const bf16_t* r2 = row - (size_t)back * LDP; const u32x4 c = *(const u32x4*)(r2 + O_CC + ch), x = *(const u32x4*)(r2 + O_CX + ch);
                const unsigned cwv[4] = {c.x, c.y, c.z, c.w}, xwv[4] = {x.x, x.y, x.z, x.w};
#pragma unroll
                for (int j = 0; j < 4; ++j) { u[d][2 * j] = bflo(cwv[j]) * bflo(xwv[j]); u[d][2 * j + 1] = bfhi(cwv[j]) * bfhi(xwv[j]); } }
            else {
#pragma unroll
                for (int j = 0; j < 8; ++j) u[d][j] = 0.f; }
        }
        const unsigned bw[4] = {b.x, b.y, b.z, b.w}; float o[8];
#pragma unroll
        for (int j = 0; j < 8; ++j) { const float bb = (j & 1) ? bfhi(bw[j >> 1]) : bflo(bw[j >> 1]);
            o[j] = bb * (u[0][j] * cw[ch + j] + u[1][j] * cw[DCONV + ch + j] + u[2][j] * cw[2 * DCONV + ch + j]); }
        u32x4 w; w.x = pk2(o[0], o[1]); w.y = pk2(o[2], o[3]); w.z = pk2(o[4], o[5]); w.w = pk2(o[6], o[7]);
        if (!dry) *(u32x4*)(row + O_CB + ch) = w;
    }
}
__device__ __forceinline__ void prep_gate(const Ctx& C, int l, int part, int nparts, int dry = 0) {
    TID_SETUP(); ArgsP A = args_ptr();
    const float* gn = A->in[11] + (size_t)l * DM; bf16_t* PROJ = WSP(bf16_t, WS_PROJ);
    const int nit = MG * 4, g = lane >> 4, li = lane & 15;
    for (int i = (part * NWAVES + wave) * 4 + g; i < nit; i += nparts * NWAVES * 4) {
        const int tok = i >> 2, hd = i & 3;
        bf16_t* row = PROJ + (size_t)tok * LDP;
        const u32x4 h0 = *(const u32x4*)(row + O_MV + hd * 256 + li * 16), h1 = *(const u32x4*)(row + O_MV + hd * 256 + li * 16 + 8);
        const u32x4 o0 = *(const u32x4*)(row + O_MO + hd * 256 + li * 16), o1 = *(const u32x4*)(row + O_MO + hd * 256 + li * 16 + 8);
        const unsigned hw[8] = {h0.x, h0.y, h0.z, h0.w, h1.x, h1.y, h1.z, h1.w}, ow[8] = {o0.x, o0.y, o0.z, o0.w, o1.x, o1.y, o1.z, o1.w};
        float ssq = 0.f;
#pragma unroll
        for (int j = 0; j < 8; ++j) { const float a = bflo(hw[j]), bb = bfhi(hw[j]); ssq += a * a + bb * bb; }
#pragma unroll
        for (int o = 1; o < 16; o <<= 1) ssq += __shfl_xor(ssq, o);
        const float r = 1.0f / sqrtf(ssq * (1.0f / 256.0f) + EPS);
        const f32x4* gp = (const f32x4*)(gn + hd * 256 + li * 16);
        unsigned w[8];
#pragma unroll
        for (int j = 0; j < 4; ++j) { const f32x4 gv = gp[j];
            w[2 * j] = pk2(fsigmoid(bflo(ow[2 * j])) * bflo(hw[2 * j]) * r * gv[0], fsigmoid(bfhi(ow[2 * j])) * bfhi(hw[2 * j]) * r * gv[1]);
            w[2 * j + 1] = pk2(fsigmoid(bflo(ow[2 * j + 1])) * bflo(hw[2 * j + 1]) * r * gv[2], fsigmoid(bfhi(ow[2 * j + 1])) * bfhi(hw[2 * j + 1]) * r * gv[3]); }
        if (!dry) { *(u32x4*)(row + O_MO + hd * 256 + li * 16) = (u32x4){w[0], w[1], w[2], w[3]}; *(u32x4*)(row + O_MO + hd * 256 + li * 16 + 8) = (u32x4){w[4], w[5], w[6], w[7]}; }
    }
}

namespace ml {
constexpr int QS = 0, KS = 17408, VS = 34816, VW = 44032, PS = 53248, CB = 62464, SC = 97280, NP = 99328, NV = 103424, MS = 103936, LEND = 104704;
constexpr int PQ = 272, PT = 144;
static_assert(LEND <= RING_BYTES, "mlstm LDS");
typedef short s16x4 __attribute__((ext_vector_type(4)));
__device__ __forceinline__ f32x4 mfma16(bf16x8 a, bf16x8 b, f32x4 c) { return __builtin_amdgcn_mfma_f32_16x16x32_bf16(a, b, c, 0, 0, 0); }
__device__ __forceinline__ bf16x8 ldsv(const LAS unsigned char* p) { return *(const LAS bf16x8*)p; }
__device__ __forceinline__ bf16x8 frag_tr(const LAS unsigned char* X, int P, int r0, int c0, int lane) {
    const int g = lane >> 4, li = lane & 15;
    const LAS unsigned char* p = X + (r0 + 8 * g + (li >> 2)) * P + (c0 + 4 * (li & 3)) * 2;
    const s16x4 lo = __builtin_amdgcn_ds_read_tr16_b64_v4i16((LAS s16x4*)p), hi = __builtin_amdgcn_ds_read_tr16_b64_v4i16((LAS s16x4*)(p + 4 * P));
    return __builtin_shufflevector(lo, hi, 0, 1, 2, 3, 4, 5, 6, 7);
}

__device__ __forceinline__ void unit(const Ctx& C, int l, int uidx, int dry) {
    TID_SETUP(); ArgsP A = args_ptr();
    const int b = uidx >> 4, hd = (uidx >> 2) & 3, vq = uidx & 3;
    LAS unsigned char* L = C.lds;
    LAS float* sc = (LAS float*)(L + SC);
    LAS float* npart = (LAS float*)(L + NP);
    LAS float* nv = (LAS float*)(L + NV);
    LAS float* ms = (LAS float*)(L + MS);
    const int w = wave, fr = lane & 15, fq = lane >> 4;
    const float bi = A->in[9][l * 4 + hd], bfg = A->in[10][l * 4 + hd];
    bf16_t* base = WSP(bf16_t, WS_PROJ) + (size_t)b * SEQ * LDP;
    float* scr = WSP(float, WS_SCR) + (size_t)uidx * (64 * 192);
    for (int c = w; c < SEQ / 64; c += NWAVES) {
        const bf16_t* rb = WSP(bf16_t, WS_SIDE) + (size_t)(b * SEQ + c * 64 + lane) * LDS_;
        const float fv = bf2f(rb[O_MF - O_SIDE + hd]) + bfg, iv = bf2f(rb[O_MI - O_SIDE + hd]) + bi;
        const float lf = fminf(fv, 0.f) - log1pf(__expf(-fabsf(fv)));
        float bt = lf;
#pragma unroll
        for (int o = 1; o < 64; o <<= 1) { const float t = __shfl_up(bt, o); if (lane >= o) bt += t; }
        const float a = iv - bt; float pm = a;
#pragma unroll
        for (int o = 1; o < 64; o <<= 1) { const float t = __shfl_up(pm, o); if (lane >= o) pm = fmaxf(pm, t); }
        scr[c * 192 + lane] = a; scr[c * 192 + 64 + lane] = pm; scr[c * 192 + 128 + lane] = bt;
        if (lane == 63) { ms[64 + c] = bt; ms[128 + c] = pm; }
    }
    f32x4 cst[4];
#pragma unroll
    for (int i = 0; i < 4; ++i) cst[i] = (f32x4){0.f, 0.f, 0.f, 0.f};
    for (int i = tid; i < 2 * 64 * PQ / 4; i += NTHR) ((LAS unsigned*)(L + CB))[i] = 0u;
    for (int i = tid; i < 8 * 128; i += NTHR) npart[i] = 0.f;
    if (tid < 128) nv[tid] = 0.f;
    __syncthreads();
    if (tid == 0) { float m = 0.f; for (int c = 0; c < SEQ / 64; ++c) { ms[c] = m; m = ms[64 + c] + fmaxf(m, ms[128 + c]); } }
    const int qr = tid >> 4, qc = (tid & 15) * 8;
    const int vr = tid >> 3, vc = (tid & 7) * 8;
    u32x4 rq[2], rk[2], rv; float ra = 0.f, rpm = 0.f, rbt = 0.f;
#define ML_ISSUE(cc) do { const bf16_t* rb = base + (size_t)((cc) * 64) * LDP; \
        rq[0] = *(const u32x4*)(rb + (size_t)qr * LDP + O_MQ + hd * 128 + qc); rq[1] = *(const u32x4*)(rb + (size_t)(qr + 32) * LDP + O_MQ + hd * 128 + qc); \
        rk[0] = *(const u32x4*)(rb + (size_t)qr * LDP + O_MK + hd * 128 + qc); rk[1] = *(const u32x4*)(rb + (size_t)(qr + 32) * LDP + O_MK + hd * 128 + qc); \
        rv = *(const u32x4*)(rb + (size_t)vr * LDP + O_MV + hd * 256 + vq * 64 + vc); \
        if (w == 0) { ra = scr[(cc) * 192 + lane]; rpm = scr[(cc) * 192 + 64 + lane]; rbt = scr[(cc) * 192 + 128 + lane]; } } while (0)
    __syncthreads();
    ML_ISSUE(0);
    float decay = 0.f;
    int cur = 0;
#pragma unroll 1
    for (int c = 0; c < SEQ / 64; ++c) {
#pragma unroll
        for (int i = 0; i < 2; ++i) {
            *(LAS u32x4*)(L + QS + (qr + 32 * i) * PQ + qc * 2) = rq[i];
            *(LAS u32x4*)(L + KS + (qr + 32 * i) * PQ + qc * 2) = rk[i];
        }
        *(LAS u32x4*)(L + VS + vr * PT + vc * 2) = rv;
        const u32x4 vkeep = rv;
        if (tid < 128) { float pn[8], nold = nv[tid];
#pragma unroll
            for (int j = 0; j < 8; ++j) pn[j] = npart[j * 128 + tid];
            asm volatile("" : "+v"(pn[0]), "+v"(pn[1]), "+v"(pn[2]), "+v"(pn[3]), "+v"(pn[4]), "+v"(pn[5]), "+v"(pn[6]), "+v"(pn[7]), "+v"(nold));
            float sn = 0.f;
#pragma unroll
            for (int j = 0; j < 8; ++j) sn += pn[j];
            nv[tid] = decay * nold + sn; }
        if (w == 0) {
            const float mc = ms[c], p63 = ms[128 + c];
            const float Mt = fmaxf(mc, rpm), M63 = fmaxf(mc, p63);
            sc[lane] = ra; sc[64 + lane] = Mt; sc[128 + lane] = __expf(mc - Mt); sc[192 + lane] = __expf(-(rbt + Mt)); sc[256 + lane] = __expf(ra - M63);
            if (lane == 0) sc[320] = __expf(mc - M63);
        }
        __syncthreads();
        decay = sc[320];
        if (c + 1 < SEQ / 64) ML_ISSUE(c + 1);
        { const float wk = sc[256 + vr]; const unsigned vw[4] = {vkeep.x, vkeep.y, vkeep.z, vkeep.w}; u32x4 o;
          o.x = pk2(bflo(vw[0]) * wk, bfhi(vw[0]) * wk); o.y = pk2(bflo(vw[1]) * wk, bfhi(vw[1]) * wk); o.z = pk2(bflo(vw[2]) * wk, bfhi(vw[2]) * wk); o.w = pk2(bflo(vw[3]) * wk, bfhi(vw[3]) * wk);
          *(LAS u32x4*)(L + VW + vr * PT + vc * 2) = o; }
        {
            const int ti = w >> 1;
            bf16x8 qa[4], kf[2][4];
#pragma unroll
            for (int kk = 0; kk < 4; ++kk) qa[kk] = ldsv(L + QS + (16 * ti + fr) * PQ + (32 * kk + 8 * fq) * 2);
#pragma unroll
            for (int s2 = 0; s2 < 2; ++s2)
#pragma unroll
                for (int kk = 0; kk < 4; ++kk) kf[s2][kk] = ldsv(L + KS + (16 * (2 * (w & 1) + s2) + fr) * PQ + (32 * kk + 8 * fq) * 2);
            f32x4 Mr = *(const LAS f32x4*)(sc + 64 + 16 * ti + 4 * fq);
            float as2[2] = {sc[16 * (2 * (w & 1)) + fr], sc[16 * (2 * (w & 1) + 1) + fr]};
            asm volatile("" : "+v"(qa[0]), "+v"(qa[1]), "+v"(qa[2]), "+v"(qa[3]), "+v"(kf[0][0]), "+v"(kf[0][1]), "+v"(kf[0][2]), "+v"(kf[0][3]),
                              "+v"(kf[1][0]), "+v"(kf[1][1]), "+v"(kf[1][2]), "+v"(kf[1][3]), "+v"(Mr), "+v"(as2[0]), "+v"(as2[1]));
#pragma unroll
            for (int s2 = 0; s2 < 2; ++s2) { const int si = 2 * (w & 1) + s2; f32x4 sa = (f32x4){0.f, 0.f, 0.f, 0.f};
#pragma unroll
                for (int kk = 0; kk < 4; ++kk) sa = mfma16(qa[kk], kf[s2][kk], sa);
                const int scol = 16 * si + fr; const float as = as2[s2];
#pragma unroll
                for (int r = 0; r < 4; ++r) { const int trow = 16 * ti + 4 * fq + r; const float p = (scol <= trow) ? sa[r] * __expf(as - Mr[r]) : 0.f;
                    *(LAS bf16_t*)(L + PS + trow * PT + scol * 2) = f2bf(p); } }
        }
        __syncthreads();
        {
            const int vi = w >> 1;
            bf16x8 va[2], kt[4][2];
#pragma unroll
            for (int kk = 0; kk < 2; ++kk) va[kk] = frag_tr(L + VW, PT, 32 * kk, 16 * vi, lane);
#pragma unroll
            for (int i = 0; i < 4; ++i)
#pragma unroll
                for (int kk = 0; kk < 2; ++kk) kt[i][kk] = frag_tr(L + KS, PQ, 32 * kk, 16 * (4 * (w & 1) + i), lane);
            asm volatile("" : "+v"(va[0]), "+v"(va[1]), "+v"(kt[0][0]), "+v"(kt[0][1]), "+v"(kt[1][0]), "+v"(kt[1][1]), "+v"(kt[2][0]), "+v"(kt[2][1]), "+v"(kt[3][0]), "+v"(kt[3][1]));
#pragma unroll
            for (int i = 0; i < 4; ++i) { const int di = 4 * (w & 1) + i; f32x4 a = cst[i] * decay;
#pragma unroll
                for (int kk = 0; kk < 2; ++kk) a = mfma16(va[kk], kt[i][kk], a);
                cst[i] = a;
#pragma unroll
                for (int r = 0; r < 4; ++r) *(LAS bf16_t*)(L + CB + (cur ^ 1) * 64 * PQ + (16 * vi + 4 * fq + r) * PQ + (16 * di + fr) * 2) = f2bf(a[r]); }
        }
        {
            float p0 = 0.f, p1 = 0.f; unsigned kw[8];
#pragma unroll
            for (int i = 0; i < 8; ++i) kw[i] = *(const LAS unsigned*)(L + KS + (8 * w + i) * PQ + lane * 4);
            f32x4 wk0 = *(const LAS f32x4*)(sc + 256 + 8 * w), wk1 = *(const LAS f32x4*)(sc + 256 + 8 * w + 4);
            asm volatile("" : "+v"(kw[0]), "+v"(kw[1]), "+v"(kw[2]), "+v"(kw[3]), "+v"(kw[4]), "+v"(kw[5]), "+v"(kw[6]), "+v"(kw[7]), "+v"(wk0), "+v"(wk1));
#pragma unroll
            for (int i = 0; i < 8; ++i) { const float wk = (i < 4) ? wk0[i & 3] : wk1[i & 3]; p0 += wk * bflo(kw[i]); p1 += wk * bfhi(kw[i]); }
            npart[w * 128 + 2 * lane] = p0; npart[w * 128 + 2 * lane + 1] = p1;
        }
        {
            const int ti = w >> 1;
            float nq = 0.f, ps = 0.f;
            { const LAS unsigned char* qrow = L + QS + (16 * ti + fr) * PQ + (32 * fq) * 2;
              const LAS unsigned char* prow = L + PS + (16 * ti + fr) * PT + (16 * fq) * 2;
              u32x4 qv[4], pv[2]; f32x4 nvv[8];
#pragma unroll
              for (int h4 = 0; h4 < 4; ++h4) qv[h4] = *(const LAS u32x4*)(qrow + h4 * 16);
#pragma unroll
              for (int i = 0; i < 8; ++i) nvv[i] = *(const LAS f32x4*)(nv + 32 * fq + 4 * i);
#pragma unroll
              for (int h2 = 0; h2 < 2; ++h2) pv[h2] = *(const LAS u32x4*)(prow + h2 * 16);
              asm volatile("" : "+v"(qv[0]), "+v"(qv[1]), "+v"(qv[2]), "+v"(qv[3]), "+v"(pv[0]), "+v"(pv[1]),
                                "+v"(nvv[0]), "+v"(nvv[1]), "+v"(nvv[2]), "+v"(nvv[3]), "+v"(nvv[4]), "+v"(nvv[5]), "+v"(nvv[6]), "+v"(nvv[7]));
#pragma unroll
              for (int h4 = 0; h4 < 4; ++h4) { const unsigned qw[4] = {qv[h4].x, qv[h4].y, qv[h4].z, qv[h4].w};
#pragma unroll
                  for (int j = 0; j < 4; ++j) { const int e0 = 8 * h4 + 2 * j; nq += nvv[e0 >> 2][e0 & 3] * bflo(qw[j]) + nvv[(e0 + 1) >> 2][(e0 + 1) & 3] * bfhi(qw[j]); } }
#pragma unroll
              for (int h2 = 0; h2 < 2; ++h2) { const unsigned pw[4] = {pv[h2].x, pv[h2].y, pv[h2].z, pv[h2].w};
#pragma unroll
                  for (int j = 0; j < 4; ++j) ps += bflo(pw[j]) + bfhi(pw[j]); } }
            { const auto a1 = __builtin_amdgcn_permlane16_swap(__float_as_uint(nq), __float_as_uint(nq), false, false); const auto b1 = __builtin_amdgcn_permlane16_swap(__float_as_uint(ps), __float_as_uint(ps), false, false);
              nq = __uint_as_float(a1[0]) + __uint_as_float(a1[1]); ps = __uint_as_float(b1[0]) + __uint_as_float(b1[1]);
              const auto a2 = __builtin_amdgcn_permlane32_swap(__float_as_uint(nq), __float_as_uint(nq), false, false); const auto b2 = __builtin_amdgcn_permlane32_swap(__float_as_uint(ps), __float_as_uint(ps), false, false);
              nq = __uint_as_float(a2[0]) + __uint_as_float(a2[1]); ps = __uint_as_float(b2[0]) + __uint_as_float(b2[1]); }
            const float den_own = sc[128 + 16 * ti + fr] * nq + ps;
            float wr4[4], em4[4], dn4[4];
#pragma unroll
            for (int r = 0; r < 4; ++r) { wr4[r] = sc[128 + 16 * ti + 4 * fq + r]; em4[r] = sc[192 + 16 * ti + 4 * fq + r]; dn4[r] = __shfl(den_own, 4 * fq + r); }
            asm volatile("" : "+v"(dn4[0]), "+v"(dn4[1]), "+v"(dn4[2]), "+v"(dn4[3]), "+v"(wr4[0]), "+v"(wr4[1]), "+v"(wr4[2]), "+v"(wr4[3]), "+v"(em4[0]), "+v"(em4[1]), "+v"(em4[2]), "+v"(em4[3]));
            bf16x8 qa[4], pa[2], cbf[2][4], vtf[2][2];
#pragma unroll
            for (int kk = 0; kk < 4; ++kk) qa[kk] = ldsv(L + QS + (16 * ti + fr) * PQ + (32 * kk + 8 * fq) * 2);
#pragma unroll
            for (int kk = 0; kk < 2; ++kk) pa[kk] = ldsv(L + PS + (16 * ti + fr) * PT + (32 * kk + 8 * fq) * 2);
#pragma unroll
            for (int v2 = 0; v2 < 2; ++v2) {
#pragma unroll
                for (int kk = 0; kk < 4; ++kk) cbf[v2][kk] = ldsv(L + CB + cur * 64 * PQ + (16 * (2 * (w & 1) + v2) + fr) * PQ + (32 * kk + 8 * fq) * 2);
#pragma unroll
                for (int kk = 0; kk < 2; ++kk) vtf[v2][kk] = frag_tr(L + VS, PT, 32 * kk, 16 * (2 * (w & 1) + v2), lane); }
            asm volatile("" : "+v"(qa[0]), "+v"(qa[1]), "+v"(qa[2]), "+v"(qa[3]), "+v"(pa[0]), "+v"(pa[1]), "+v"(cbf[0][0]), "+v"(cbf[0][1]), "+v"(cbf[0][2]), "+v"(cbf[0][3]),
                              "+v"(cbf[1][0]), "+v"(cbf[1][1]), "+v"(cbf[1][2]), "+v"(cbf[1][3]), "+v"(vtf[0][0]), "+v"(vtf[0][1]), "+v"(vtf[1][0]), "+v"(vtf[1][1]));
            const float kscale = 0.08838834764831845f;
#pragma unroll
            for (int v2 = 0; v2 < 2; ++v2) { const int vi = 2 * (w & 1) + v2; f32x4 a = (f32x4){0.f, 0.f, 0.f, 0.f};
#pragma unroll
                for (int kk = 0; kk < 4; ++kk) a = mfma16(qa[kk], cbf[v2][kk], a);
#pragma unroll
                for (int r = 0; r < 4; ++r) a[r] *= wr4[r];
#pragma unroll
                for (int kk = 0; kk < 2; ++kk) a = mfma16(pa[kk], vtf[v2][kk], a);
#pragma unroll
                for (int r = 0; r < 4; ++r) { const float hval = kscale * a[r] * __builtin_amdgcn_rcpf(fmaxf(kscale * fabsf(dn4[r]), em4[r]));
                    if (!dry) base[(size_t)(c * 64 + 16 * ti + 4 * fq + r) * LDP + O_MV + hd * 256 + vq * 64 + 16 * vi + fr] = f2bf(hval); } }
        }
        __syncthreads();
        cur ^= 1;
    }
#undef ML_ISSUE
}
}

namespace dsa {
constexpr int GT = 0, EQ = 16384, QST = 32768, HIST = 33280, HPITCH = 257, LIST = HIST + 32 * HPITCH * 4, LCAP = 64, CNT = LIST + 32 * LCAP * 4, KST = 33280, KBUF = 128 * 144, VST = KST + 2 * KBUF, LEND = VST + 2 * KBUF, EMK = LEND, EMKB = 8192;
static_assert(CNT + 512 <= LEND, "dsa LDS");
typedef short s16x4 __attribute__((ext_vector_type(4)));
static_assert(LEND <= RING_BYTES, "dsa LDS");
__device__ __forceinline__ f32x16 mfma32(bf16x8 a, bf16x8 b, f32x16 c) { return __builtin_amdgcn_mfma_f32_32x32x16_bf16(a, b, c, 0, 0, 0); }
__device__ __forceinline__ unsigned fkey(float s) { const unsigned u = __float_as_uint(s); return (u & 0x80000000u) ? ~u : (u | 0x80000000u); }
__device__ __forceinline__ unsigned lowbits(unsigned e, int k) { if (k >= (int)__popc(e)) return e; unsigned r = 0u; for (int i = 0; i < k; ++i) { const unsigned b = e & (0u - e); r |= b; e ^= b; } return r; }

#define DSA_LOADK(dst, tile) do { _Pragma("unroll") for (int kk = 0; kk < 4; ++kk) dst[kk] = *(const bf16x8*)(kbase + (size_t)((tile) * 32 + q) * LDS_ + (O_IK - O_SIDE) + kk * 16 + hf * 8); } while (0)
__device__ __forceinline__ void idx_scores(const bf16x8 (&ka)[4], const bf16x8 (&bq)[4][4], const float (&wq)[4], float (&sc)[16]) {
    f32x16 a[4];
#pragma unroll
    for (int h = 0; h < 4; ++h)
#pragma unroll
        for (int r = 0; r < 16; ++r) a[h][r] = 0.f;
#pragma unroll
    for (int kk = 0; kk < 4; ++kk)
#pragma unroll
        for (int h = 0; h < 4; ++h) a[h] = mfma32(ka[kk], bq[h][kk], a[h]);
#pragma unroll
    for (int r = 0; r < 16; ++r) {
        float v = wq[0] * __builtin_amdgcn_fmed3f(a[0][r], 0.f, 3.0e38f);
        v = fmaf(wq[1], __builtin_amdgcn_fmed3f(a[1][r], 0.f, 3.0e38f), v);
        v = fmaf(wq[2], __builtin_amdgcn_fmed3f(a[2][r], 0.f, 3.0e38f), v);
        sc[r] = fmaf(wq[3], __builtin_amdgcn_fmed3f(a[3][r], 0.f, 3.0e38f), v) + 0.0f; }
}

#define DSA_PRELOAD() do { DSA_LOADK(k0, min(w, tlast)); DSA_LOADK(k1, min(w + NWAVES, tlast)); } while (0)
#define DSA_DIAG_MASK() if (tile == qt) { _Pragma("unroll") for (int r = 0; r < 16; ++r) { const int pos = (r & 3) + 8 * (r >> 2) + 4 * hf; sc[r] = (pos <= q) ? sc[r] : -__builtin_inff(); } }
template <int PASS>
__device__ __forceinline__ void radix_pass(LAS unsigned char* L, int lane, int w, int q, int hf, int qt, int ntile, const bf16_t* kbase, const bf16x8 (&bq)[4][4], const float (&wq)[4],
                                           bf16x8 (&k0)[4], bf16x8 (&k1)[4], u32x4* kc) {
    constexpr int shift = 24 - 8 * PASS;
    LAS unsigned* hist = (LAS unsigned*)(L + HIST); LAS unsigned* qst = (LAS unsigned*)(L + QST);
    const unsigned prefix = qst[q];
    LAS unsigned* hrow = hist + q * HPITCH;
    int tile = w; const int tlast = ntile - 1;
    if constexpr (PASS == 1) {
#pragma unroll 2
        for (; tile < ntile; tile += NWAVES) {
            const u32x4 ca = __builtin_nontemporal_load(kc + (size_t)(tile * 64 + lane) * 2), cb = __builtin_nontemporal_load(kc + (size_t)(tile * 64 + lane) * 2 + 1);
            const unsigned cw[8] = {ca.x, ca.y, ca.z, ca.w, cb.x, cb.y, cb.z, cb.w};
#pragma unroll
            for (int r = 0; r < 16; ++r) { const unsigned h16 = (r & 1) ? (cw[r >> 1] >> 16) : (cw[r >> 1] & 0xffffu);
                const bool hit = ((h16 >> 8) == prefix); const unsigned bin = hit ? (h16 & 255u) : 256u;
                __hip_atomic_fetch_add(&hrow[bin], 1u, __ATOMIC_RELAXED, __HIP_MEMORY_SCOPE_WORKGROUP); }
        }
    } else {
#define DSA_RSTEP(KB) { \
        float sc[16]; idx_scores(KB, bq, wq, sc); \
        DSA_LOADK(KB, min(tile + 2 * NWAVES, tlast)); \
        DSA_DIAG_MASK() \
        unsigned kh[8], kl[8]; \
        _Pragma("unroll") for (int r = 0; r < 16; ++r) { const unsigned key = fkey(sc[r]); unsigned bin = (key >> shift) & 255u; bool hit = true; \
            if (PASS == 0) { if (r & 1) { kh[r >> 1] |= key & 0xffff0000u; kl[r >> 1] |= key << 16; } else { kh[r >> 1] = key >> 16; kl[r >> 1] = key & 0xffffu; } } \
            if (PASS > 0) { hit = ((key >> ((shift + 8) & 31)) == prefix); bin = hit ? bin : 256u; } \
            if (PASS < 2 || __any(hit)) __hip_atomic_fetch_add(&hrow[bin], 1u, __ATOMIC_RELAXED, __HIP_MEMORY_SCOPE_WORKGROUP); } \
        if (PASS == 0) { __builtin_nontemporal_store((u32x4){kh[0], kh[1], kh[2], kh[3]}, kc + (size_t)(tile * 64 + lane) * 2); __builtin_nontemporal_store((u32x4){kh[4], kh[5], kh[6], kh[7]}, kc + (size_t)(tile * 64 + lane) * 2 + 1); \
            u32x4* kcl_ = kc + (WS_KCL - WS_KC) / 16; __builtin_nontemporal_store((u32x4){kl[0], kl[1], kl[2], kl[3]}, kcl_ + (size_t)(tile * 64 + lane) * 2); __builtin_nontemporal_store((u32x4){kl[4], kl[5], kl[6], kl[7]}, kcl_ + (size_t)(tile * 64 + lane) * 2 + 1); } \
        tile += NWAVES; }
#pragma unroll 1
    while (tile + NWAVES < ntile) { DSA_RSTEP(k0) DSA_RSTEP(k1) }
    if (tile < ntile) DSA_RSTEP(k0)
#undef DSA_RSTEP
    }
    if constexpr (PASS != 1) DSA_PRELOAD();
    __syncthreads();
    { const int g = lane >> 4, li = lane & 15, qq = 4 * w + g; const unsigned need = qst[32 + qq];
        unsigned c[16]; unsigned t = 0u;
#pragma unroll
        for (int j = 0; j < 16; ++j) { c[j] = hist[qq * HPITCH + 16 * li + j]; t += c[j]; hist[qq * HPITCH + 16 * li + j] = 0u; }
        if (li == 15) hist[qq * HPITCH + 256] = 0u;
        unsigned sfx = t;
#pragma unroll
        for (int o = 1; o < 16; o <<= 1) { const unsigned v = __shfl_down(sfx, o, 16); if (li + o < 16) sfx += v; }
        unsigned cum = sfx - t; int found = -1; unsigned cat = 0u;
#pragma unroll
        for (int j = 15; j >= 0; --j) { if (cum < need && cum + c[j] >= need) { found = j; cat = cum; } cum += c[j]; }
        if (found >= 0) { qst[qq] = (qst[qq] << 8) | (unsigned)(16 * li + found); qst[32 + qq] = need - cat; } }
    __syncthreads();
}
__device__ __forceinline__ void tie_fixup(LAS unsigned* gt, LAS unsigned* eq, int qq, int li, int need) {
    unsigned e[8]; int cn[8]; int t = 0;
#pragma unroll
    for (int j = 0; j < 8; ++j) { e[j] = eq[qq * 128 + 8 * li + j]; cn[j] = __popc(e[j]); t += cn[j]; }
    int pre = t;
#pragma unroll
    for (int o = 1; o < 16; o <<= 1) { const int v = __shfl_up(pre, o, 16); if (li >= o) pre += v; }
    int before = pre - t;
#pragma unroll
    for (int j = 0; j < 8; ++j) { const int k = min(cn[j], max(need - before, 0)); if (e[j]) gt[qq * 128 + 8 * li + j] |= lowbits(e[j], k); before += cn[j]; }
}

__device__ __forceinline__ void unit(const Ctx& C, int b, int qt, int dry) {
    TID_SETUP(); ArgsP A = args_ptr();
    LAS unsigned char* L = C.lds;
    LAS unsigned* hist = (LAS unsigned*)(L + HIST); LAS unsigned* gt = (LAS unsigned*)(L + GT); LAS unsigned* eq = (LAS unsigned*)(L + EQ); LAS unsigned* qst = (LAS unsigned*)(L + QST);
    LAS unsigned* list = (LAS unsigned*)(L + LIST); LAS unsigned* cnt = (LAS unsigned*)(L + CNT);
    const int w = wave, q = lane & 31, hf = lane >> 5;
    const int t0 = 32 * qt, ntile = qt + 1, tlast = ntile - 1;
    const bf16_t* kbase = WSP(bf16_t, WS_SIDE) + (size_t)b * SEQ * LDS_;
    const bf16_t* srow = kbase + (size_t)(t0 + q) * LDS_;
    bf16_t* qrow = WSP(bf16_t, WS_PROJ) + (size_t)(b * SEQ + t0 + q) * LDP;
    const bool sel = (qt >= 8);
    for (int i = tid; i < 2 * 32 * 128; i += NTHR) gt[i] = 0u;
    if (sel) { for (int i = tid; i < 32 * HPITCH; i += NTHR) hist[i] = 0u; }
    if (tid < 64) qst[tid] = (tid < 32) ? 0u : 256u;
    if (tid < 128) cnt[tid] = (tid >= 32 && tid < 64) ? 0xffffffffu : 0u;
    __syncthreads();
    if (sel) {
        bf16x8 bq[4][4]; float wq[4];
#pragma unroll
        for (int h = 0; h < 4; ++h) { wq[h] = bf2f(srow[O_IW - O_SIDE + h]) * 0.0625f;
#pragma unroll
            for (int kk = 0; kk < 4; ++kk) bq[h][kk] = *(const bf16x8*)(srow + (O_IQ - O_SIDE) + h * 64 + kk * 16 + hf * 8); }
        bf16x8 k0[4], k1[4];
        u32x4* kc = WSP(u32x4, WS_KC) + (size_t)C.bid * (128 * 64 * 2);
        DSA_PRELOAD();
        radix_pass<0>(L, lane, w, q, hf, qt, ntile, kbase, bq, wq, k0, k1, kc);
        radix_pass<1>(L, lane, w, q, hf, qt, ntile, kbase, bq, wq, k0, k1, kc);
        {
            const unsigned p16 = qst[q]; const u32x4* kcl = kc + (WS_KCL - WS_KC) / 16;
#pragma unroll 2
            for (int tile = w; tile < ntile; tile += NWAVES) {
                const u32x4 ha = __builtin_nontemporal_load(kc + (size_t)(tile * 64 + lane) * 2), hb = __builtin_nontemporal_load(kc + (size_t)(tile * 64 + lane) * 2 + 1);
                const u32x4 la = __builtin_nontemporal_load(kcl + (size_t)(tile * 64 + lane) * 2), lb = __builtin_nontemporal_load(kcl + (size_t)(tile * 64 + lane) * 2 + 1);
                const unsigned hw[8] = {ha.x, ha.y, ha.z, ha.w, hb.x, hb.y, hb.z, hb.w}, lw[8] = {la.x, la.y, la.z, la.w, lb.x, lb.y, lb.z, lb.w};
                unsigned gw = 0u, ew = 0u;
#pragma unroll
                for (int r = 0; r < 16; ++r) { const int pos = (r & 3) + 8 * (r >> 2) + 4 * hf;
                    const unsigned hi = (r & 1) ? (hw[r >> 1] >> 16) : (hw[r >> 1] & 0xffffu);
                    gw |= (hi > p16) ? (1u << pos) : 0u; const bool m = (hi == p16); ew |= m ? (1u << pos) : 0u;
                    if (__any(m)) { if (m) { const unsigned low = (r & 1) ? (lw[r >> 1] >> 16) : (lw[r >> 1] & 0xffffu);
                        const unsigned slot = __hip_atomic_fetch_add(&cnt[q], 1u, __ATOMIC_RELAXED, __HIP_MEMORY_SCOPE_WORKGROUP);
                        if (slot < (unsigned)LCAP) list[q * LCAP + slot] = 0x10000000u | (low << 12) | (unsigned)(4095 - (tile * 32 + pos));
                        __hip_atomic_fetch_min(&cnt[32 + q], low, __ATOMIC_RELAXED, __HIP_MEMORY_SCOPE_WORKGROUP);
                        __hip_atomic_fetch_max(&cnt[64 + q], low, __ATOMIC_RELAXED, __HIP_MEMORY_SCOPE_WORKGROUP); } } }
                gw |= __shfl_xor(gw, 32); ew |= __shfl_xor(ew, 32);
                if (hf == 0) { gt[q * 128 + tile] = gw; eq[q * 128 + tile] = ew; }
            }
        }
        __syncthreads();
        {
            const int g = lane >> 4, li = lane & 15, qq = 4 * w + g; const int need = (int)qst[32 + qq]; const int n = (int)cnt[qq];
            if (n <= LCAP) {
                unsigned c[4]; int rank[4];
#pragma unroll
                for (int k = 0; k < 4; ++k) { const int idx = li + 16 * k; c[k] = (idx < n) ? list[qq * LCAP + idx] : 0u; rank[k] = 0; }
                for (int j = 0; j < n; ++j) { const unsigned e = list[qq * LCAP + j];
#pragma unroll
                    for (int k = 0; k < 4; ++k) rank[k] += (e > c[k]) ? 1 : 0; }
#pragma unroll
                for (int k = 0; k < 4; ++k) if (c[k] != 0u && rank[k] < need) { const int sp = 4095 - (int)(c[k] & 4095u);
                    __hip_atomic_fetch_or(&gt[qq * 128 + (sp >> 5)], 1u << (sp & 31), __ATOMIC_RELAXED, __HIP_MEMORY_SCOPE_WORKGROUP); }
            } else if (cnt[32 + qq] == cnt[64 + qq]) {
                tie_fixup(gt, eq, qq, li, need);
            } else if (li == 0) cnt[96] = 1u;
        }
        __syncthreads();
        if (cnt[96] != 0u) {
            DSA_PRELOAD();
            radix_pass<2>(L, lane, w, q, hf, qt, ntile, kbase, bq, wq, k0, k1, kc);
            radix_pass<3>(L, lane, w, q, hf, qt, ntile, kbase, bq, wq, k0, k1, kc);
            const unsigned prefix = qst[q];
            for (int tile = w; tile < ntile; tile += NWAVES) {
                bf16x8 ka[4]; DSA_LOADK(ka, tile);
                float sc[16]; idx_scores(ka, bq, wq, sc);
                DSA_DIAG_MASK()
                unsigned gw = 0u, ew = 0u;
#pragma unroll
                for (int r = 0; r < 16; ++r) { const int pos = (r & 3) + 8 * (r >> 2) + 4 * hf; const unsigned key = fkey(sc[r]);
                    gw |= (key > prefix) ? (1u << pos) : 0u; ew |= (key == prefix) ? (1u << pos) : 0u; }
                gw |= __shfl_xor(gw, 32); ew |= __shfl_xor(ew, 32);
                if (hf == 0) { gt[q * 128 + tile] = gw; eq[q * 128 + tile] = ew; }
            }
            __syncthreads();
            tie_fixup(gt, eq, 4 * w + (lane >> 4), lane & 15, (int)qst[32 + 4 * w + (lane >> 4)]);
        }
    } else {
        for (int tile = w; tile < ntile; tile += NWAVES) { unsigned gw = 0u; const bool diag = (tile == qt);
#pragma unroll
            for (int r = 0; r < 16; ++r) { const int pos = (r & 3) + 8 * (r >> 2) + 4 * hf; if (!diag || (pos <= q)) gw |= 1u << pos; }
            gw |= __shfl_xor(gw, 32);
            if (hf == 0) gt[q * 128 + tile] = gw; }
    }
    __syncthreads();
    {
        const int a = w;
        bf16x8 bqa[4];
#pragma unroll
        for (int kk = 0; kk < 4; ++kk) bqa[kk] = *(const bf16x8*)(qrow + O_AQ + a * 64 + kk * 16 + hf * 8);
        f32x16 o0, o1;
#pragma unroll
        for (int r = 0; r < 16; ++r) { o0[r] = 0.f; o1[r] = 0.f; }
        float mrun = 0.f;
        f32x4 lacc = {0.f, 0.f, 0.f, 0.f};
        u32x4 onesw; onesw.x = onesw.y = onesw.z = onesw.w = ((lane & 15) == ((lane >> 4) & 1)) ? 0x3F803F80u : 0u;
        const bf16x8 onesA = __builtin_bit_cast(bf16x8, onesw);
#define DSA_EMASK(c, buf) do { const int mw_ = (int)(gt[q * 128 + 4 * (c) + (w >> 1)] >> (4 * hf + 16 * (w & 1))); u32x4 em_; \
            em_.x = __builtin_amdgcn_perm((unsigned)__builtin_amdgcn_sbfe(mw_, 1, 1), (unsigned)__builtin_amdgcn_sbfe(mw_, 0, 1), 0x07060100u); \
            em_.y = __builtin_amdgcn_perm((unsigned)__builtin_amdgcn_sbfe(mw_, 3, 1), (unsigned)__builtin_amdgcn_sbfe(mw_, 2, 1), 0x07060100u); \
            em_.z = __builtin_amdgcn_perm((unsigned)__builtin_amdgcn_sbfe(mw_, 9, 1), (unsigned)__builtin_amdgcn_sbfe(mw_, 8, 1), 0x07060100u); \
            em_.w = __builtin_amdgcn_perm((unsigned)__builtin_amdgcn_sbfe(mw_, 11, 1), (unsigned)__builtin_amdgcn_sbfe(mw_, 10, 1), 0x07060100u); \
            *(LAS u32x4*)(L + EMK + (buf) * EMKB + (w * 64 + lane) * 16) = em_; } while (0)
        const int nch = (ntile + 3) >> 2;
        const int kr0 = tid >> 3, ks0 = tid & 7;
        u32x4 rkA[2], rvA[2], rkB[2], rvB[2];
#define DSA_ISSUE(c, RK, RV) do { _Pragma("unroll") for (int i = 0; i < 2; ++i) { const bf16_t* rp_ = kbase + (size_t)((c) * 128 + kr0 + 64 * i) * LDS_ + ks0 * 8; \
            RK[i] = *(const u32x4*)(rp_ + (O_AK - O_SIDE)); RV[i] = *(const u32x4*)(rp_ + (O_AV - O_SIDE)); } } while (0)
#define DSA_WRITE(buf, RK, RV) do { _Pragma("unroll") for (int i = 0; i < 2; ++i) { \
            *(LAS u32x4*)(L + KST + (buf) * KBUF + (kr0 + 64 * i) * 144 + ks0 * 16) = RK[i]; \
            *(LAS u32x4*)(L + VST + (buf) * KBUF + (kr0 + 64 * i) * 144 + ks0 * 16) = RV[i]; } } while (0)
        const int g16 = lane >> 4, li = lane & 15;
        const int vtoff = (4 * hf + (li >> 2)) * 144 + (16 * (g16 & 1) + 4 * (li & 3)) * 2;
#ifndef ATTN_REPS
#define ATTN_REPS 1
#endif
#pragma unroll 1
        for (int rep = 0; rep < ATTN_REPS; ++rep) {
        if (ATTN_REPS > 1) { mrun = 0.f; lacc[0] = lacc[1] = lacc[2] = lacc[3] = 0.f;
#pragma unroll
            for (int r = 0; r < 16; ++r) { o0[r] = 0.f; o1[r] = 0.f; } }
        DSA_ISSUE(0, rkA, rvA); DSA_ISSUE(min(1, nch - 1), rkB, rvB);
        DSA_WRITE(0, rkA, rvA); DSA_EMASK(0, 0);
        __syncthreads();
        asm volatile("" :: "v"(bqa[0]), "v"(bqa[1]), "v"(bqa[2]), "v"(bqa[3]));
        f32x16 nmv;
#pragma unroll
        for (int r = 0; r < 16; ++r) nmv[r] = -mrun;
#define DSA_KREAD(dst, tt_) do { const LAS unsigned char* kp_ = L + KST + buf * KBUF + (32 * (tt_) + q) * 144 + 16 * hf; \
            _Pragma("unroll") for (int kk = 0; kk < 4; ++kk) dst[kk] = *(const LAS bf16x8*)(kp_ + 32 * kk); } while (0)
#define DSA_STEP(tt, CUR, NXT, KFN, HASN) do { \
            s16x4 vlo[2][2], vhi[2][2]; \
            _Pragma("unroll") for (int ks = 0; ks < 2; ++ks) \
            _Pragma("unroll") for (int dt = 0; dt < 2; ++dt) { const LAS unsigned char* vp = L + VST + buf * KBUF + (32 * (tt) + 16 * ks) * 144 + 64 * dt + vtoff; \
                vlo[ks][dt] = __builtin_amdgcn_ds_read_tr16_b64_v4i16((LAS s16x4*)vp); vhi[ks][dt] = __builtin_amdgcn_ds_read_tr16_b64_v4i16((LAS s16x4*)(vp + 8 * 144)); } \
            u32x4 em[2]; \
            _Pragma("unroll") for (int ks = 0; ks < 2; ++ks) em[ks] = *(const LAS u32x4*)(L + EMK + buf * EMKB + ((2 * (tt) + ks) * 64 + lane) * 16); \
            float mx = CUR[0]; \
            _Pragma("unroll") for (int r = 1; r < 16; ++r) mx = fmaxf(mx, CUR[r]); \
            { const auto rr = __builtin_amdgcn_permlane32_swap(__float_as_uint(mx), __float_as_uint(mx), false, false); mx = fmaxf(__uint_as_float(rr[0]), __uint_as_float(rr[1])); } \
            const bool first = (c == 0) && ((tt) == 0); \
            if (first || __any(mx > 8.0f)) {              \
                const float d = first ? mx : fmaxf(mx, 0.f), alpha = first ? 1.0f : __builtin_amdgcn_exp2f(-d); mrun += d; \
                lacc[0] *= __shfl(alpha, lane & 15); lacc[1] *= __shfl(alpha, (lane & 15) + 16); \
                _Pragma("unroll") for (int r = 0; r < 16; ++r) { o0[r] *= alpha; o1[r] *= alpha; CUR[r] -= d; nmv[r] = -mrun; } } \
            __builtin_amdgcn_sched_barrier(0); \
            float p[16]; \
            _Pragma("unroll") for (int g = 0; g < 4; ++g) { \
                if (HASN) NXT = mfma32(KFN[g], bqa[g], (g == 0) ? nmv : NXT); \
                _Pragma("unroll") for (int r = 4 * g; r < 4 * g + 4; ++r) p[r] = __builtin_amdgcn_exp2f(CUR[r]); \
                __builtin_amdgcn_sched_barrier(0); } \
            _Pragma("unroll") for (int ks = 0; ks < 2; ++ks) { \
                u32x4 pw; pw.x = pk2(p[8 * ks], p[8 * ks + 1]) & em[ks].x; pw.y = pk2(p[8 * ks + 2], p[8 * ks + 3]) & em[ks].y; pw.z = pk2(p[8 * ks + 4], p[8 * ks + 5]) & em[ks].z; pw.w = pk2(p[8 * ks + 6], p[8 * ks + 7]) & em[ks].w; \
                const bf16x8 pb = __builtin_bit_cast(bf16x8, pw); \
                o0 = mfma32(__builtin_shufflevector(vlo[ks][0], vhi[ks][0], 0, 1, 2, 3, 4, 5, 6, 7), pb, o0); \
                o1 = mfma32(__builtin_shufflevector(vlo[ks][1], vhi[ks][1], 0, 1, 2, 3, 4, 5, 6, 7), pb, o1); \
                lacc = __builtin_amdgcn_mfma_f32_16x16x32_bf16(onesA, pb, lacc, 0, 0, 0); } \
        } while (0)
#define DSA_CHUNK(RKY, RVY, RKX, RVX) do { \
            const int buf = c & 1; \
            DSA_ISSUE(min(c + 2, nch - 1), RKY, RVY);         \
            bf16x8 kfa[4], kfb[4]; f32x16 sA, sB; \
            DSA_KREAD(kfa, 0); DSA_KREAD(kfb, 1); __builtin_amdgcn_sched_barrier(0); \
            _Pragma("unroll") for (int kk = 0; kk < 4; ++kk) sA = mfma32(kfa[kk], bqa[kk], (kk == 0) ? nmv : sA); \
            DSA_KREAD(kfa, 2); __builtin_amdgcn_sched_barrier(0); \
            DSA_STEP(0, sA, sB, kfb, true); \
            DSA_KREAD(kfb, 3); __builtin_amdgcn_sched_barrier(0); \
            DSA_STEP(1, sB, sA, kfa, true); \
            DSA_STEP(2, sA, sB, kfb, true); \
            DSA_STEP(3, sB, sA, kfa, false); \
            if (c + 1 < nch) { DSA_WRITE(buf ^ 1, RKX, RVX); DSA_EMASK(c + 1, buf ^ 1); } \
            __syncthreads(); } while (0)
#pragma unroll 1
        for (int c = 0; c < nch; ++c) {
            DSA_CHUNK(rkA, rvA, rkB, rvB);
            if (++c >= nch) break;
            DSA_CHUNK(rkB, rvB, rkA, rvA);
        }
        }
#undef DSA_CHUNK
#undef DSA_EMASK
#undef DSA_STEP
#undef DSA_KREAD
        const float l0 = __shfl(lacc[0], lane & 15), l1 = __shfl(lacc[1], lane & 15);
        const float lt = (lane & 16) ? l1 : l0, inv = 1.0f / lt;
#pragma unroll
        for (int g = 0; g < 4; ++g) {
            u32x2 w0, w1; w0.x = pk2(o0[4 * g] * inv, o0[4 * g + 1] * inv); w0.y = pk2(o0[4 * g + 2] * inv, o0[4 * g + 3] * inv);
            w1.x = pk2(o1[4 * g] * inv, o1[4 * g + 1] * inv); w1.y = pk2(o1[4 * g + 2] * inv, o1[4 * g + 3] * inv);
            if (!dry) { *(u32x2*)(qrow + O_AQ + a * 64 + 8 * g + 4 * hf) = w0; *(u32x2*)(qrow + O_AQ + a * 64 + 32 + 8 * g + 4 * hf) = w1; } }
    }
    __syncthreads();
}
}

#ifdef NO_ML
#define ML_CALL(x)
#else
#define ML_CALL(x) x
#endif
#ifdef NO_DSA
#define DSA_CALL(x)
#else
#define DSA_CALL(x) x
#endif
#if defined(NO_GEMM)
#define GEMM_CALL(k, x)
#elif defined(ONLY_GEMM)
#define GEMM_CALL(k, x) do { if ((k) == ONLY_GEMM) { x; } } while (0)
#else
#define GEMM_CALL(k, x) x
#endif
#ifndef PROBE_MIX
#define PROBE_MIX 0
#endif
constexpr int PH_PER_LAYER = 20, N_PHASES = DEPTH * PH_PER_LAYER + 1;
__global__ void __launch_bounds__(NTHR, 2) mk_fwd(Args Aval) {
    extern __shared__ __attribute__((aligned(16))) unsigned char lds_raw[];
    Ctx C;
    C.lds = (LAS unsigned char*)lds_raw;
    C.G = gridDim.x; C.bid = blockIdx.x;
    volatile LAS unsigned* MISC = (volatile LAS unsigned*)(C.lds + MISC_OFF);
    for (int u = threadIdx.x; u < (LDS_BYTES - LDSCTL_OFF) / 4; u += NTHR) ((LAS unsigned*)(C.lds + LDSCTL_OFF))[u] = 0u;
    __syncthreads();
    unsigned* barw = (unsigned*)(Aval.ws + WS_CTL) + CW_BAR;
    XcdBarrier bar; bar.bar = barw; bar.x = 0; bar.st = nullptr;
    const int lo = Aval.ph_lo, hi = Aval.ph_hi;
    if ((hi - lo) > 1) bar = xcd_barrier_post(barw, MISC + 8);
#define IN(k) (lo <= (k) && (k) < hi)
#define SEAM(k) do { if (IN((k) + 1)) xcd_barrier(bar); } while (0)
#pragma unroll 1
    for (int l = 0; l < DEPTH; ++l) {
        const int P0 = l * PH_PER_LAYER;
        if (IN(P0 + 0)) { phase_convert(C, l); phase_pb(C, l); if (l == 0) phase_init_rows(C); SEAM(P0 + 0); }
        if (IN(P0 + 1)) {
            ArgsP A = args_ptr(); bf16_t* const W = WSP(bf16_t, WS_W); pg8::Gemm g{WSP(bf16_t, WS_XB), W + W_GU1, DM, MTOK, 2 * DFF, DM}; pg8::StaticOrder S; S.init(MTOK, 2 * DFF, C.G, C.bid);
            pg8::EpiSwiglu E{WSP(bf16_t, WS_HID), WSP(float, WS_SS0)}; GEMM_CALL(0, pg8::gemm_phase(C.lds, g, S, E)); SEAM(P0 + 1); }
        if (IN(P0 + 2)) {
            ArgsP A = args_ptr(); bf16_t* const W = WSP(bf16_t, WS_W); pg8::Gemm g{WSP(bf16_t, WS_HID), W + W_DN1, DFF, MTOK, DM, DFF}; pg8::StaticOrder S; S.init(MTOK, DM, C.G, C.bid);
            pg8::EpiResid E{(l == 0) ? A->in[0] : A->out, A->out, WSP(bf16_t, WS_XB), 0.5f, WSP(float, WS_SS1), (LAS float*)(C.lds + LDS_SSQ)}; GEMM_CALL(1, pg8::gemm_phase(C.lds, g, S, E)); SEAM(P0 + 2); }
#pragma unroll 1
        for (int gi = 0; gi < NGRP; ++gi) {
            const int PG = P0 + 4 + 5 * gi; const size_t r0 = (size_t)gi * MG;
            if (IN(PG + 0)) {
                ArgsP A = args_ptr(); bf16_t* const W = WSP(bf16_t, WS_W); pg8::Gemm g{WSP(bf16_t, WS_XB) + r0 * DM, W + W_IN, DM, MG, LDP, DM}; pg8::StaticOrder S; S.init(MG, LDP, C.G, C.bid);
                pg8::EpiProj E{WSP(bf16_t, WS_PROJ), WSP(float, WS_SS1) + r0 * 4, WSP(bf16_t, WS_SIDE)}; GEMM_CALL(2, pg8::gemm_phase(C.lds, g, S, E)); SEAM(PG + 0); }
            if (IN(PG + 1)) {
                constexpr int NMLB = 16, NDSAB = 128, NCVB = 32, NITEMB = NMLB + NDSAB + NCVB;
                unsigned* qbase = (unsigned*)(Aval.ws + WS_CTL) + CW_Q + 64 * (8 * (2 * l + gi));
                const int xq = (int)(xb_xcc_id() & 7u);
                for (int hop = 0; hop < GB; ++hop) {
                    const int bq_ = (xq + hop) & (GB - 1);
                    unsigned* qhead = qbase + 64 * bq_;
                    for (;;) {
                        __syncthreads();
                        if (threadIdx.x == 0) MISC[16] = __hip_atomic_fetch_add(qhead, 1u, __ATOMIC_RELAXED, __HIP_MEMORY_SCOPE_AGENT);
                        __syncthreads();
                        const int item = (int)MISC[16];
                        if (item >= NITEMB) break;
                        if (item < NMLB) { ML_CALL(ml::unit(C, l, bq_ * 16 + item, 0)); }
                        else if (item < NMLB + NDSAB) { DSA_CALL(dsa::unit(C, bq_, 127 - (item - NMLB), 0)); }
                        else prep_conv(C, l, bq_, item - NMLB - NDSAB, NCVB, 0);
                    }
                }
                SEAM(PG + 1); }
            if (IN(PG + 2)) { prep_gate(C, l, C.bid, C.G); SEAM(PG + 2); }
            if (IN(PG + 3)) {
                ArgsP A = args_ptr(); bf16_t* const W = WSP(bf16_t, WS_W); bf16_t* PROJ = WSP(bf16_t, WS_PROJ);
                pg8::Gemm g{PROJ + O_CB, W + W_MRG, LDP, MG, DM, 2 * DM}; pg8::StaticOrder S; S.init(MG, DM, C.G, C.bid);
                pg8::EpiMerge E{WSP(bf16_t, WS_GCAT), PROJ + O_G + 2 * DM}; pg8::MergeHook H{PROJ + O_G};
                GEMM_CALL(3, (pg8::gemm_phase<pg8::EpiMerge, pg8::MergeHook>(C.lds, g, S, E, H)));
                SEAM(PG + 3); }
            if (IN(PG + 4)) {
                ArgsP A = args_ptr(); bf16_t* const W = WSP(bf16_t, WS_W); pg8::Gemm g{WSP(bf16_t, WS_GCAT), W + W_O, DM, MG, DM, DM}; pg8::StaticOrder S; S.init(MG, DM, C.G, C.bid);
                pg8::EpiResid E{A->out + r0 * DM, A->out + r0 * DM, WSP(bf16_t, WS_XB) + r0 * DM, 1.0f, WSP(float, WS_SS0) + r0 * 4, (LAS float*)(C.lds + LDS_SSQ)}; GEMM_CALL(6, pg8::gemm_phase(C.lds, g, S, E)); SEAM(PG + 4); }
        }
        if (IN(P0 + 15)) {
            ArgsP A = args_ptr(); bf16_t* const W = WSP(bf16_t, WS_W); pg8::Gemm g{WSP(bf16_t, WS_XB), W + W_GU2, DM, MTOK, 2 * DFF, DM}; pg8::StaticOrder S; S.init(MTOK, 2 * DFF, C.G, C.bid);
            pg8::EpiSwiglu E{WSP(bf16_t, WS_HID), WSP(float, WS_SS0)}; GEMM_CALL(7, pg8::gemm_phase(C.lds, g, S, E)); SEAM(P0 + 15); }
        if (IN(P0 + 16)) {
            ArgsP A = args_ptr(); bf16_t* const W = WSP(bf16_t, WS_W); pg8::Gemm g{WSP(bf16_t, WS_HID), W + W_DN2, DFF, MTOK, DM, DFF}; pg8::StaticOrder S; S.init(MTOK, DM, C.G, C.bid);
            pg8::EpiResid E{A->out, A->out, WSP(bf16_t, WS_XB), 0.5f, WSP(float, WS_SS1), (LAS float*)(C.lds + LDS_SSQ)}; GEMM_CALL(8, pg8::gemm_phase(C.lds, g, S, E)); SEAM(P0 + 16); }
        if (IN(P0 + 18)) {
            ArgsP A = args_ptr(); bf16_t* const W = WSP(bf16_t, WS_W); pg8::Gemm g{WSP(bf16_t, WS_PB), W + W_PP, DPLE, MTOK, DM, DPLE}; pg8::StaticOrder S; S.init(MTOK, DM, C.G, C.bid);
            pg8::EpiBf16 E{WSP(bf16_t, WS_PP), DM, nullptr}; GEMM_CALL(9, pg8::gemm_phase(C.lds, g, S, E)); SEAM(P0 + 18); }
        if (IN(P0 + 19)) {
            ArgsP A = args_ptr(); bf16_t* const W = WSP(bf16_t, WS_W); pg8::Gemm g{WSP(bf16_t, WS_XB), W + W_PG, DM, MTOK, DM, DM}; pg8::StaticOrder S; S.init(MTOK, DM, C.G, C.bid);
            pg8::EpiPle E{A->out, WSP(bf16_t, WS_XB), WSP(bf16_t, WS_PP), WSP(float, WS_SS1), WSP(float, WS_SS0), (LAS float*)(C.lds + LDS_SSQ), (l + 1 < DEPTH) ? 1 : 0}; GEMM_CALL(10, pg8::gemm_phase(C.lds, g, S, E)); SEAM(P0 + 19); }
    }
    if (IN(N_PHASES - 1)) phase_final(C);
#undef IN
#undef SEAM
}

extern "C" void kernel_launch(void* const* d_in, const int* in_sizes, int n_in, void* d_out, int out_size, void* d_ws, size_t ws_size, hipStream_t stream) {
    static int grid = 0;
    if (grid == 0) {
        if (n_in != 22 || out_size != MTOK * DM || ws_size < WS_END) { fprintf(stderr, "kernel_launch: unexpected shapes (n_in %d out %d ws %zu, need %zu)\n", n_in, out_size, ws_size, (size_t)WS_END); grid = -1; return; }
        int dev = 0, cus = 0, per_cu = 0;
        if (hipGetDevice(&dev) != hipSuccess || hipDeviceGetAttribute(&cus, hipDeviceAttributeMultiprocessorCount, dev) != hipSuccess) { grid = -1; return; }
        if (hipFuncSetAttribute((const void*)mk_fwd, hipFuncAttributeMaxDynamicSharedMemorySize, LDS_BYTES) != hipSuccess) { fprintf(stderr, "kernel_launch: hipFuncSetAttribute failed\n"); grid = -1; return; }
        if (hipOccupancyMaxActiveBlocksPerMultiprocessor(&per_cu, (const void*)mk_fwd, NTHR, LDS_BYTES) != hipSuccess || per_cu < 1) { fprintf(stderr, "kernel_launch: occupancy query says %d\n", per_cu); (void)hipGetLastError(); grid = -1; return; }
        grid = cus;
    }
    if (grid < 0) return;
    if (hipMemsetAsync((char*)d_ws + WS_CTL, 0, CTL_ZERO_BYTES, stream) != hipSuccess) return;
    Args a{};
    for (int i = 0; i < 22; ++i) a.in[i] = (const float*)d_in[i];
    a.out = (float*)d_out; a.ws = (unsigned char*)d_ws;
#if MK_N_LAUNCHES == 1
    a.ph_lo = 0; a.ph_hi = N_PHASES;
    hipLaunchKernelGGL(mk_fwd, dim3(grid), dim3(NTHR), LDS_BYTES, stream, a);
#else
    for (int p = 0; p < N_PHASES; ++p) { a.ph_lo = p; a.ph_hi = p + 1; hipLaunchKernelGGL(mk_fwd, dim3(grid), dim3(NTHR), LDS_BYTES, stream, a); }
#endif
}
```

```cpp
#include <hip/hip_runtime.h>
#include <cstdio>
#include <cstdint>

#ifndef MK_N_LAUNCHES
#define MK_N_LAUNCHES 1
#endif

constexpr int BATCH = 16, SEQ = 4096, DM = 1024, DEPTH = 2, DPLE = 256, DFF = 2816, DCONV = 512;
constexpr int MTOK = BATCH * SEQ;
constexpr int NGRP = 2, GB = BATCH / NGRP, MG = GB * SEQ;
constexpr int LDP = 8704;
constexpr int O_CC = 0, O_CX = 512, O_MQ = 1024, O_MK = 1536, O_MV = 2048, O_CB = 3072, O_MO = 3584, O_AQ = 4608, O_G = 5120, O_AK = 8192, O_AV = 8256,
              O_IQ = 8320, O_IK = 8576, O_MI = 8640, O_MF = 8644, O_IW = 8648;
constexpr int LDS_ = 512, O_SIDE = 8192;
constexpr float EPS = 1e-6f;

constexpr size_t W_GU1 = 0, W_DN1 = W_GU1 + (size_t)5632 * 1024, W_IN = W_DN1 + (size_t)1024 * 2816, W_MRG = W_IN + (size_t)LDP * 1024,
                 W_O = W_MRG + (size_t)1024 * 2048, W_GU2 = W_O + (size_t)1024 * 1024,
                 W_DN2 = W_GU2 + (size_t)5632 * 1024, W_PG = W_DN2 + (size_t)1024 * 2816, W_PP = W_PG + (size_t)1024 * 1024, W_END = W_PP + (size_t)1024 * 256;

constexpr size_t MiB = 1u << 20;
constexpr size_t WS_CTL = 0, CTL_ZERO_BYTES = 64 * 1024;
constexpr size_t WS_W = 1 * MiB;
constexpr size_t WS_XB = 65 * MiB;
constexpr size_t WS_SS0 = 193 * MiB, WS_SS1 = 194 * MiB;
constexpr size_t WS_SCR = 198 * MiB;
constexpr size_t WS_BIG = 206 * MiB;
constexpr size_t WS_PROJ = WS_BIG;
constexpr size_t WS_GCAT = WS_BIG + 544 * MiB;
constexpr size_t WS_SIDE = WS_GCAT + 64 * MiB;
constexpr size_t WS_HID = WS_BIG;
constexpr size_t WS_PB = WS_BIG + 640 * MiB;
constexpr size_t WS_PP = WS_BIG + 384 * MiB;
constexpr size_t WS_KC = WS_BIG + 672 * MiB;
constexpr size_t WS_KCL = WS_BIG + 736 * MiB;
constexpr size_t WS_END = WS_BIG + 800 * MiB;
static_assert(W_END * 2 <= 64 * MiB, "weights fit");
constexpr int CW_BAR = 4096;
constexpr int CW_Q = 8192;

constexpr int RING_BYTES = 131072, LDSCTL_OFF = RING_BYTES, MISC_OFF = LDSCTL_OFF + 320, LDS_BYTES = 147456;
constexpr int NWAVES = 8, NTHR = 512;

#define GAS __attribute__((address_space(1)))
#define LAS __attribute__((address_space(3)))
typedef unsigned short bf16_t;
typedef short bf16x8 __attribute__((ext_vector_type(8)));
typedef short bf16x4 __attribute__((ext_vector_type(4)));
typedef float f32x4 __attribute__((ext_vector_type(4)));
typedef float f32x16 __attribute__((ext_vector_type(16)));
typedef unsigned u32x4 __attribute__((ext_vector_type(4)));
typedef unsigned u32x2 __attribute__((ext_vector_type(2)));
typedef __bf16 bf2_t __attribute__((ext_vector_type(2)));

__device__ __forceinline__ unsigned pk2(float lo, float hi) { bf2_t v = {(__bf16)lo, (__bf16)hi}; return __builtin_bit_cast(unsigned, v); }
__device__ __forceinline__ bf16_t f2bf(float x) { __bf16 v = (__bf16)x; return __builtin_bit_cast(bf16_t, v); }
__device__ __forceinline__ float bf2f(bf16_t b) { return __uint_as_float(((unsigned)b) << 16); }
__device__ __forceinline__ float bflo(unsigned w) { return __uint_as_float(w << 16); }
__device__ __forceinline__ float bfhi(unsigned w) { return __uint_as_float(w & 0xffff0000u); }
__device__ __forceinline__ float fsigmoid(float x) { return __builtin_amdgcn_rcpf(1.0f + __expf(-x)); }
__device__ __forceinline__ float rstd_from(const f32x4 p) { return __builtin_amdgcn_rsqf(((p[0] + p[1]) + (p[2] + p[3])) * (1.0f / DM) + EPS); }
__device__ __forceinline__ void rstd8(const float* ss, int row0, float mul, float (&rs)[8]) {
    f32x4 t[8];
#pragma unroll
    for (int i = 0; i < 8; ++i) t[i] = *(const f32x4*)(ss + (size_t)(row0 + (i >> 2) * 128 + (i & 3) * 16) * 4);
    asm volatile("" : "+v"(t[0]), "+v"(t[1]), "+v"(t[2]), "+v"(t[3]), "+v"(t[4]), "+v"(t[5]), "+v"(t[6]), "+v"(t[7]));
#pragma unroll
    for (int i = 0; i < 8; ++i) rs[i] = rstd_from(t[i]) * mul;
}
__device__ __forceinline__ float rstd_of(const float* ss4) { const f32x4 p = *(const f32x4*)ss4; return 1.0f / sqrtf(((p[0] + p[1]) + (p[2] + p[3])) * (1.0f / DM) + EPS); }
constexpr int LDS_SSQ = RING_BYTES + 1024;
__device__ __forceinline__ float wave_sum(float v) {
#pragma unroll
    for (int o = 1; o < 64; o <<= 1) v += __shfl_xor(v, o);
    return v;
}

namespace pg8 {
#ifndef PG8_ALIGN
#define PG8_ALIGN 1
#endif
constexpr bool ALIGN_EPI = PG8_ALIGN;
constexpr int BM = 256, BK = 64, HALF = 128, HTB = HALF * BK * 2, STAGE_BYTES = 8 * HTB, NXCD = 8, WGM = 8;
__host__ __device__ __forceinline__ int lds_byte(int r, int c) { const int st = (r >> 4) * 2 + (c >> 5), rr = r & 15, cc = c & 31, ob = rr * 64 + cc * 2; return st * 1024 + (ob ^ (((ob >> 9) & 1) << 5)); }
__host__ __device__ __forceinline__ void stage_rc(int b, int& R, int& C) { const int st = b / 1024, sb = b % 1024, swz = sb ^ (((sb >> 9) & 1) << 5); R = (st >> 1) * 16 + swz / 64; C = (st & 1) * 32 + (swz % 64) / 2; }
__host__ __device__ __forceinline__ int perm32(int rho) { const int n = rho >> 4, i = rho & 15; return 8 * (i >> 2) + 4 * n + (i & 3); }
struct Unit { int pm, pn; };
struct Gemm { const bf16_t* A; const bf16_t* Bt; int lda, M, N, K; };
struct StaticOrder {
    int nM, nN, nwg, G, c;
    __host__ __device__ void init(int M, int N, int G_, int c_) { nM = M / BM; nN = N / BM; nwg = nM * nN; G = G_; c = c_; }
    __host__ __device__ bool next(int i, Unit& u) const {
        const long L = (long)i * G + c; if (L >= nwg) return false;
        int wgid = (int)L; { const int q = nwg / NXCD, r = nwg % NXCD, xcd = wgid % NXCD, off = wgid / NXCD; wgid = (xcd < r ? xcd * (q + 1) : r * (q + 1) + (xcd - r) * q) + off; }
        const int nig = WGM * nN, gid = wgid / nig, fm = gid * WGM, gsz = (nM - fm) < WGM ? (nM - fm) : WGM;
        u.pm = fm + ((wgid % nig) % gsz); u.pn = (wgid % nig) / gsz; return true;
    }
};
typedef f32x4 Acc[2][2][4][2];

struct EpiSwiglu {
    bf16_t* H; const float* ss;
    __device__ __forceinline__ void operator()(const Acc& acc, const Unit& u, int wr, int wc, int fr, int fq) const {
        const int row0 = u.pm * BM + wr * 64 + fr, col0 = u.pn * 128 + wc * 32 + 8 * fq;
        float rs[8]; rstd8(ss, row0, 1.0f, rs);
#pragma unroll
        for (int ai = 0; ai < 2; ++ai)
#pragma unroll
            for (int m = 0; m < 4; ++m) { const int row = row0 + ai * HALF + m * 16; const float r = rs[ai * 4 + m];
                float h[8];
#pragma unroll
                for (int n = 0; n < 2; ++n)
#pragma unroll
                    for (int j = 0; j < 4; ++j) { const float g = acc[ai][0][m][n][j] * r, uu = acc[ai][1][m][n][j] * r; h[n * 4 + j] = g * fsigmoid(g) * uu; }
                u32x4 w; w.x = pk2(h[0], h[1]); w.y = pk2(h[2], h[3]); w.z = pk2(h[4], h[5]); w.w = pk2(h[6], h[7]);
                *(u32x4*)(H + (size_t)row * DFF + col0) = w; }
    }
};
struct EpiResid {
    const float* Xin; float* X; bf16_t* XB; float scale; float* SS; LAS float* lq;
    __device__ __forceinline__ void operator()(const Acc& acc, const Unit& u, int wr, int wc, int fr, int fq) const {
        const int row0 = u.pm * BM + wr * 64 + fr, col0 = u.pn * BM + wc * 32 + 8 * fq;
#pragma unroll
        for (int ai = 0; ai < 2; ++ai)
#pragma unroll
            for (int m = 0; m < 4; ++m) { const int row = row0 + ai * HALF + m * 16; const size_t off = (size_t)row * DM + col0; float sq = 0.f;
#pragma unroll
                for (int bj = 0; bj < 2; ++bj) { float* xp = X + off + bj * HALF; const float* xi = Xin + off + bj * HALF;
                    f32x4 a = *(const f32x4*)xi, b = *(const f32x4*)(xi + 4);
                    a = a + acc[ai][bj][m][0] * scale; b = b + acc[ai][bj][m][1] * scale;
                    *(f32x4*)xp = a; *(f32x4*)(xp + 4) = b;
                    sq += (a[0] * a[0] + a[1] * a[1]) + (a[2] * a[2] + a[3] * a[3]) + (b[0] * b[0] + b[1] * b[1]) + (b[2] * b[2] + b[3] * b[3]);
                    u32x4 w; w.x = pk2(a[0], a[1]); w.y = pk2(a[2], a[3]); w.z = pk2(b[0], b[1]); w.w = pk2(b[2], b[3]);
                    *(u32x4*)(XB + off + bj * HALF) = w; }
                sq += __shfl_xor(sq, 16); sq += __shfl_xor(sq, 32);
                if (fq == 0) lq[wc * 256 + (ai * HALF + wr * 64 + m * 16 + fr)] = sq;
                asm volatile("" ::: "memory"); }
        asm volatile("s_waitcnt lgkmcnt(0)" ::: "memory"); __builtin_amdgcn_s_barrier(); asm volatile("" ::: "memory");
        if (wr == 0) { const int rr = wc * 64 + fq * 16 + fr;
            SS[(size_t)(u.pm * BM + rr) * 4 + u.pn] = (lq[rr] + lq[256 + rr]) + (lq[512 + rr] + lq[768 + rr]); }
    }
};
struct EpiBf16 {
    bf16_t* O; int ldc; const float* rs;
    __device__ __forceinline__ void operator()(const Acc& acc, const Unit& u, int wr, int wc, int fr, int fq) const {
        const int row0 = u.pm * BM + wr * 64 + fr, col0 = u.pn * BM + wc * 32 + 8 * fq;
#pragma unroll
        for (int ai = 0; ai < 2; ++ai)
#pragma unroll
            for (int m = 0; m < 4; ++m) { const int row = row0 + ai * HALF + m * 16; const float r = rs ? rs[row] : 1.0f;
#pragma unroll
                for (int bj = 0; bj < 2; ++bj) { const f32x4 a = acc[ai][bj][m][0] * r, b = acc[ai][bj][m][1] * r;
                    u32x4 w; w.x = pk2(a[0], a[1]); w.y = pk2(a[2], a[3]); w.z = pk2(b[0], b[1]); w.w = pk2(b[2], b[3]);
                    *(u32x4*)(O + (size_t)row * ldc + col0 + bj * HALF) = w; } }
    }
};
constexpr float AQ_SCALE = 0.125f * 1.4426950408889634f;
struct EpiProj {
    bf16_t* O; const float* ss; bf16_t* SIDE;
    __device__ __forceinline__ void operator()(const Acc& acc, const Unit& u, int wr, int wc, int fr, int fq) const {
        const int row0 = u.pm * BM + wr * 64 + fr; int col0 = u.pn * BM + wc * 32 + 8 * fq;
        const bool sg = (u.pn >= O_G / BM) && (u.pn < O_AK / BM);
        const float qs = (u.pn >= O_AQ / BM && u.pn < O_G / BM) ? AQ_SCALE : 1.0f;
        bf16_t* base = O; int ldc = LDP;
        if (u.pn >= O_SIDE / BM) { base = SIDE; ldc = LDS_; col0 -= O_SIDE; }
        float rs[8]; rstd8(ss, row0, qs, rs);
#pragma unroll
        for (int ai = 0; ai < 2; ++ai)
#pragma unroll
            for (int m = 0; m < 4; ++m) { const int row = row0 + ai * HALF + m * 16; const float r = rs[ai * 4 + m];
#pragma unroll
                for (int bj = 0; bj < 2; ++bj) { f32x4 a = acc[ai][bj][m][0] * r, b = acc[ai][bj][m][1] * r;
                    if (sg) {
#pragma unroll
                        for (int j = 0; j < 4; ++j) { a[j] = fmaxf(fsigmoid(a[j]), 1e-10f); b[j] = fmaxf(fsigmoid(b[j]), 1e-10f); } }
                    u32x4 w; w.x = pk2(a[0], a[1]); w.y = pk2(a[2], a[3]); w.z = pk2(b[0], b[1]); w.w = pk2(b[2], b[3]);
                    *(u32x4*)(base + (size_t)row * ldc + col0 + bj * HALF) = w; } }
    }
};
struct MergeHook {
    static constexpr bool ON = true;
    const bf16_t* S;
    __device__ __forceinline__ void operator()(Acc& acc, const Unit& u, int t, int wr, int wc, int fr, int fq) const {
        if (t != 8 && t != 24) return;
        int row0 = u.pm * BM + wr * 64 + fr, col0 = u.pn * BM + wc * 32 + 8 * fq + ((t == 8) ? 0 : DM);
        asm volatile("" : "+v"(row0), "+v"(col0));
#pragma unroll
        for (int ai = 0; ai < 2; ++ai) {
            u32x4 nv[4][2], dv[4][2];
#pragma unroll
            for (int m = 0; m < 4; ++m)
#pragma unroll
                for (int bj = 0; bj < 2; ++bj) { const bf16_t* gp = S + (size_t)(row0 + ai * HALF + m * 16) * LDP + col0 + bj * HALF; nv[m][bj] = *(const u32x4*)gp; dv[m][bj] = *(const u32x4*)(gp + DM); }
            asm volatile("" : "+v"(nv[0][0]), "+v"(nv[0][1]), "+v"(nv[1][0]), "+v"(nv[1][1]), "+v"(nv[2][0]), "+v"(nv[2][1]), "+v"(nv[3][0]), "+v"(nv[3][1]),
                              "+v"(dv[0][0]), "+v"(dv[0][1]), "+v"(dv[1][0]), "+v"(dv[1][1]), "+v"(dv[2][0]), "+v"(dv[2][1]), "+v"(dv[3][0]), "+v"(dv[3][1]));
#pragma unroll
            for (int m = 0; m < 4; ++m)
#pragma unroll
                for (int bj = 0; bj < 2; ++bj) { const u32x4 n = nv[m][bj], d = dv[m][bj];
                    f32x4 ra, rb;
                    ra[0] = bflo(n.x) * __builtin_amdgcn_rcpf(bflo(d.x)); ra[1] = bfhi(n.x) * __builtin_amdgcn_rcpf(bfhi(d.x)); ra[2] = bflo(n.y) * __builtin_amdgcn_rcpf(bflo(d.y)); ra[3] = bfhi(n.y) * __builtin_amdgcn_rcpf(bfhi(d.y));
                    rb[0] = bflo(n.z) * __builtin_amdgcn_rcpf(bflo(d.z)); rb[1] = bfhi(n.z) * __builtin_amdgcn_rcpf(bfhi(d.z)); rb[2] = bflo(n.w) * __builtin_amdgcn_rcpf(bflo(d.w)); rb[3] = bfhi(n.w) * __builtin_amdgcn_rcpf(bfhi(d.w));
                    acc[ai][bj][m][0] *= ra; acc[ai][bj][m][1] *= rb; }
            asm volatile("" ::: "memory"); }
    }
};
struct NoHook { static constexpr bool ON = false; __device__ __forceinline__ void operator()(Acc&, const Unit&, int, int, int, int, int) const {} };
struct EpiMerge {
    bf16_t* O; const bf16_t* S2;
    __device__ __forceinline__ void operator()(const Acc& acc, const Unit& u, int wr, int wc, int fr, int fq) const {
        const int row0 = u.pm * BM + wr * 64 + fr, col0 = u.pn * BM + wc * 32 + 8 * fq;
#pragma unroll
        for (int ai = 0; ai < 2; ++ai) {
            u32x4 gv[4][2];
#pragma unroll
            for (int m = 0; m < 4; ++m)
#pragma unroll
                for (int bj = 0; bj < 2; ++bj) gv[m][bj] = *(const u32x4*)(S2 + (size_t)(row0 + ai * HALF + m * 16) * LDP + col0 + bj * HALF);
            asm volatile("" : "+v"(gv[0][0]), "+v"(gv[0][1]), "+v"(gv[1][0]), "+v"(gv[1][1]), "+v"(gv[2][0]), "+v"(gv[2][1]), "+v"(gv[3][0]), "+v"(gv[3][1]));
#pragma unroll
            for (int m = 0; m < 4; ++m) { const int row = row0 + ai * HALF + m * 16;
#pragma unroll
                for (int bj = 0; bj < 2; ++bj) { const u32x4 g = gv[m][bj];
                    const f32x4 a = acc[ai][bj][m][0], b = acc[ai][bj][m][1];
                    u32x4 w;
                    w.x = pk2(a[0] * bflo(g.x), a[1] * bfhi(g.x)); w.y = pk2(a[2] * bflo(g.y), a[3] * bfhi(g.y));
                    w.z = pk2(b[0] * bflo(g.z), b[1] * bfhi(g.z)); w.w = pk2(b[2] * bflo(g.w), b[3] * bfhi(g.w));
                    *(u32x4*)(O + (size_t)row * DM + col0 + bj * HALF) = w; } }
            asm volatile("" ::: "memory"); }
    }
};
struct EpiPle {
    float* X; bf16_t* XB; const bf16_t* PP; const float* ss; float* SSout; LAS float* lq; int wxb;
    __device__ __forceinline__ void operator()(const Acc& acc, const Unit& u, int wr, int wc, int fr, int fq) const {
        const int row0 = u.pm * BM + wr * 64 + fr, col0 = u.pn * BM + wc * 32 + 8 * fq;
#pragma unroll
        for (int ai = 0; ai < 2; ++ai)
#pragma unroll
            for (int m = 0; m < 4; ++m) { const int row = row0 + ai * HALF + m * 16; const float r = rstd_of(ss + (size_t)row * 4); const size_t off = (size_t)row * DM + col0; float sq = 0.f;
#pragma unroll
                for (int bj = 0; bj < 2; ++bj) { float* xp = X + off + bj * HALF;
                    f32x4 a = *(const f32x4*)xp, b = *(const f32x4*)(xp + 4); const u32x4 p = *(const u32x4*)(PP + off + bj * HALF);
                    const f32x4 ga = acc[ai][bj][m][0] * r, gb = acc[ai][bj][m][1] * r;
                    a[0] += fsigmoid(ga[0]) * bflo(p.x); a[1] += fsigmoid(ga[1]) * bfhi(p.x); a[2] += fsigmoid(ga[2]) * bflo(p.y); a[3] += fsigmoid(ga[3]) * bfhi(p.y);
                    b[0] += fsigmoid(gb[0]) * bflo(p.z); b[1] += fsigmoid(gb[1]) * bfhi(p.z); b[2] += fsigmoid(gb[2]) * bflo(p.w); b[3] += fsigmoid(gb[3]) * bfhi(p.w);
                    *(f32x4*)xp = a; *(f32x4*)(xp + 4) = b;
                    sq += (a[0] * a[0] + a[1] * a[1]) + (a[2] * a[2] + a[3] * a[3]) + (b[0] * b[0] + b[1] * b[1]) + (b[2] * b[2] + b[3] * b[3]);
                    u32x4 w; w.x = pk2(a[0], a[1]); w.y = pk2(a[2], a[3]); w.z = pk2(b[0], b[1]); w.w = pk2(b[2], b[3]);
                    if (wxb) *(u32x4*)(XB + off + bj * HALF) = w; }
                sq += __shfl_xor(sq, 16); sq += __shfl_xor(sq, 32);
                if (fq == 0) lq[wc * 256 + (ai * HALF + wr * 64 + m * 16 + fr)] = sq;
                asm volatile("" ::: "memory"); }
        asm volatile("s_waitcnt lgkmcnt(0)" ::: "memory"); __builtin_amdgcn_s_barrier(); asm volatile("" ::: "memory");
        if (wr == 0) { const int rr = wc * 64 + fq * 16 + fr;
            SSout[(size_t)(u.pm * BM + rr) * 4 + u.pn] = (lq[rr] + lq[256 + rr]) + (lq[512 + rr] + lq[768 + rr]); }
    }
};

template <class Epi, class Hook = NoHook>
__device__ __forceinline__ void gemm_phase(LAS unsigned char* lds, const Gemm g, const StaticOrder& S, const Epi& E, const Hook H = Hook()) {
    int tid = threadIdx.x; asm volatile("" : "+v"(tid));
    const int wid = __builtin_amdgcn_readfirstlane(tid >> 6), lane = tid & 63, wr = wid >> 2, wc = wid & 3, fr = lane & 15, fq = lane >> 4;
    const int K = g.K, nt = K / BK, lda = g.lda;
    unsigned voffA[2], voffB[2];
#pragma unroll
    for (int i = 0; i < 2; ++i) { int R, C; stage_rc(tid * 16 + i * 8192, R, C); const int Rb = (R & ~31) + perm32(R & 31);
        voffA[i] = (unsigned)(R * lda + C) * 2u; voffB[i] = (unsigned)(Rb * K + C) * 2u; }
    const size_t kstep = (size_t)(BK * 2);
    const size_t hstepA = (size_t)HALF * lda * 2, tstepA = 2 * hstepA;
    const size_t hstepB = (size_t)HALF * K * 2, tstepB = 2 * hstepB;
    const unsigned ldsw = (unsigned)wid * 1024u;
    const int aoff = lds_byte(wr * 64 + fr, fq * 8), boff = lds_byte(wc * 32 + fr, fq * 8);
#define PG8_SA(b, h) (((b) * 2 + (h)) * HTB)
#define PG8_SB(b, h) ((4 + (b) * 2 + (h)) * HTB)
#define PG8_STAGE(bufoff, gbase, voff) do { _Pragma("unroll") for (int _i = 0; _i < 2; ++_i) \
        __builtin_amdgcn_global_load_lds((const unsigned*)((const char*)(gbase) + (voff)[_i]), (LAS unsigned*)(lds + (bufoff) + ldsw + _i * 8192), 16, 0, 0); } while (0)
#define PG8_LDA(dst, b, h) do { _Pragma("unroll") for (int m = 0; m < 4; ++m) _Pragma("unroll") for (int k = 0; k < 2; ++k) dst[m][k] = *(const LAS bf16x8*)(lds + PG8_SA(b, h) + aoff + m * 2048 + k * 1024); } while (0)
#define PG8_LDB(dst, b, h) do { _Pragma("unroll") for (int n = 0; n < 2; ++n) _Pragma("unroll") for (int k = 0; k < 2; ++k) dst[n][k] = *(const LAS bf16x8*)(lds + PG8_SB(b, h) + boff + n * 2048 + k * 1024); } while (0)
#define PG8_MMA(ai, bj, At, Bt) do { __builtin_amdgcn_s_setprio(1); _Pragma("unroll") for (int m = 0; m < 4; ++m) _Pragma("unroll") for (int n = 0; n < 2; ++n) _Pragma("unroll") for (int k = 0; k < 2; ++k) \
        acc[ai][bj][m][n] = __builtin_amdgcn_mfma_f32_16x16x32_bf16(Bt[n][k], At[m][k], acc[ai][bj][m][n], 0, 0, 0); __builtin_amdgcn_s_setprio(0); } while (0)
#define PG8_WAIT_V(n) asm volatile("s_waitcnt vmcnt(" #n ")" ::: "memory")
#define PG8_WAIT_L(n) asm volatile("s_waitcnt lgkmcnt(" #n ")" ::: "memory")
#define PG8_BAR __builtin_amdgcn_s_barrier()
#define PG8_SCHED __builtin_amdgcn_sched_barrier(0)
    Unit cur, nxt; int ui = 0;
    if (!S.next(0, cur)) return;
    Acc acc;
#pragma unroll
    for (int a = 0; a < 2; ++a)
#pragma unroll
        for (int b = 0; b < 2; ++b)
#pragma unroll
            for (int m = 0; m < 4; ++m)
#pragma unroll
                for (int n = 0; n < 2; ++n) acc[a][b][m][n] = (f32x4){0.f, 0.f, 0.f, 0.f};
    bf16x8 At[4][2], B0[2][2], B1[2][2];
    const char* cA = (const char*)g.A + (size_t)cur.pm * tstepA; const char* cB = (const char*)g.Bt + (size_t)cur.pn * tstepB;
    PG8_STAGE(PG8_SB(0, 0), cB, voffB); PG8_STAGE(PG8_SB(0, 1), cB + hstepB, voffB); PG8_STAGE(PG8_SA(0, 0), cA, voffA); PG8_STAGE(PG8_SA(0, 1), cA + hstepA, voffA);
    if (wr == 1) PG8_BAR;
    PG8_WAIT_V(2); PG8_BAR;
    PG8_STAGE(PG8_SB(1, 0), cB + kstep, voffB); PG8_STAGE(PG8_SA(1, 0), cA + kstep, voffA); PG8_STAGE(PG8_SB(1, 1), cB + hstepB + kstep, voffB);
    PG8_WAIT_V(6); PG8_BAR;
    for (;;) {
        const bool has_next = S.next(ui + 1, nxt);
        const char* nA = has_next ? (const char*)g.A + (size_t)nxt.pm * tstepA : cA; const char* nB = has_next ? (const char*)g.Bt + (size_t)nxt.pn * tstepB : cB;
#pragma unroll 1
        for (int t = 0; t < nt; t += 2) {
            const bool last = (t == nt - 2);
            const char* a1 = cA + (size_t)(t + 1) * kstep;
            const char* a2 = last ? nA : cA + (size_t)(t + 2) * kstep; const char* b2 = last ? nB : cB + (size_t)(t + 2) * kstep;
            const char* a3 = a2 + kstep; const char* b3 = b2 + kstep;
            if constexpr (Hook::ON) H(acc, cur, t, wr, wc, fr, fq);
            PG8_LDB(B0, 0, 0); PG8_LDB(B1, 0, 1); PG8_SCHED; PG8_LDA(At, 0, 0); PG8_STAGE(PG8_SA(1, 1), a1 + hstepA, voffA);
            PG8_WAIT_V(8); PG8_WAIT_L(0); PG8_BAR; PG8_MMA(0, 0, At, B0); PG8_MMA(0, 1, At, B1); PG8_BAR; PG8_SCHED;
            PG8_LDA(At, 0, 1); PG8_STAGE(PG8_SB(0, 0), b2, voffB); PG8_STAGE(PG8_SB(0, 1), b2 + hstepB, voffB); PG8_STAGE(PG8_SA(0, 0), a2, voffA);
            PG8_WAIT_V(8); PG8_WAIT_L(0); PG8_BAR; PG8_MMA(1, 0, At, B0); PG8_MMA(1, 1, At, B1); PG8_BAR; PG8_SCHED;
            PG8_LDB(B0, 1, 0); PG8_LDB(B1, 1, 1); PG8_SCHED; PG8_LDA(At, 1, 0); PG8_STAGE(PG8_SA(0, 1), a2 + hstepA, voffA);
            PG8_WAIT_V(8); PG8_WAIT_L(0); PG8_BAR; PG8_MMA(0, 0, At, B0); PG8_MMA(0, 1, At, B1); PG8_BAR; PG8_SCHED;
            PG8_LDA(At, 1, 1); PG8_STAGE(PG8_SB(1, 0), b3, voffB); PG8_STAGE(PG8_SB(1, 1), b3 + hstepB, voffB); PG8_STAGE(PG8_SA(1, 0), a3, voffA);
            PG8_WAIT_V(8); PG8_WAIT_L(0); PG8_BAR; PG8_MMA(1, 0, At, B0); PG8_MMA(1, 1, At, B1); PG8_BAR; PG8_SCHED;
        }
        if (ALIGN_EPI) { if (wr == 0) PG8_BAR; }
        E(acc, cur, wr, wc, fr, fq);
        if (!has_next) break;
#pragma unroll
        for (int a = 0; a < 2; ++a)
#pragma unroll
            for (int b = 0; b < 2; ++b)
#pragma unroll
                for (int m = 0; m < 4; ++m)
#pragma unroll
                    for (int n = 0; n < 2; ++n) acc[a][b][m][n] = (f32x4){0.f, 0.f, 0.f, 0.f};
        cur = nxt; cA = nA; cB = nB; ++ui;
        if (ALIGN_EPI) { if (wr == 1) PG8_BAR; }
    }
    PG8_WAIT_V(0);
    if (!ALIGN_EPI) { if (wr == 0) PG8_BAR; }
    PG8_BAR;
#undef PG8_SA
#undef PG8_SB
#undef PG8_STAGE
#undef PG8_LDA
#undef PG8_LDB
#undef PG8_MMA
#undef PG8_WAIT_V
#undef PG8_WAIT_L
#undef PG8_BAR
#undef PG8_SCHED
}
}

#define XB_TMO      128
#define XB_XCNT(j)  (256  + 64 * (j))
#define XB_XSUB(j)  (1280 + 64 * (j))
#define XB_XGEN(j)  (2304 + 64 * (j))
#define XB_TOP      3328
#define XB_TOPGEN   3392
#define XCD_BAR_WORDS 3456
#define XB_SPIN_CAP (1u << 18)
__device__ __forceinline__ unsigned xb_ld(unsigned* p)              { return __hip_atomic_load(p, __ATOMIC_RELAXED, __HIP_MEMORY_SCOPE_AGENT); }
__device__ __forceinline__ unsigned xb_add(unsigned* p, unsigned v) { return __hip_atomic_fetch_add(p, v, __ATOMIC_RELAXED, __HIP_MEMORY_SCOPE_AGENT); }
__device__ __forceinline__ unsigned xb_xcc_id() { return (unsigned)__builtin_amdgcn_s_getreg((3 << 11) | 20) & 0xFu; }
#define XB_SPIN(cond, bar) do { unsigned _sp = 0; while (cond) { __builtin_amdgcn_s_sleep(1); \
    if ((++_sp & 255u) == 0u) { if (xb_ld(&(bar)[XB_TMO])) break; if (_sp > XB_SPIN_CAP) { atomicAdd(&(bar)[XB_TMO], 1u); break; } } } } while (0)
struct XcdBarrier { unsigned* bar; unsigned x; volatile LAS unsigned* st; };
__device__ __forceinline__ XcdBarrier xcd_barrier_post(unsigned* bar, volatile LAS unsigned* st) {
    XcdBarrier b; b.bar = bar; b.x = xb_xcc_id(); b.st = st;
    if (threadIdx.x == 0) (void)xb_add(&bar[XB_XCNT(b.x)], 1u);
    return b;
}
__device__ __forceinline__ void xcd_barrier_complete(unsigned* bar, unsigned x, unsigned& nloc, unsigned& nx) {
    const unsigned G = gridDim.x * gridDim.y * gridDim.z;
    unsigned sum, cnt, mine, sp = 0u;
    for (;;) {
        sum = 0u; cnt = 0u; mine = 0u;
#pragma unroll
        for (unsigned j = 0; j < 16; ++j) { const unsigned c = xb_ld(&bar[XB_XCNT(j)]); sum += c; cnt += (c > 0u) ? 1u : 0u; mine = (j == x) ? c : mine; }
        if (sum == G) break;
        __builtin_amdgcn_s_sleep(1);
        if ((++sp & 255u) == 0u) { if (xb_ld(&bar[XB_TMO])) break; if (sp > XB_SPIN_CAP) { atomicAdd(&bar[XB_TMO], 1u); break; } }
    }
    nloc = mine > 0u ? mine : 1u; nx = cnt > 0u ? cnt : 1u;
}
__device__ __forceinline__ void xcd_barrier(const XcdBarrier& b) {
    asm volatile("s_waitcnt vmcnt(0)" ::: "memory");
    __syncthreads();
    if (threadIdx.x == 0) {
        unsigned* bar = b.bar;
        __builtin_amdgcn_s_waitcnt(0);
        unsigned nloc = b.st[0], nx = b.st[1];
        if (nloc == 0u) { xcd_barrier_complete(bar, b.x, nloc, nx); b.st[0] = nloc; b.st[1] = nx; }
        const unsigned old = xb_add(&bar[XB_XSUB(b.x)], 1u);
        const unsigned gen = old / nloc;
        if (old + 1u == (gen + 1u) * nloc) {
            __builtin_amdgcn_fence(__ATOMIC_RELEASE, "agent");
            asm volatile("s_waitcnt vmcnt(0)" ::: "memory");
            const unsigned og = xb_add(&bar[XB_TOP], 1u);
            const unsigned tg = og / nx;
            if (og + 1u == (tg + 1u) * nx) xb_add(&bar[XB_TOPGEN], 1u);
            else XB_SPIN(xb_ld(&bar[XB_TOPGEN]) == tg, bar);
            __builtin_amdgcn_fence(__ATOMIC_ACQUIRE, "agent");
            xb_add(&bar[XB_XGEN(b.x)], 1u);
            asm volatile("s_waitcnt vmcnt(0)" ::: "memory");
        } else {
            XB_SPIN(xb_ld(&bar[XB_XGEN(b.x)]) == gen, bar);
            __builtin_amdgcn_fence(__ATOMIC_ACQUIRE, "agent");
            asm volatile("s_waitcnt vmcnt(0)" ::: "memory");
        }
    }
    __syncthreads();
}

struct Args { const float* in[22]; float* out; unsigned char* ws; int ph_lo, ph_hi; };
struct Ctx { LAS unsigned char* lds; int G, bid; };
#define TID_SETUP() int tid = threadIdx.x; asm volatile("" : "+v"(tid)); const int lane = tid & 63, wave = __builtin_amdgcn_readfirstlane(tid >> 6); (void)lane; (void)wave
typedef const __attribute__((address_space(4))) Args* ArgsP;
__device__ __forceinline__ ArgsP args_ptr() { ArgsP p = (ArgsP)__builtin_amdgcn_kernarg_segment_ptr(); asm volatile("" : "+s"(p)); return p; }
#define WSP(T, off) ((T*)(A->ws + (off)))

struct MapId { __device__ __forceinline__ int operator()(int n) const { return n; } };
struct MapGU { __device__ __forceinline__ int operator()(int n) const { const int t = n >> 8, w = n & 255; return w < 128 ? 128 * t + w : DFF + 128 * t + (w - 128); } };
struct MapIn { __device__ __forceinline__ int operator()(int n) const {
    if (n < 3072) return n + 512; if (n < 3584) return n - 3072; if (n < 4608) return n; if (n < 5120) return n + 8; if (n < 8192) return n + 460; if (n < 8640) return n - 3064;
    if (n < 8644) return 4608 + (n - 8640); if (n < 8648) return 4612 + (n - 8644); if (n < 8652) return 5576 + (n - 8648); return -1; } };
template <class Map>
__device__ __forceinline__ void conv_item(const float* W, int K, int N, bf16_t* WT, int ldt, int koff, const float* gain, LAS float* scr, int item, int nblk, int lane, Map map) {
    const int kb = item / nblk, nb = item % nblk, k0 = 64 * kb, n0 = 32 * nb;
    const int c = map(n0 + (lane & 31));
    float wv[32];
#pragma unroll
    for (int i = 0; i < 32; ++i) { const int kk = 2 * i + (lane >> 5); wv[i] = (c >= 0) ? W[(size_t)(k0 + kk) * N + c] : 0.f; }
#pragma unroll
    for (int i = 0; i < 32; ++i) { const int kk = 2 * i + (lane >> 5); float v = wv[i]; if (gain) v *= gain[k0 + kk]; scr[kk * 33 + (lane & 31)] = v; }
    asm volatile("s_waitcnt lgkmcnt(0)" ::: "memory");
    const int c8 = lane & 7;
#pragma unroll
    for (int j = 0; j < 4; ++j) { const int n = (lane >> 3) + 8 * j; const LAS float* s = scr + (8 * c8) * 33 + n;
        u32x4 o; o.x = pk2(s[0 * 33], s[1 * 33]); o.y = pk2(s[2 * 33], s[3 * 33]); o.z = pk2(s[4 * 33], s[5 * 33]); o.w = pk2(s[6 * 33], s[7 * 33]);
        *(u32x4*)(WT + (size_t)(n0 + n) * ldt + koff + k0 + 8 * c8) = o; }
    asm volatile("s_waitcnt lgkmcnt(0)" ::: "memory");
}
__device__ __forceinline__ void phase_convert(const Ctx& C, int l) {
    TID_SETUP(); ArgsP A = args_ptr(); const int gw = C.bid * NWAVES + wave, NGW = C.G * NWAVES;
    LAS float* scr = (LAS float*)(C.lds + wave * 16384);
    bf16_t* W = WSP(bf16_t, WS_W);
    constexpr int I_GU = 16 * 176, I_DN = 44 * 32, I_IN = 16 * 272, I_CO = 8 * 32, I_MO = 16 * 32, I_AO = 8 * 32, I_O = 16 * 32, I_PG = 16 * 32, I_PP = 4 * 32;
    constexpr int NIT = 2 * I_GU + 2 * I_DN + I_IN + I_CO + I_MO + I_AO + I_O + I_PG + I_PP;
    for (int it = gw; it < NIT; it += NGW) {
        int r = it;
        if (r < I_GU) { conv_item(A->in[3] + (size_t)l * DM * 2 * DFF, DM, 2 * DFF, W + W_GU1, DM, 0, A->in[2] + (size_t)l * DM, scr, r, 176, lane, MapGU()); continue; } r -= I_GU;
        if (r < I_GU) { conv_item(A->in[16] + (size_t)l * DM * 2 * DFF, DM, 2 * DFF, W + W_GU2, DM, 0, A->in[15] + (size_t)l * DM, scr, r, 176, lane, MapGU()); continue; } r -= I_GU;
        if (r < I_DN) { conv_item(A->in[4] + (size_t)l * DFF * DM, DFF, DM, W + W_DN1, DFF, 0, nullptr, scr, r, 32, lane, MapId()); continue; } r -= I_DN;
        if (r < I_DN) { conv_item(A->in[17] + (size_t)l * DFF * DM, DFF, DM, W + W_DN2, DFF, 0, nullptr, scr, r, 32, lane, MapId()); continue; } r -= I_DN;
        if (r < I_IN) { conv_item(A->in[6] + (size_t)l * DM * 8652, DM, 8652, W + W_IN, DM, 0, A->in[5] + (size_t)l * DM, scr, r, 272, lane, MapIn()); continue; } r -= I_IN;
        if (r < I_CO) { conv_item(A->in[8] + (size_t)l * DCONV * DM, DCONV, DM, W + W_MRG, 2048, 0, nullptr, scr, r, 32, lane, MapId()); continue; } r -= I_CO;
        if (r < I_MO) { conv_item(A->in[12] + (size_t)l * DM * DM, DM, DM, W + W_MRG, 2048, 512, nullptr, scr, r, 32, lane, MapId()); continue; } r -= I_MO;
        if (r < I_AO) { conv_item(A->in[13] + (size_t)l * 512 * DM, 512, DM, W + W_MRG, 2048, 1536, nullptr, scr, r, 32, lane, MapId()); continue; } r -= I_AO;
        if (r < I_O) { conv_item(A->in[14] + (size_t)l * DM * DM, DM, DM, W + W_O, DM, 0, nullptr, scr, r, 32, lane, MapId()); continue; } r -= I_O;
        if (r < I_PG) { conv_item(A->in[19] + (size_t)l * DM * DM, DM, DM, W + W_PG, DM, 0, A->in[18] + (size_t)l * DM, scr, r, 32, lane, MapId()); continue; } r -= I_PG;
        conv_item(A->in[20] + (size_t)l * DPLE * DM, DPLE, DM, W + W_PP, DPLE, 0, nullptr, scr, r, 32, lane, MapId());
    }
}
__device__ __forceinline__ void phase_init_rows(const Ctx& C) {
    TID_SETUP(); ArgsP A = args_ptr(); const int gw = C.bid * NWAVES + wave, NGW = C.G * NWAVES;
    const float* x = A->in[0]; bf16_t* XB = WSP(bf16_t, WS_XB); float* SS0 = WSP(float, WS_SS0);
    for (int m0 = 4 * gw; m0 < MTOK; m0 += 4 * NGW) {
        f32x4 v[4][4];
#pragma unroll
        for (int k = 0; k < 4; ++k) { const int m = m0 + k; const f32x4* xr = (const f32x4*)(x + (size_t)m * DM) + lane;
#pragma unroll
            for (int j = 0; j < 4; ++j) v[k][j] = xr[64 * j]; }
#pragma unroll
        for (int k = 0; k < 4; ++k) { const int m = m0 + k;
            { u32x2* bo = (u32x2*)(XB + (size_t)m * DM) + lane; float s = 0.f;
#pragma unroll
                for (int j = 0; j < 4; ++j) { const f32x4 t = v[k][j]; u32x2 w; w.x = pk2(t[0], t[1]); w.y = pk2(t[2], t[3]); bo[64 * j] = w; s += (t[0] * t[0] + t[1] * t[1]) + (t[2] * t[2] + t[3] * t[3]); }
                s = wave_sum(s);
                if (lane == 0) *(f32x4*)(SS0 + (size_t)m * 4) = (f32x4){s, 0.f, 0.f, 0.f}; } }
    }
}
__device__ __forceinline__ void phase_pb(const Ctx& C, int l) {
    TID_SETUP(); ArgsP A = args_ptr();
    const f32x4* p = (const f32x4*)(A->in[1] + (size_t)l * MTOK * DPLE); u32x2* o = WSP(u32x2, WS_PB);
    const size_t n4 = (size_t)MTOK * DPLE / 4;
    for (size_t i = (size_t)C.bid * NTHR + tid; i < n4; i += (size_t)C.G * NTHR) { const f32x4 v = p[i]; u32x2 w; w.x = pk2(v[0], v[1]); w.y = pk2(v[2], v[3]); o[i] = w; }
}
__device__ __forceinline__ void phase_final(const Ctx& C) {
    TID_SETUP(); ArgsP A = args_ptr(); const int gw = C.bid * NWAVES + wave, NGW = C.G * NWAVES;
    const f32x4* gn = (const f32x4*)A->in[21] + lane; float* X = A->out; const float* SS = WSP(float, WS_SS0);
    f32x4 g4[4];
#pragma unroll
    for (int j = 0; j < 4; ++j) g4[j] = gn[64 * j];
    for (int m0 = 4 * gw; m0 < MTOK; m0 += 4 * NGW) {
        f32x4 v[4][4]; float r[4];
#pragma unroll
        for (int k = 0; k < 4; ++k) { const int m = m0 + k; const f32x4* xr = (const f32x4*)(X + (size_t)m * DM) + lane;
#pragma unroll
            for (int j = 0; j < 4; ++j) v[k][j] = xr[64 * j];
            r[k] = rstd_of(SS + (size_t)m * 4); }
#pragma unroll
        for (int k = 0; k < 4; ++k) { const int m = m0 + k;
            { f32x4* xr = (f32x4*)(X + (size_t)m * DM) + lane;
#pragma unroll
                for (int j = 0; j < 4; ++j) xr[64 * j] = v[k][j] * r[k] * g4[j]; } }
    }
}

__device__ __forceinline__ void prep_conv(const Ctx& C, int l, int b, int part, int nparts, int dry) {
    TID_SETUP(); ArgsP A = args_ptr();
    const float* cw = A->in[7] + (size_t)l * 3 * DCONV; bf16_t* PROJ = WSP(bf16_t, WS_PROJ);
    const int nit = SEQ * 64;
    for (int i = part * NTHR + tid; i < nit; i += nparts * NTHR) {
        const int ts = i >> 6, ch = (i & 63) * 8, tok = b * SEQ + ts;
        bf16_t* row = PROJ + (size_t)tok * LDP;
        const u32x4 b = *(const u32x4*)(row + O_CB + ch);
        float u[3][8];
#pragma unroll
        for (int d = 0; d < 3; ++d) {
            const int back = 2 - d;
            if (ts >= back) { const bf16_t* r2 = row - (size_t)back * LDP; const u32x4 c = *(const u32x4*)(r2 + O_CC + ch), x = *(const u32x4*)(r2 + O_CX + ch);
                const unsigned cwv[4] = {c.x, c.y, c.z, c.w}, xwv[4] = {x.x, x.y, x.z, x.w};
#pragma unroll
                for (int j = 0; j < 4; ++j) { u[d][2 * j] = bflo(cwv[j]) * bflo(xwv[j]); u[d][2 * j + 1] = bfhi(cwv[j]) * bfhi(xwv[j]); } }
            else {
#pragma unroll
                for (int j = 0; j < 8; ++j) u[d][j] = 0.f; }
        }
        const unsigned bw[4] = {b.x, b.y, b.z, b.w}; float o[8];
#pragma unroll
        for (int j = 0; j < 8; ++j) { const float bb = (j & 1) ? bfhi(bw[j >> 1]) : bflo(bw[j >> 1]);
            o[j] = bb * (u[0][j] * cw[ch + j] + u[1][j] * cw[DCONV + ch + j] + u[2][j] * cw[2 * DCONV + ch + j]); }
        u32x4 w; w.x = pk2(o[0], o[1]); w.y = pk2(o[2], o[3]); w.z = pk2(o[4], o[5]); w.w = pk2(o[6], o[7]);
        if (!dry) *(u32x4*)(row + O_CB + ch) = w;
    }
}
__device__ __forceinline__ void prep_gate(const Ctx& C, int l, int part, int nparts, int dry = 0) {
    TID_SETUP(); ArgsP A = args_ptr();
    const float* gn = A->in[11] + (size_t)l * DM; bf16_t* PROJ = WSP(bf16_t, WS_PROJ);
    const int nit = MG * 4, g = lane >> 4, li = lane & 15;
    for (int i = (part * NWAVES + wave) * 4 + g; i < nit; i += nparts * NWAVES * 4) {
        const int tok = i >> 2, hd = i & 3;
        bf16_t* row = PROJ + (size_t)tok * LDP;
        const u32x4 h0 = *(const u32x4*)(row + O_MV + hd * 256 + li * 16), h1 = *(const u32x4*)(row + O_MV + hd * 256 + li * 16 + 8);
        const u32x4 o0 = *(const u32x4*)(row + O_MO + hd * 256 + li * 16), o1 = *(const u32x4*)(row + O_MO + hd * 256 + li * 16 + 8);
        const unsigned hw[8] = {h0.x, h0.y, h0.z, h0.w, h1.x, h1.y, h1.z, h1.w}, ow[8] = {o0.x, o0.y, o0.z, o0.w, o1.x, o1.y, o1.z, o1.w};
        float ssq = 0.f;
#pragma unroll
        for (int j = 0; j < 8; ++j) { const float a = bflo(hw[j]), bb = bfhi(hw[j]); ssq += a * a + bb * bb; }
#pragma unroll
        for (int o = 1; o < 16; o <<= 1) ssq += __shfl_xor(ssq, o);
        const float r = 1.0f / sqrtf(ssq * (1.0f / 256.0f) + EPS);
        const f32x4* gp = (const f32x4*)(gn + hd * 256 + li * 16);
        unsigned w[8];
#pragma unroll
        for (int j = 0; j < 4; ++j) { const f32x4 gv = gp[j];
            w[2 * j] = pk2(fsigmoid(bflo(ow[2 * j])) * bflo(hw[2 * j]) * r * gv[0], fsigmoid(bfhi(ow[2 * j])) * bfhi(hw[2 * j]) * r * gv[1]);
            w[2 * j + 1] = pk2(fsigmoid(bflo(ow[2 * j + 1])) * bflo(hw[2 * j + 1]) * r * gv[2], fsigmoid(bfhi(ow[2 * j + 1])) * bfhi(hw[2 * j + 1]) * r * gv[3]); }
        if (!dry) { *(u32x4*)(row + O_MO + hd * 256 + li * 16) = (u32x4){w[0], w[1], w[2], w[3]}; *(u32x4*)(row + O_MO + hd * 256 + li * 16 + 8) = (u32x4){w[4], w[5], w[6], w[7]}; }
    }
}

namespace ml {
constexpr int QS = 0, KS = 17408, VS = 34816, VW = 44032, PS = 53248, CB = 62464, SC = 97280, NP = 99328, NV = 103424, MS = 103936, LEND = 104704;
constexpr int PQ = 272, PT = 144;
static_assert(LEND <= RING_BYTES, "mlstm LDS");
typedef short s16x4 __attribute__((ext_vector_type(4)));
__device__ __forceinline__ f32x4 mfma16(bf16x8 a, bf16x8 b, f32x4 c) { return __builtin_amdgcn_mfma_f32_16x16x32_bf16(a, b, c, 0, 0, 0); }
__device__ __forceinline__ bf16x8 ldsv(const LAS unsigned char* p) { return *(const LAS bf16x8*)p; }
__device__ __forceinline__ bf16x8 frag_tr(const LAS unsigned char* X, int P, int r0, int c0, int lane) {
    const int g = lane >> 4, li = lane & 15;
    const LAS unsigned char* p = X + (r0 + 8 * g + (li >> 2)) * P + (c0 + 4 * (li & 3)) * 2;
    const s16x4 lo = __builtin_amdgcn_ds_read_tr16_b64_v4i16((LAS s16x4*)p), hi = __builtin_amdgcn_ds_read_tr16_b64_v4i16((LAS s16x4*)(p + 4 * P));
    return __builtin_shufflevector(lo, hi, 0, 1, 2, 3, 4, 5, 6, 7);
}

__device__ __forceinline__ void unit(const Ctx& C, int l, int uidx, int dry) {
    TID_SETUP(); ArgsP A = args_ptr();
    const int b = uidx >> 4, hd = (uidx >> 2) & 3, vq = uidx & 3;
    LAS unsigned char* L = C.lds;
    LAS float* sc = (LAS float*)(L + SC);
    LAS float* npart = (LAS float*)(L + NP);
    LAS float* nv = (LAS float*)(L + NV);
    LAS float* ms = (LAS float*)(L + MS);
    const int w = wave, fr = lane & 15, fq = lane >> 4;
    const float bi = A->in[9][l * 4 + hd], bfg = A->in[10][l * 4 + hd];
    bf16_t* base = WSP(bf16_t, WS_PROJ) + (size_t)b * SEQ * LDP;
    float* scr = WSP(float, WS_SCR) + (size_t)uidx * (64 * 192);
    for (int c = w; c < SEQ / 64; c += NWAVES) {
        const bf16_t* rb = WSP(bf16_t, WS_SIDE) + (size_t)(b * SEQ + c * 64 + lane) * LDS_;
        const float fv = bf2f(rb[O_MF - O_SIDE + hd]) + bfg, iv = bf2f(rb[O_MI - O_SIDE + hd]) + bi;
        const float lf = fminf(fv, 0.f) - log1pf(__expf(-fabsf(fv)));
        float bt = lf;
#pragma unroll
        for (int o = 1; o < 64; o <<= 1) { const float t = __shfl_up(bt, o); if (lane >= o) bt += t; }
        const float a = iv - bt; float pm = a;
#pragma unroll
        for (int o = 1; o < 64; o <<= 1) { const float t = __shfl_up(pm, o); if (lane >= o) pm = fmaxf(pm, t); }
        scr[c * 192 + lane] = a; scr[c * 192 + 64 + lane] = pm; scr[c * 192 + 128 + lane] = bt;
        if (lane == 63) { ms[64 + c] = bt; ms[128 + c] = pm; }
    }
    f32x4 cst[4];
#pragma unroll
    for (int i = 0; i < 4; ++i) cst[i] = (f32x4){0.f, 0.f, 0.f, 0.f};
    for (int i = tid; i < 2 * 64 * PQ / 4; i += NTHR) ((LAS unsigned*)(L + CB))[i] = 0u;
    for (int i = tid; i < 8 * 128; i += NTHR) npart[i] = 0.f;
    if (tid < 128) nv[tid] = 0.f;
    __syncthreads();
    if (tid == 0) { float m = 0.f; for (int c = 0; c < SEQ / 64; ++c) { ms[c] = m; m = ms[64 + c] + fmaxf(m, ms[128 + c]); } }
    const int qr = tid >> 4, qc = (tid & 15) * 8;
    const int vr = tid >> 3, vc = (tid & 7) * 8;
    u32x4 rq[2], rk[2], rv; float ra = 0.f, rpm = 0.f, rbt = 0.f;
#define ML_ISSUE(cc) do { const bf16_t* rb = base + (size_t)((cc) * 64) * LDP; \
        rq[0] = *(const u32x4*)(rb + (size_t)qr * LDP + O_MQ + hd * 128 + qc); rq[1] = *(const u32x4*)(rb + (size_t)(qr + 32) * LDP + O_MQ + hd * 128 + qc); \
        rk[0] = *(const u32x4*)(rb + (size_t)qr * LDP + O_MK + hd * 128 + qc); rk[1] = *(const u32x4*)(rb + (size_t)(qr + 32) * LDP + O_MK + hd * 128 + qc); \
        rv = *(const u32x4*)(rb + (size_t)vr * LDP + O_MV + hd * 256 + vq * 64 + vc); \
        if (w == 0) { ra = scr[(cc) * 192 + lane]; rpm = scr[(cc) * 192 + 64 + lane]; rbt = scr[(cc) * 192 + 128 + lane]; } } while (0)
    __syncthreads();
    ML_ISSUE(0);
    float decay = 0.f;
    int cur = 0;
#pragma unroll 1
    for (int c = 0; c < SEQ / 64; ++c) {
#pragma unroll
        for (int i = 0; i < 2; ++i) {
            *(LAS u32x4*)(L + QS + (qr + 32 * i) * PQ + qc * 2) = rq[i];
            *(LAS u32x4*)(L + KS + (qr + 32 * i) * PQ + qc * 2) = rk[i];
        }
        *(LAS u32x4*)(L + VS + vr * PT + vc * 2) = rv;
        const u32x4 vkeep = rv;
        if (tid < 128) { float pn[8], nold = nv[tid];
#pragma unroll
            for (int j = 0; j < 8; ++j) pn[j] = npart[j * 128 + tid];
            asm volatile("" : "+v"(pn[0]), "+v"(pn[1]), "+v"(pn[2]), "+v"(pn[3]), "+v"(pn[4]), "+v"(pn[5]), "+v"(pn[6]), "+v"(pn[7]), "+v"(nold));
            float sn = 0.f;
#pragma unroll
            for (int j = 0; j < 8; ++j) sn += pn[j];
            nv[tid] = decay * nold + sn; }
        if (w == 0) {
            const float mc = ms[c], p63 = ms[128 + c];
            const float Mt = fmaxf(mc, rpm), M63 = fmaxf(mc, p63);
            sc[lane] = ra; sc[64 + lane] = Mt; sc[128 + lane] = __expf(mc - Mt); sc[192 + lane] = __expf(-(rbt + Mt)); sc[256 + lane] = __expf(ra - M63);
            if (lane == 0) sc[320] = __expf(mc - M63);
        }
        __syncthreads();
        decay = sc[320];
        if (c + 1 < SEQ / 64) ML_ISSUE(c + 1);
        { const float wk = sc[256 + vr]; const unsigned vw[4] = {vkeep.x, vkeep.y, vkeep.z, vkeep.w}; u32x4 o;
          o.x = pk2(bflo(vw[0]) * wk, bfhi(vw[0]) * wk); o.y = pk2(bflo(vw[1]) * wk, bfhi(vw[1]) * wk); o.z = pk2(bflo(vw[2]) * wk, bfhi(vw[2]) * wk); o.w = pk2(bflo(vw[3]) * wk, bfhi(vw[3]) * wk);
          *(LAS u32x4*)(L + VW + vr * PT + vc * 2) = o; }
        {
            const int ti = w >> 1;
            bf16x8 qa[4], kf[2][4];
#pragma unroll
            for (int kk = 0; kk < 4; ++kk) qa[kk] = ldsv(L + QS + (16 * ti + fr) * PQ + (32 * kk + 8 * fq) * 2);
#pragma unroll
            for (int s2 = 0; s2 < 2; ++s2)
#pragma unroll
                for (int kk = 0; kk < 4; ++kk) kf[s2][kk] = ldsv(L + KS + (16 * (2 * (w & 1) + s2) + fr) * PQ + (32 * kk + 8 * fq) * 2);
            f32x4 Mr = *(const LAS f32x4*)(sc + 64 + 16 * ti + 4 * fq);
            float as2[2] = {sc[16 * (2 * (w & 1)) + fr], sc[16 * (2 * (w & 1) + 1) + fr]};
            asm volatile("" : "+v"(qa[0]), "+v"(qa[1]), "+v"(qa[2]), "+v"(qa[3]), "+v"(kf[0][0]), "+v"(kf[0][1]), "+v"(kf[0][2]), "+v"(kf[0][3]),
                              "+v"(kf[1][0]), "+v"(kf[1][1]), "+v"(kf[1][2]), "+v"(kf[1][3]), "+v"(Mr), "+v"(as2[0]), "+v"(as2[1]));
#pragma unroll
            for (int s2 = 0; s2 < 2; ++s2) { const int si = 2 * (w & 1) + s2; f32x4 sa = (f32x4){0.f, 0.f, 0.f, 0.f};
#pragma unroll
                for (int kk = 0; kk < 4; ++kk) sa = mfma16(qa[kk], kf[s2][kk], sa);
                const int scol = 16 * si + fr; const float as = as2[s2];
#pragma unroll
                for (int r = 0; r < 4; ++r) { const int trow = 16 * ti + 4 * fq + r; const float p = (scol <= trow) ? sa[r] * __expf(as - Mr[r]) : 0.f;
                    *(LAS bf16_t*)(L + PS + trow * PT + scol * 2) = f2bf(p); } }
        }
        __syncthreads();
        {
            const int vi = w >> 1;
            bf16x8 va[2], kt[4][2];
#pragma unroll
            for (int kk = 0; kk < 2; ++kk) va[kk] = frag_tr(L + VW, PT, 32 * kk, 16 * vi, lane);
#pragma unroll
            for (int i = 0; i < 4; ++i)
#pragma unroll
                for (int kk = 0; kk < 2; ++kk) kt[i][kk] = frag_tr(L + KS, PQ, 32 * kk, 16 * (4 * (w & 1) + i), lane);
            asm volatile("" : "+v"(va[0]), "+v"(va[1]), "+v"(kt[0][0]), "+v"(kt[0][1]), "+v"(kt[1][0]), "+v"(kt[1][1]), "+v"(kt[2][0]), "+v"(kt[2][1]), "+v"(kt[3][0]), "+v"(kt[3][1]));
#pragma unroll
            for (int i = 0; i < 4; ++i) { const int di = 4 * (w & 1) + i; f32x4 a = cst[i] * decay;
#pragma unroll
                for (int kk = 0; kk < 2; ++kk) a = mfma16(va[kk], kt[i][kk], a);
                cst[i] = a;
#pragma unroll
                for (int r = 0; r < 4; ++r) *(LAS bf16_t*)(L + CB + (cur ^ 1) * 64 * PQ + (16 * vi + 4 * fq + r) * PQ + (16 * di + fr) * 2) = f2bf(a[r]); }
        }
        {
            float p0 = 0.f, p1 = 0.f; unsigned kw[8];
#pragma unroll
            for (int i = 0; i < 8; ++i) kw[i] = *(const LAS unsigned*)(L + KS + (8 * w + i) * PQ + lane * 4);
            f32x4 wk0 = *(const LAS f32x4*)(sc + 256 + 8 * w), wk1 = *(const LAS f32x4*)(sc + 256 + 8 * w + 4);
            asm volatile("" : "+v"(kw[0]), "+v"(kw[1]), "+v"(kw[2]), "+v"(kw[3]), "+v"(kw[4]), "+v"(kw[5]), "+v"(kw[6]), "+v"(kw[7]), "+v"(wk0), "+v"(wk1));
#pragma unroll
            for (int i = 0; i < 8; ++i) { const float wk = (i < 4) ? wk0[i & 3] : wk1[i & 3]; p0 += wk * bflo(kw[i]); p1 += wk * bfhi(kw[i]); }
            npart[w * 128 + 2 * lane] = p0; npart[w * 128 + 2 * lane + 1] = p1;
        }
        {
            const int ti = w >> 1;
            float nq = 0.f, ps = 0.f;
            { const LAS unsigned char* qrow = L + QS + (16 * ti + fr) * PQ + (32 * fq) * 2;
              const LAS unsigned char* prow = L + PS + (16 * ti + fr) * PT + (16 * fq) * 2;
              u32x4 qv[4], pv[2]; f32x4 nvv[8];
#pragma unroll
              for (int h4 = 0; h4 < 4; ++h4) qv[h4] = *(const LAS u32x4*)(qrow + h4 * 16);
#pragma unroll
              for (int i = 0; i < 8; ++i) nvv[i] = *(const LAS f32x4*)(nv + 32 * fq + 4 * i);
#pragma unroll
              for (int h2 = 0; h2 < 2; ++h2) pv[h2] = *(const LAS u32x4*)(prow + h2 * 16);
              asm volatile("" : "+v"(qv[0]), "+v"(qv[1]), "+v"(qv[2]), "+v"(qv[3]), "+v"(pv[0]), "+v"(pv[1]),
                                "+v"(nvv[0]), "+v"(nvv[1]), "+v"(nvv[2]), "+v"(nvv[3]), "+v"(nvv[4]), "+v"(nvv[5]), "+v"(nvv[6]), "+v"(nvv[7]));
#pragma unroll
              for (int h4 = 0; h4 < 4; ++h4) { const unsigned qw[4] = {qv[h4].x, qv[h4].y, qv[h4].z, qv[h4].w};
#pragma unroll
                  for (int j = 0; j < 4; ++j) { const int e0 = 8 * h4 + 2 * j; nq += nvv[e0 >> 2][e0 & 3] * bflo(qw[j]) + nvv[(e0 + 1) >> 2][(e0 + 1) & 3] * bfhi(qw[j]); } }
#pragma unroll
              for (int h2 = 0; h2 < 2; ++h2) { const unsigned pw[4] = {pv[h2].x, pv[h2].y, pv[h2].z, pv[h2].w};
#pragma unroll
                  for (int j = 0; j < 4; ++j) ps += bflo(pw[j]) + bfhi(pw[j]); } }
            { const auto a1 = __builtin_amdgcn_permlane16_swap(__float_as_uint(nq), __float_as_uint(nq), false, false); const auto b1 = __builtin_amdgcn_permlane16_swap(__float_as_uint(ps), __float_as_uint(ps), false, false);
              nq = __uint_as_float(a1[0]) + __uint_as_float(a1[1]); ps = __uint_as_float(b1[0]) + __uint_as_float(b1[1]);
              const auto a2 = __builtin_amdgcn_permlane32_swap(__float_as_uint(nq), __float_as_uint(nq), false, false); const auto b2 = __builtin_amdgcn_permlane32_swap(__float_as_uint(ps), __float_as_uint(ps), false, false);
              nq = __uint_as_float(a2[0]) + __uint_as_float(a2[1]); ps = __uint_as_float(b2[0]) + __uint_as_float(b2[1]); }
            const float den_own = sc[128 + 16 * ti + fr] * nq + ps;
            float wr4[4], em4[4], dn4[4];
#pragma unroll
            for (int r = 0; r < 4; ++r) { wr4[r] = sc[128 + 16 * ti + 4 * fq + r]; em4[r] = sc[192 + 16 * ti + 4 * fq + r]; dn4[r] = __shfl(den_own, 4 * fq + r); }
            asm volatile("" : "+v"(dn4[0]), "+v"(dn4[1]), "+v"(dn4[2]), "+v"(dn4[3]), "+v"(wr4[0]), "+v"(wr4[1]), "+v"(wr4[2]), "+v"(wr4[3]), "+v"(em4[0]), "+v"(em4[1]), "+v"(em4[2]), "+v"(em4[3]));
            bf16x8 qa[4], pa[2], cbf[2][4], vtf[2][2];
#pragma unroll
            for (int kk = 0; kk < 4; ++kk) qa[kk] = ldsv(L + QS + (16 * ti + fr) * PQ + (32 * kk + 8 * fq) * 2);
#pragma unroll
            for (int kk = 0; kk < 2; ++kk) pa[kk] = ldsv(L + PS + (16 * ti + fr) * PT + (32 * kk + 8 * fq) * 2);
#pragma unroll
            for (int v2 = 0; v2 < 2; ++v2) {
#pragma unroll
                for (int kk = 0; kk < 4; ++kk) cbf[v2][kk] = ldsv(L + CB + cur * 64 * PQ + (16 * (2 * (w & 1) + v2) + fr) * PQ + (32 * kk + 8 * fq) * 2);
#pragma unroll
                for (int kk = 0; kk < 2; ++kk) vtf[v2][kk] = frag_tr(L + VS, PT, 32 * kk, 16 * (2 * (w & 1) + v2), lane); }
            asm volatile("" : "+v"(qa[0]), "+v"(qa[1]), "+v"(qa[2]), "+v"(qa[3]), "+v"(pa[0]), "+v"(pa[1]), "+v"(cbf[0][0]), "+v"(cbf[0][1]), "+v"(cbf[0][2]), "+v"(cbf[0][3]),
                              "+v"(cbf[1][0]), "+v"(cbf[1][1]), "+v"(cbf[1][2]), "+v"(cbf[1][3]), "+v"(vtf[0][0]), "+v"(vtf[0][1]), "+v"(vtf[1][0]), "+v"(vtf[1][1]));
            const float kscale = 0.08838834764831845f;
#pragma unroll
            for (int v2 = 0; v2 < 2; ++v2) { const int vi = 2 * (w & 1) + v2; f32x4 a = (f32x4){0.f, 0.f, 0.f, 0.f};
#pragma unroll
                for (int kk = 0; kk < 4; ++kk) a = mfma16(qa[kk], cbf[v2][kk], a);
#pragma unroll
                for (int r = 0; r < 4; ++r) a[r] *= wr4[r];
#pragma unroll
                for (int kk = 0; kk < 2; ++kk) a = mfma16(pa[kk], vtf[v2][kk], a);
#pragma unroll
                for (int r = 0; r < 4; ++r) { const float hval = kscale * a[r] * __builtin_amdgcn_rcpf(fmaxf(kscale * fabsf(dn4[r]), em4[r]));
                    if (!dry) base[(size_t)(c * 64 + 16 * ti + 4 * fq + r) * LDP + O_MV + hd * 256 + vq * 64 + 16 * vi + fr] = f2bf(hval); } }
        }
        __syncthreads();
        cur ^= 1;
    }
#undef ML_ISSUE
}
}

namespace dsa {
constexpr int GT = 0, EQ = 16384, QST = 32768, HIST = 33280, HPITCH = 257, LIST = HIST + 32 * HPITCH * 4, LCAP = 64, CNT = LIST + 32 * LCAP * 4, KST = 33280, KBUF = 128 * 144, VST = KST + 2 * KBUF, LEND = VST + 2 * KBUF, EMK = LEND, EMKB = 8192;
static_assert(CNT + 512 <= LEND, "dsa LDS");
typedef short s16x4 __attribute__((ext_vector_type(4)));
static_assert(LEND <= RING_BYTES, "dsa LDS");
__device__ __forceinline__ f32x16 mfma32(bf16x8 a, bf16x8 b, f32x16 c) { return __builtin_amdgcn_mfma_f32_32x32x16_bf16(a, b, c, 0, 0, 0); }
__device__ __forceinline__ unsigned fkey(float s) { const unsigned u = __float_as_uint(s); return (u & 0x80000000u) ? ~u : (u | 0x80000000u); }
__device__ __forceinline__ unsigned lowbits(unsigned e, int k) { if (k >= (int)__popc(e)) return e; unsigned r = 0u; for (int i = 0; i < k; ++i) { const unsigned b = e & (0u - e); r |= b; e ^= b; } return r; }

#define DSA_LOADK(dst, tile) do { _Pragma("unroll") for (int kk = 0; kk < 4; ++kk) dst[kk] = *(const bf16x8*)(kbase + (size_t)((tile) * 32 + q) * LDS_ + (O_IK - O_SIDE) + kk * 16 + hf * 8); } while (0)
__device__ __forceinline__ void idx_scores(const bf16x8 (&ka)[4], const bf16x8 (&bq)[4][4], const float (&wq)[4], float (&sc)[16]) {
    f32x16 a[4];
#pragma unroll
    for (int h = 0; h < 4; ++h)
#pragma unroll
        for (int r = 0; r < 16; ++r) a[h][r] = 0.f;
#pragma unroll
    for (int kk = 0; kk < 4; ++kk)
#pragma unroll
        for (int h = 0; h < 4; ++h) a[h] = mfma32(ka[kk], bq[h][kk], a[h]);
#pragma unroll
    for (int r = 0; r < 16; ++r) {
        float v = wq[0] * __builtin_amdgcn_fmed3f(a[0][r], 0.f, 3.0e38f);
        v = fmaf(wq[1], __builtin_amdgcn_fmed3f(a[1][r], 0.f, 3.0e38f), v);
        v = fmaf(wq[2], __builtin_amdgcn_fmed3f(a[2][r], 0.f, 3.0e38f), v);
        sc[r] = fmaf(wq[3], __builtin_amdgcn_fmed3f(a[3][r], 0.f, 3.0e38f), v) + 0.0f; }
}

#define DSA_PRELOAD() do { DSA_LOADK(k0, min(w, tlast)); DSA_LOADK(k1, min(w + NWAVES, tlast)); } while (0)
#define DSA_DIAG_MASK() if (tile == qt) { _Pragma("unroll") for (int r = 0; r < 16; ++r) { const int pos = (r & 3) + 8 * (r >> 2) + 4 * hf; sc[r] = (pos <= q) ? sc[r] : -__builtin_inff(); } }
template <int PASS>
__device__ __forceinline__ void radix_pass(LAS unsigned char* L, int lane, int w, int q, int hf, int qt, int ntile, const bf16_t* kbase, const bf16x8 (&bq)[4][4], const float (&wq)[4],
                                           bf16x8 (&k0)[4], bf16x8 (&k1)[4], u32x4* kc) {
    constexpr int shift = 24 - 8 * PASS;
    LAS unsigned* hist = (LAS unsigned*)(L + HIST); LAS unsigned* qst = (LAS unsigned*)(L + QST);
    const unsigned prefix = qst[q];
    LAS unsigned* hrow = hist + q * HPITCH;
    int tile = w; const int tlast = ntile - 1;
    if constexpr (PASS == 1) {
#pragma unroll 2
        for (; tile < ntile; tile += NWAVES) {
            const u32x4 ca = __builtin_nontemporal_load(kc + (size_t)(tile * 64 + lane) * 2), cb = __builtin_nontemporal_load(kc + (size_t)(tile * 64 + lane) * 2 + 1);
            const unsigned cw[8] = {ca.x, ca.y, ca.z, ca.w, cb.x, cb.y, cb.z, cb.w};
#pragma unroll
            for (int r = 0; r < 16; ++r) { const unsigned h16 = (r & 1) ? (cw[r >> 1] >> 16) : (cw[r >> 1] & 0xffffu);
                const bool hit = ((h16 >> 8) == prefix); const unsigned bin = hit ? (h16 & 255u) : 256u;
                __hip_atomic_fetch_add(&hrow[bin], 1u, __ATOMIC_RELAXED, __HIP_MEMORY_SCOPE_WORKGROUP); }
        }
    } else {
#define DSA_RSTEP(KB) { \
        float sc[16]; idx_scores(KB, bq, wq, sc); \
        DSA_LOADK(KB, min(tile + 2 * NWAVES, tlast)); \
        DSA_DIAG_MASK() \
        unsigned kh[8], kl[8]; \
        _Pragma("unroll") for (int r = 0; r < 16; ++r) { const unsigned key = fkey(sc[r]); unsigned bin = (key >> shift) & 255u; bool hit = true; \
            if (PASS == 0) { if (r & 1) { kh[r >> 1] |= key & 0xffff0000u; kl[r >> 1] |= key << 16; } else { kh[r >> 1] = key >> 16; kl[r >> 1] = key & 0xffffu; } } \
            if (PASS > 0) { hit = ((key >> ((shift + 8) & 31)) == prefix); bin = hit ? bin : 256u; } \
            if (PASS < 2 || __any(hit)) __hip_atomic_fetch_add(&hrow[bin], 1u, __ATOMIC_RELAXED, __HIP_MEMORY_SCOPE_WORKGROUP); } \
        if (PASS == 0) { __builtin_nontemporal_store((u32x4){kh[0], kh[1], kh[2], kh[3]}, kc + (size_t)(tile * 64 + lane) * 2); __builtin_nontemporal_store((u32x4){kh[4], kh[5], kh[6], kh[7]}, kc + (size_t)(tile * 64 + lane) * 2 + 1); \
            u32x4* kcl_ = kc + (WS_KCL - WS_KC) / 16; __builtin_nontemporal_store((u32x4){kl[0], kl[1], kl[2], kl[3]}, kcl_ + (size_t)(tile * 64 + lane) * 2); __builtin_nontemporal_store((u32x4){kl[4], kl[5], kl[6], kl[7]}, kcl_ + (size_t)(tile * 64 + lane) * 2 + 1); } \
        tile += NWAVES; }
#pragma unroll 1
    while (tile + NWAVES < ntile) { DSA_RSTEP(k0) DSA_RSTEP(k1) }
    if (tile < ntile) DSA_RSTEP(k0)
#undef DSA_RSTEP
    }
    if constexpr (PASS != 1) DSA_PRELOAD();
    __syncthreads();
    { const int g = lane >> 4, li = lane & 15, qq = 4 * w + g; const unsigned need = qst[32 + qq];
        unsigned c[16]; unsigned t = 0u;
#pragma unroll
        for (int j = 0; j < 16; ++j) { c[j] = hist[qq * HPITCH + 16 * li + j]; t += c[j]; hist[qq * HPITCH + 16 * li + j] = 0u; }
        if (li == 15) hist[qq * HPITCH + 256] = 0u;
        unsigned sfx = t;
#pragma unroll
        for (int o = 1; o < 16; o <<= 1) { const unsigned v = __shfl_down(sfx, o, 16); if (li + o < 16) sfx += v; }
        unsigned cum = sfx - t; int found = -1; unsigned cat = 0u;
#pragma unroll
        for (int j = 15; j >= 0; --j) { if (cum < need && cum + c[j] >= need) { found = j; cat = cum; } cum += c[j]; }
        if (found >= 0) { qst[qq] = (qst[qq] << 8) | (unsigned)(16 * li + found); qst[32 + qq] = need - cat; } }
    __syncthreads();
}
__device__ __forceinline__ void tie_fixup(LAS unsigned* gt, LAS unsigned* eq, int qq, int li, int need) {
    unsigned e[8]; int cn[8]; int t = 0;
#pragma unroll
    for (int j = 0; j < 8; ++j) { e[j] = eq[qq * 128 + 8 * li + j]; cn[j] = __popc(e[j]); t += cn[j]; }
    int pre = t;
#pragma unroll
    for (int o = 1; o < 16; o <<= 1) { const int v = __shfl_up(pre, o, 16); if (li >= o) pre += v; }
    int before = pre - t;
#pragma unroll
    for (int j = 0; j < 8; ++j) { const int k = min(cn[j], max(need - before, 0)); if (e[j]) gt[qq * 128 + 8 * li + j] |= lowbits(e[j], k); before += cn[j]; }
}

__device__ __forceinline__ void unit(const Ctx& C, int b, int qt, int dry) {
    TID_SETUP(); ArgsP A = args_ptr();
    LAS unsigned char* L = C.lds;
    LAS unsigned* hist = (LAS unsigned*)(L + HIST); LAS unsigned* gt = (LAS unsigned*)(L + GT); LAS unsigned* eq = (LAS unsigned*)(L + EQ); LAS unsigned* qst = (LAS unsigned*)(L + QST);
    LAS unsigned* list = (LAS unsigned*)(L + LIST); LAS unsigned* cnt = (LAS unsigned*)(L + CNT);
    const int w = wave, q = lane & 31, hf = lane >> 5;
    const int t0 = 32 * qt, ntile = qt + 1, tlast = ntile - 1;
    const bf16_t* kbase = WSP(bf16_t, WS_SIDE) + (size_t)b * SEQ * LDS_;
    const bf16_t* srow = kbase + (size_t)(t0 + q) * LDS_;
    bf16_t* qrow = WSP(bf16_t, WS_PROJ) + (size_t)(b * SEQ + t0 + q) * LDP;
    const bool sel = (qt >= 8);
    for (int i = tid; i < 2 * 32 * 128; i += NTHR) gt[i] = 0u;
    if (sel) { for (int i = tid; i < 32 * HPITCH; i += NTHR) hist[i] = 0u; }
    if (tid < 64) qst[tid] = (tid < 32) ? 0u : 256u;
    if (tid < 128) cnt[tid] = (tid >= 32 && tid < 64) ? 0xffffffffu : 0u;
    __syncthreads();
    if (sel) {
        bf16x8 bq[4][4]; float wq[4];
#pragma unroll
        for (int h = 0; h < 4; ++h) { wq[h] = bf2f(srow[O_IW - O_SIDE + h]) * 0.0625f;
#pragma unroll
            for (int kk = 0; kk < 4; ++kk) bq[h][kk] = *(const bf16x8*)(srow + (O_IQ - O_SIDE) + h * 64 + kk * 16 + hf * 8); }
        bf16x8 k0[4], k1[4];
        u32x4* kc = WSP(u32x4, WS_KC) + (size_t)C.bid * (128 * 64 * 2);
        DSA_PRELOAD();
        radix_pass<0>(L, lane, w, q, hf, qt, ntile, kbase, bq, wq, k0, k1, kc);
        radix_pass<1>(L, lane, w, q, hf, qt, ntile, kbase, bq, wq, k0, k1, kc);
        {
            const unsigned p16 = qst[q]; const u32x4* kcl = kc + (WS_KCL - WS_KC) / 16;
#pragma unroll 2
            for (int tile = w; tile < ntile; tile += NWAVES) {
                const u32x4 ha = __builtin_nontemporal_load(kc + (size_t)(tile * 64 + lane) * 2), hb = __builtin_nontemporal_load(kc + (size_t)(tile * 64 + lane) * 2 + 1);
                const u32x4 la = __builtin_nontemporal_load(kcl + (size_t)(tile * 64 + lane) * 2), lb = __builtin_nontemporal_load(kcl + (size_t)(tile * 64 + lane) * 2 + 1);
                const unsigned hw[8] = {ha.x, ha.y, ha.z, ha.w, hb.x, hb.y, hb.z, hb.w}, lw[8] = {la.x, la.y, la.z, la.w, lb.x, lb.y, lb.z, lb.w};
                unsigned gw = 0u, ew = 0u;
#pragma unroll
                for (int r = 0; r < 16; ++r) { const int pos = (r & 3) + 8 * (r >> 2) + 4 * hf;
                    const unsigned hi = (r & 1) ? (hw[r >> 1] >> 16) : (hw[r >> 1] & 0xffffu);
                    gw |= (hi > p16) ? (1u << pos) : 0u; const bool m = (hi == p16); ew |= m ? (1u << pos) : 0u;
                    if (__any(m)) { if (m) { const unsigned low = (r & 1) ? (lw[r >> 1] >> 16) : (lw[r >> 1] & 0xffffu);
                        const unsigned slot = __hip_atomic_fetch_add(&cnt[q], 1u, __ATOMIC_RELAXED, __HIP_MEMORY_SCOPE_WORKGROUP);
                        if (slot < (unsigned)LCAP) list[q * LCAP + slot] = 0x10000000u | (low << 12) | (unsigned)(4095 - (tile * 32 + pos));
                        __hip_atomic_fetch_min(&cnt[32 + q], low, __ATOMIC_RELAXED, __HIP_MEMORY_SCOPE_WORKGROUP);
                        __hip_atomic_fetch_max(&cnt[64 + q], low, __ATOMIC_RELAXED, __HIP_MEMORY_SCOPE_WORKGROUP); } } }
                gw |= __shfl_xor(gw, 32); ew |= __shfl_xor(ew, 32);
                if (hf == 0) { gt[q * 128 + tile] = gw; eq[q * 128 + tile] = ew; }
            }
        }
        __syncthreads();
        {
            const int g = lane >> 4, li = lane & 15, qq = 4 * w + g; const int need = (int)qst[32 + qq]; const int n = (int)cnt[qq];
            if (n <= LCAP) {
                unsigned c[4]; int rank[4];
#pragma unroll
                for (int k = 0; k < 4; ++k) { const int idx = li + 16 * k; c[k] = (idx < n) ? list[qq * LCAP + idx] : 0u; rank[k] = 0; }
                for (int j = 0; j < n; ++j) { const unsigned e = list[qq * LCAP + j];
#pragma unroll
                    for (int k = 0; k < 4; ++k) rank[k] += (e > c[k]) ? 1 : 0; }
#pragma unroll
                for (int k = 0; k < 4; ++k) if (c[k] != 0u && rank[k] < need) { const int sp = 4095 - (int)(c[k] & 4095u);
                    __hip_atomic_fetch_or(&gt[qq * 128 + (sp >> 5)], 1u << (sp & 31), __ATOMIC_RELAXED, __HIP_MEMORY_SCOPE_WORKGROUP); }
            } else if (cnt[32 + qq] == cnt[64 + qq]) {
                tie_fixup(gt, eq, qq, li, need);
            } else if (li == 0) cnt[96] = 1u;
        }
        __syncthreads();
        if (cnt[96] != 0u) {
            DSA_PRELOAD();
            radix_pass<2>(L, lane, w, q, hf, qt, ntile, kbase, bq, wq, k0, k1, kc);
            radix_pass<3>(L, lane, w, q, hf, qt, ntile, kbase, bq, wq, k0, k1, kc);
            const unsigned prefix = qst[q];
            for (int tile = w; tile < ntile; tile += NWAVES) {
                bf16x8 ka[4]; DSA_LOADK(ka, tile);
                float sc[16]; idx_scores(ka, bq, wq, sc);
                DSA_DIAG_MASK()
                unsigned gw = 0u, ew = 0u;
#pragma unroll
                for (int r = 0; r < 16; ++r) { const int pos = (r & 3) + 8 * (r >> 2) + 4 * hf; const unsigned key = fkey(sc[r]);
                    gw |= (key > prefix) ? (1u << pos) : 0u; ew |= (key == prefix) ? (1u << pos) : 0u; }
                gw |= __shfl_xor(gw, 32); ew |= __shfl_xor(ew, 32);
                if (hf == 0) { gt[q * 128 + tile] = gw; eq[q * 128 + tile] = ew; }
            }
            __syncthreads();
            tie_fixup(gt, eq, 4 * w + (lane >> 4), lane & 15, (int)qst[32 + 4 * w + (lane >> 4)]);
        }
    } else {
        for (int tile = w; tile < ntile; tile += NWAVES) { unsigned gw = 0u; const bool diag = (tile == qt);
#pragma unroll
            for (int r = 0; r < 16; ++r) { const int pos = (r & 3) + 8 * (r >> 2) + 4 * hf; if (!diag || (pos <= q)) gw |= 1u << pos; }
            gw |= __shfl_xor(gw, 32);
            if (hf == 0) gt[q * 128 + tile] = gw; }
    }
    __syncthreads();
    {
        const int a = w;
        bf16x8 bqa[4];
#pragma unroll
        for (int kk = 0; kk < 4; ++kk) bqa[kk] = *(const bf16x8*)(qrow + O_AQ + a * 64 + kk * 16 + hf * 8);
        f32x16 o0, o1;
#pragma unroll
        for (int r = 0; r < 16; ++r) { o0[r] = 0.f; o1[r] = 0.f; }
        float mrun = 0.f;
        f32x4 lacc = {0.f, 0.f, 0.f, 0.f};
        u32x4 onesw; onesw.x = onesw.y = onesw.z = onesw.w = ((lane & 15) == ((lane >> 4) & 1)) ? 0x3F803F80u : 0u;
        const bf16x8 onesA = __builtin_bit_cast(bf16x8, onesw);
#define DSA_EMASK(c, buf) do { const int mw_ = (int)(gt[q * 128 + 4 * (c) + (w >> 1)] >> (4 * hf + 16 * (w & 1))); u32x4 em_; \
            em_.x = __builtin_amdgcn_perm((unsigned)__builtin_amdgcn_sbfe(mw_, 1, 1), (unsigned)__builtin_amdgcn_sbfe(mw_, 0, 1), 0x07060100u); \
            em_.y = __builtin_amdgcn_perm((unsigned)__builtin_amdgcn_sbfe(mw_, 3, 1), (unsigned)__builtin_amdgcn_sbfe(mw_, 2, 1), 0x07060100u); \
            em_.z = __builtin_amdgcn_perm((unsigned)__builtin_amdgcn_sbfe(mw_, 9, 1), (unsigned)__builtin_amdgcn_sbfe(mw_, 8, 1), 0x07060100u); \
            em_.w = __builtin_amdgcn_perm((unsigned)__builtin_amdgcn_sbfe(mw_, 11, 1), (unsigned)__builtin_amdgcn_sbfe(mw_, 10, 1), 0x07060100u); \
            *(LAS u32x4*)(L + EMK + (buf) * EMKB + (w * 64 + lane) * 16) = em_; } while (0)
        const int nch = (ntile + 3) >> 2;
        const int kr0 = tid >> 3, ks0 = tid & 7;
        u32x4 rkA[2], rvA[2], rkB[2], rvB[2];
#define DSA_ISSUE(c, RK, RV) do { _Pragma("unroll") for (int i = 0; i < 2; ++i) { const bf16_t* rp_ = kbase + (size_t)((c) * 128 + kr0 + 64 * i) * LDS_ + ks0 * 8; \
            RK[i] = *(const u32x4*)(rp_ + (O_AK - O_SIDE)); RV[i] = *(const u32x4*)(rp_ + (O_AV - O_SIDE)); } } while (0)
#define DSA_WRITE(buf, RK, RV) do { _Pragma("unroll") for (int i = 0; i < 2; ++i) { \
            *(LAS u32x4*)(L + KST + (buf) * KBUF + (kr0 + 64 * i) * 144 + ks0 * 16) = RK[i]; \
            *(LAS u32x4*)(L + VST + (buf) * KBUF + (kr0 + 64 * i) * 144 + ks0 * 16) = RV[i]; } } while (0)
        const int g16 = lane >> 4, li = lane & 15;
        const int vtoff = (4 * hf + (li >> 2)) * 144 + (16 * (g16 & 1) + 4 * (li & 3)) * 2;
#ifndef ATTN_REPS
#define ATTN_REPS 1
#endif
#pragma unroll 1
        for (int rep = 0; rep < ATTN_REPS; ++rep) {
        if (ATTN_REPS > 1) { mrun = 0.f; lacc[0] = lacc[1] = lacc[2] = lacc[3] = 0.f;
#pragma unroll
            for (int r = 0; r < 16; ++r) { o0[r] = 0.f; o1[r] = 0.f; } }
        DSA_ISSUE(0, rkA, rvA); DSA_ISSUE(min(1, nch - 1), rkB, rvB);
        DSA_WRITE(0, rkA, rvA); DSA_EMASK(0, 0);
        __syncthreads();
        asm volatile("" :: "v"(bqa[0]), "v"(bqa[1]), "v"(bqa[2]), "v"(bqa[3]));
        f32x16 nmv;
#pragma unroll
        for (int r = 0; r < 16; ++r) nmv[r] = -mrun;
#define DSA_KREAD(dst, tt_) do { const LAS unsigned char* kp_ = L + KST + buf * KBUF + (32 * (tt_) + q) * 144 + 16 * hf; \
            _Pragma("unroll") for (int kk = 0; kk < 4; ++kk) dst[kk] = *(const LAS bf16x8*)(kp_ + 32 * kk); } while (0)
#define DSA_STEP(tt, CUR, NXT, KFN, HASN) do { \
            s16x4 vlo[2][2], vhi[2][2]; \
            _Pragma("unroll") for (int ks = 0; ks < 2; ++ks) \
            _Pragma("unroll") for (int dt = 0; dt < 2; ++dt) { const LAS unsigned char* vp = L + VST + buf * KBUF + (32 * (tt) + 16 * ks) * 144 + 64 * dt + vtoff; \
                vlo[ks][dt] = __builtin_amdgcn_ds_read_tr16_b64_v4i16((LAS s16x4*)vp); vhi[ks][dt] = __builtin_amdgcn_ds_read_tr16_b64_v4i16((LAS s16x4*)(vp + 8 * 144)); } \
            u32x4 em[2]; \
            _Pragma("unroll") for (int ks = 0; ks < 2; ++ks) em[ks] = *(const LAS u32x4*)(L + EMK + buf * EMKB + ((2 * (tt) + ks) * 64 + lane) * 16); \
            float mx = CUR[0]; \
            _Pragma("unroll") for (int r = 1; r < 16; ++r) mx = fmaxf(mx, CUR[r]); \
            { const auto rr = __builtin_amdgcn_permlane32_swap(__float_as_uint(mx), __float_as_uint(mx), false, false); mx = fmaxf(__uint_as_float(rr[0]), __uint_as_float(rr[1])); } \
            const bool first = (c == 0) && ((tt) == 0); \
            if (first || __any(mx > 8.0f)) {              \
                const float d = first ? mx : fmaxf(mx, 0.f), alpha = first ? 1.0f : __builtin_amdgcn_exp2f(-d); mrun += d; \
                lacc[0] *= __shfl(alpha, lane & 15); lacc[1] *= __shfl(alpha, (lane & 15) + 16); \
                _Pragma("unroll") for (int r = 0; r < 16; ++r) { o0[r] *= alpha; o1[r] *= alpha; CUR[r] -= d; nmv[r] = -mrun; } } \
            __builtin_amdgcn_sched_barrier(0); \
            float p[16]; \
            _Pragma("unroll") for (int g = 0; g < 4; ++g) { \
                if (HASN) NXT = mfma32(KFN[g], bqa[g], (g == 0) ? nmv : NXT); \
                _Pragma("unroll") for (int r = 4 * g; r < 4 * g + 4; ++r) p[r] = __builtin_amdgcn_exp2f(CUR[r]); \
                __builtin_amdgcn_sched_barrier(0); } \
            _Pragma("unroll") for (int ks = 0; ks < 2; ++ks) { \
                u32x4 pw; pw.x = pk2(p[8 * ks], p[8 * ks + 1]) & em[ks].x; pw.y = pk2(p[8 * ks + 2], p[8 * ks + 3]) & em[ks].y; pw.z = pk2(p[8 * ks + 4], p[8 * ks + 5]) & em[ks].z; pw.w = pk2(p[8 * ks + 6], p[8 * ks + 7]) & em[ks].w; \
                const bf16x8 pb = __builtin_bit_cast(bf16x8, pw); \
                o0 = mfma32(__builtin_shufflevector(vlo[ks][0], vhi[ks][0], 0, 1, 2, 3, 4, 5, 6, 7), pb, o0); \
                o1 = mfma32(__builtin_shufflevector(vlo[ks][1], vhi[ks][1], 0, 1, 2, 3, 4, 5, 6, 7), pb, o1); \
                lacc = __builtin_amdgcn_mfma_f32_16x16x32_bf16(onesA, pb, lacc, 0, 0, 0); } \
        } while (0)
#define DSA_CHUNK(RKY, RVY, RKX, RVX) do { \
            const int buf = c & 1; \
            DSA_ISSUE(min(c + 2, nch - 1), RKY, RVY);         \
            bf16x8 kfa[4], kfb[4]; f32x16 sA, sB; \
            DSA_KREAD(kfa, 0); DSA_KREAD(kfb, 1); __builtin_amdgcn_sched_barrier(0); \
            _Pragma("unroll") for (int kk = 0; kk < 4; ++kk) sA = mfma32(kfa[kk], bqa[kk], (kk == 0) ? nmv : sA); \
            DSA_KREAD(kfa, 2); __builtin_amdgcn_sched_barrier(0); \
            DSA_STEP(0, sA, sB, kfb, true); \
            DSA_KREAD(kfb, 3); __builtin_amdgcn_sched_barrier(0); \
            DSA_STEP(1, sB, sA, kfa, true); \
            DSA_STEP(2, sA, sB, kfb, true); \
            DSA_STEP(3, sB, sA, kfa, false); \
            if (c + 1 < nch) { DSA_WRITE(buf ^ 1, RKX, RVX); DSA_EMASK(c + 1, buf ^ 1); } \
            __syncthreads(); } while (0)
#pragma unroll 1
        for (int c = 0; c < nch; ++c) {
            DSA_CHUNK(rkA, rvA, rkB, rvB);
            if (++c >= nch) break;
            DSA_CHUNK(rkB, rvB, rkA, rvA);
        }
        }
#undef DSA_CHUNK
#undef DSA_EMASK
#undef DSA_STEP
#undef DSA_KREAD
        const float l0 = __shfl(lacc[0], lane & 15), l1 = __shfl(lacc[1], lane & 15);
        const float lt = (lane & 16) ? l1 : l0, inv = 1.0f / lt;
#pragma unroll
        for (int g = 0; g < 4; ++g) {
            u32x2 w0, w1; w0.x = pk2(o0[4 * g] * inv, o0[4 * g + 1] * inv); w0.y = pk2(o0[4 * g + 2] * inv, o0[4 * g + 3] * inv);
            w1.x = pk2(o1[4 * g] * inv, o1[4 * g + 1] * inv); w1.y = pk2(o1[4 * g + 2] * inv, o1[4 * g + 3] * inv);
            if (!dry) { *(u32x2*)(qrow + O_AQ + a * 64 + 8 * g + 4 * hf) = w0; *(u32x2*)(qrow + O_AQ + a * 64 + 32 + 8 * g + 4 * hf) = w1; } }
    }
    __syncthreads();
}
}

#ifdef NO_ML
#define ML_CALL(x)
#else
#define ML_CALL(x) x
#endif
#ifdef NO_DSA
#define DSA_CALL(x)
#else
#define DSA_CALL(x) x
#endif
#if defined(NO_GEMM)
#define GEMM_CALL(k, x)
#elif defined(ONLY_GEMM)
#define GEMM_CALL(k, x) do { if ((k) == ONLY_GEMM) { x; } } while (0)
#else
#define GEMM_CALL(k, x) x
#endif
#ifndef PROBE_MIX
#define PROBE_MIX 0
#endif
constexpr int PH_PER_LAYER = 20, N_PHASES = DEPTH * PH_PER_LAYER + 1;
__global__ void __launch_bounds__(NTHR, 2) mk_fwd(Args Aval) {
    extern __shared__ __attribute__((aligned(16))) unsigned char lds_raw[];
    Ctx C;
    C.lds = (LAS unsigned char*)lds_raw;
    C.G = gridDim.x; C.bid = blockIdx.x;
    volatile LAS unsigned* MISC = (volatile LAS unsigned*)(C.lds + MISC_OFF);
    for (int u = threadIdx.x; u < (LDS_BYTES - LDSCTL_OFF) / 4; u += NTHR) ((LAS unsigned*)(C.lds + LDSCTL_OFF))[u] = 0u;
    __syncthreads();
    unsigned* barw = (unsigned*)(Aval.ws + WS_CTL) + CW_BAR;
    XcdBarrier bar; bar.bar = barw; bar.x = 0; bar.st = nullptr;
    const int lo = Aval.ph_lo, hi = Aval.ph_hi;
    if ((hi - lo) > 1) bar = xcd_barrier_post(barw, MISC + 8);
#define IN(k) (lo <= (k) && (k) < hi)
#define SEAM(k) do { if (IN((k) + 1)) xcd_barrier(bar); } while (0)
#pragma unroll 1
    for (int l = 0; l < DEPTH; ++l) {
        const int P0 = l * PH_PER_LAYER;
        if (IN(P0 + 0)) { phase_convert(C, l); phase_pb(C, l); if (l == 0) phase_init_rows(C); SEAM(P0 + 0); }
        if (IN(P0 + 1)) {
            ArgsP A = args_ptr(); bf16_t* const W = WSP(bf16_t, WS_W); pg8::Gemm g{WSP(bf16_t, WS_XB), W + W_GU1, DM, MTOK, 2 * DFF, DM}; pg8::StaticOrder S; S.init(MTOK, 2 * DFF, C.G, C.bid);
            pg8::EpiSwiglu E{WSP(bf16_t, WS_HID), WSP(float, WS_SS0)}; GEMM_CALL(0, pg8::gemm_phase(C.lds, g, S, E)); SEAM(P0 + 1); }
        if (IN(P0 + 2)) {
            ArgsP A = args_ptr(); bf16_t* const W = WSP(bf16_t, WS_W); pg8::Gemm g{WSP(bf16_t, WS_HID), W + W_DN1, DFF, MTOK, DM, DFF}; pg8::StaticOrder S; S.init(MTOK, DM, C.G, C.bid);
            pg8::EpiResid E{(l == 0) ? A->in[0] : A->out, A->out, WSP(bf16_t, WS_XB), 0.5f, WSP(float, WS_SS1), (LAS float*)(C.lds + LDS_SSQ)}; GEMM_CALL(1, pg8::gemm_phase(C.lds, g, S, E)); SEAM(P0 + 2); }
#pragma unroll 1
        for (int gi = 0; gi < NGRP; ++gi) {
            const int PG = P0 + 4 + 5 * gi; const size_t r0 = (size_t)gi * MG;
            if (IN(PG + 0)) {
                ArgsP A = args_ptr(); bf16_t* const W = WSP(bf16_t, WS_W); pg8::Gemm g{WSP(bf16_t, WS_XB) + r0 * DM, W + W_IN, DM, MG, LDP, DM}; pg8::StaticOrder S; S.init(MG, LDP, C.G, C.bid);
                pg8::EpiProj E{WSP(bf16_t, WS_PROJ), WSP(float, WS_SS1) + r0 * 4, WSP(bf16_t, WS_SIDE)}; GEMM_CALL(2, pg8::gemm_phase(C.lds, g, S, E)); SEAM(PG + 0); }
            if (IN(PG + 1)) {
                constexpr int NMLB = 16, NDSAB = 128, NCVB = 32, NITEMB = NMLB + NDSAB + NCVB;
                unsigned* qbase = (unsigned*)(Aval.ws + WS_CTL) + CW_Q + 64 * (8 * (2 * l + gi));
                const int xq = (int)(xb_xcc_id() & 7u);
                for (int hop = 0; hop < GB; ++hop) {
                    const int bq_ = (xq + hop) & (GB - 1);
                    unsigned* qhead = qbase + 64 * bq_;
                    for (;;) {
                        __syncthreads();
                        if (threadIdx.x == 0) MISC[16] = __hip_atomic_fetch_add(qhead, 1u, __ATOMIC_RELAXED, __HIP_MEMORY_SCOPE_AGENT);
                        __syncthreads();
                        const int item = (int)MISC[16];
                        if (item >= NITEMB) break;
                        if (item < NMLB) { ML_CALL(ml::unit(C, l, bq_ * 16 + item, 0)); }
                        else if (item < NMLB + NDSAB) { DSA_CALL(dsa::unit(C, bq_, 127 - (item - NMLB), 0)); }
                        else prep_conv(C, l, bq_, item - NMLB - NDSAB, NCVB, 0);
                    }
                }
                SEAM(PG + 1); }
            if (IN(PG + 2)) { prep_gate(C, l, C.bid, C.G); SEAM(PG + 2); }
            if (IN(PG + 3)) {
                ArgsP A = args_ptr(); bf16_t* const W = WSP(bf16_t, WS_W); bf16_t* PROJ = WSP(bf16_t, WS_PROJ);
                pg8::Gemm g{PROJ + O_CB, W + W_MRG, LDP, MG, DM, 2 * DM}; pg8::StaticOrder S; S.init(MG, DM, C.G, C.bid);
                pg8::EpiMerge E{WSP(bf16_t, WS_GCAT), PROJ + O_G + 2 * DM}; pg8::MergeHook H{PROJ + O_G};
                GEMM_CALL(3, (pg8::gemm_phase<pg8::EpiMerge, pg8::MergeHook>(C.lds, g, S, E, H)));
                SEAM(PG + 3); }
            if (IN(PG + 4)) {
                ArgsP A = args_ptr(); bf16_t* const W = WSP(bf16_t, WS_W); pg8::Gemm g{WSP(bf16_t, WS_GCAT), W + W_O, DM, MG, DM, DM}; pg8::StaticOrder S; S.init(MG, DM, C.G, C.bid);
                pg8::EpiResid E{A->out + r0 * DM, A->out + r0 * DM, WSP(bf16_t, WS_XB) + r0 * DM, 1.0f, WSP(float, WS_SS0) + r0 * 4, (LAS float*)(C.lds + LDS_SSQ)}; GEMM_CALL(6, pg8::gemm_phase(C.lds, g, S, E));
                if (gi == NGRP - 1) SEAM(PG + 4); }
        }
        if (IN(P0 + 15)) {
            ArgsP A = args_ptr(); bf16_t* const W = WSP(bf16_t, WS_W); pg8::Gemm g{WSP(bf16_t, WS_XB), W + W_GU2, DM, MTOK, 2 * DFF, DM}; pg8::StaticOrder S; S.init(MTOK, 2 * DFF, C.G, C.bid);
            pg8::EpiSwiglu E{WSP(bf16_t, WS_HID), WSP(float, WS_SS0)}; GEMM_CALL(7, pg8::gemm_phase(C.lds, g, S, E)); SEAM(P0 + 15); }
        if (IN(P0 + 16)) {
            ArgsP A = args_ptr(); bf16_t* const W = WSP(bf16_t, WS_W); pg8::Gemm g{WSP(bf16_t, WS_HID), W + W_DN2, DFF, MTOK, DM, DFF}; pg8::StaticOrder S; S.init(MTOK, DM, C.G, C.bid);
            pg8::EpiResid E{A->out, A->out, WSP(bf16_t, WS_XB), 0.5f, WSP(float, WS_SS1), (LAS float*)(C.lds + LDS_SSQ)}; GEMM_CALL(8, pg8::gemm_phase(C.lds, g, S, E)); SEAM(P0 + 16); }
        if (IN(P0 + 18)) {
            ArgsP A = args_ptr(); bf16_t* const W = WSP(bf16_t, WS_W); pg8::Gemm g{WSP(bf16_t, WS_PB), W + W_PP, DPLE, MTOK, DM, DPLE}; pg8::StaticOrder S; S.init(MTOK, DM, C.G, C.bid);
            pg8::EpiBf16 E{WSP(bf16_t, WS_PP), DM, nullptr}; GEMM_CALL(9, pg8::gemm_phase(C.lds, g, S, E)); __syncthreads(); }
        if (IN(P0 + 19)) {
            ArgsP A = args_ptr(); bf16_t* const W = WSP(bf16_t, WS_W); pg8::Gemm g{WSP(bf16_t, WS_XB), W + W_PG, DM, MTOK, DM, DM}; pg8::StaticOrder S; S.init(MTOK, DM, C.G, C.bid);
            pg8::EpiPle E{A->out, WSP(bf16_t, WS_XB), WSP(bf16_t, WS_PP), WSP(float, WS_SS1), WSP(float, WS_SS0), (LAS float*)(C.lds + LDS_SSQ), (l + 1 < DEPTH) ? 1 : 0}; GEMM_CALL(10, pg8::gemm_phase(C.lds, g, S, E)); SEAM(P0 + 19); }
    }
    if (IN(N_PHASES - 1)) phase_final(C);
#undef IN
#undef SEAM
}

extern "C" void kernel_launch(void* const* d_in, const int* in_sizes, int n_in, void* d_out, int out_size, void* d_ws, size_t ws_size, hipStream_t stream) {
    static int grid = 0;
    if (grid == 0) {
        if (n_in != 22 || out_size != MTOK * DM || ws_size < WS_END) { fprintf(stderr, "kernel_launch: unexpected shapes (n_in %d out %d ws %zu, need %zu)\n", n_in, out_size, ws_size, (size_t)WS_END); grid = -1; return; }
        int dev = 0, cus = 0, per_cu = 0;
        if (hipGetDevice(&dev) != hipSuccess || hipDeviceGetAttribute(&cus, hipDeviceAttributeMultiprocessorCount, dev) != hipSuccess) { grid = -1; return; }
        if (hipFuncSetAttribute((const void*)mk_fwd, hipFuncAttributeMaxDynamicSharedMemorySize, LDS_BYTES) != hipSuccess) { fprintf(stderr, "kernel_launch: hipFuncSetAttribute failed\n"); grid = -1; return; }
        if (hipOccupancyMaxActiveBlocksPerMultiprocessor(&per_cu, (const void*)mk_fwd, NTHR, LDS_BYTES) != hipSuccess || per_cu < 1) { fprintf(stderr, "kernel_launch: occupancy query says %d\n", per_cu); (void)hipGetLastError(); grid = -1; return; }
        grid = cus;
    }
    if (grid < 0) return;
    if (hipMemsetAsync((char*)d_ws + WS_CTL, 0, CTL_ZERO_BYTES, stream) != hipSuccess) return;
    Args a{};
    for (int i = 0; i < 22; ++i) a.in[i] = (const float*)d_in[i];
    a.out = (float*)d_out; a.ws = (unsigned char*)d_ws;
#if MK_N_LAUNCHES == 1
    a.ph_lo = 0; a.ph_hi = N_PHASES;
    hipLaunchKernelGGL(mk_fwd, dim3(grid), dim3(NTHR), LDS_BYTES, stream, a);
#else
    for (int p = 0; p < N_PHASES; ++p) { a.ph_lo = p; a.ph_hi = p + 1; hipLaunchKernelGGL(mk_fwd, dim3(grid), dim3(NTHR), LDS_BYTES, stream, a); }
#endif
}
```

```cpp
#include <hip/hip_runtime.h>
#include <cstdio>
#include <cstdint>

#ifndef MK_N_LAUNCHES
#define MK_N_LAUNCHES 1
#endif

constexpr int BATCH = 16, SEQ = 4096, DM = 1024, DEPTH = 2, DPLE = 256, DFF = 2816, DCONV = 512;
constexpr int MTOK = BATCH * SEQ;
constexpr int NGRP = 2, GB = BATCH / NGRP, MG = GB * SEQ;
constexpr int LDP = 8704;
constexpr int O_CC = 0, O_CX = 512, O_MQ = 1024, O_MK = 1536, O_MV = 2048, O_CB = 3072, O_MO = 3584, O_AQ = 4608, O_G = 5120, O_AK = 8192, O_AV = 8256,
              O_IQ = 8320, O_IK = 8576, O_MI = 8640, O_MF = 8644, O_IW = 8648;
constexpr int LDS_ = 512, O_SIDE = 8192;
constexpr float EPS = 1e-6f;

constexpr size_t W_GU1 = 0, W_DN1 = W_GU1 + (size_t)5632 * 1024, W_IN = W_DN1 + (size_t)1024 * 2816, W_MRG = W_IN + (size_t)LDP * 1024,
                 W_O = W_MRG + (size_t)1024 * 2048, W_GU2 = W_O + (size_t)1024 * 1024,
                 W_DN2 = W_GU2 + (size_t)5632 * 1024, W_PG = W_DN2 + (size_t)1024 * 2816, W_PP = W_PG + (size_t)1024 * 1024, W_END = W_PP + (size_t)1024 * 256;

constexpr size_t MiB = 1u << 20;
constexpr size_t WS_CTL = 0, CTL_ZERO_BYTES = 64 * 1024;
constexpr size_t WS_W = 1 * MiB;
constexpr size_t WS_XB = 65 * MiB;
constexpr size_t WS_SS0 = 193 * MiB, WS_SS1 = 194 * MiB;
constexpr size_t WS_SCR = 198 * MiB;
constexpr size_t WS_BIG = 206 * MiB;
constexpr size_t WS_PROJ = WS_BIG;
constexpr size_t WS_GCAT = WS_BIG + 544 * MiB;
constexpr size_t WS_SIDE = WS_GCAT + 64 * MiB;
constexpr size_t WS_HID = WS_BIG;
constexpr size_t WS_PB = WS_BIG + 640 * MiB;
constexpr size_t WS_PP = WS_BIG + 384 * MiB;
constexpr size_t WS_KC = WS_BIG + 672 * MiB;
constexpr size_t WS_KCL = WS_BIG + 736 * MiB;
constexpr size_t WS_END = WS_BIG + 800 * MiB;
static_assert(W_END * 2 <= 64 * MiB, "weights fit");
constexpr int CW_BAR = 4096;
constexpr int CW_Q = 8192;

constexpr int RING_BYTES = 131072, LDSCTL_OFF = RING_BYTES, MISC_OFF = LDSCTL_OFF + 320, LDS_BYTES = 147456;
constexpr int NWAVES = 8, NTHR = 512;

#define GAS __attribute__((address_space(1)))
#define LAS __attribute__((address_space(3)))
typedef unsigned short bf16_t;
typedef short bf16x8 __attribute__((ext_vector_type(8)));
typedef short bf16x4 __attribute__((ext_vector_type(4)));
typedef float f32x4 __attribute__((ext_vector_type(4)));
typedef float f32x16 __attribute__((ext_vector_type(16)));
typedef unsigned u32x4 __attribute__((ext_vector_type(4)));
typedef unsigned u32x2 __attribute__((ext_vector_type(2)));
typedef __bf16 bf2_t __attribute__((ext_vector_type(2)));

__device__ __forceinline__ unsigned pk2(float lo, float hi) { bf2_t v = {(__bf16)lo, (__bf16)hi}; return __builtin_bit_cast(unsigned, v); }
__device__ __forceinline__ bf16_t f2bf(float x) { __bf16 v = (__bf16)x; return __builtin_bit_cast(bf16_t, v); }
__device__ __forceinline__ float bf2f(bf16_t b) { return __uint_as_float(((unsigned)b) << 16); }
__device__ __forceinline__ float bflo(unsigned w) { return __uint_as_float(w << 16); }
__device__ __forceinline__ float bfhi(unsigned w) { return __uint_as_float(w & 0xffff0000u); }
__device__ __forceinline__ float fsigmoid(float x) { return __builtin_amdgcn_rcpf(1.0f + __expf(-x)); }
__device__ __forceinline__ float rstd_from(const f32x4 p) { return __builtin_amdgcn_rsqf(((p[0] + p[1]) + (p[2] + p[3])) * (1.0f / DM) + EPS); }
__device__ __forceinline__ void rstd8(const float* ss, int row0, float mul, float (&rs)[8]) {
    f32x4 t[8];
#pragma unroll
    for (int i = 0; i < 8; ++i) t[i] = *(const f32x4*)(ss + (size_t)(row0 + (i >> 2) * 128 + (i & 3) * 16) * 4);
    asm volatile("" : "+v"(t[0]), "+v"(t[1]), "+v"(t[2]), "+v"(t[3]), "+v"(t[4]), "+v"(t[5]), "+v"(t[6]), "+v"(t[7]));
#pragma unroll
    for (int i = 0; i < 8; ++i) rs[i] = rstd_from(t[i]) * mul;
}
__device__ __forceinline__ float rstd_of(const float* ss4) { const f32x4 p = *(const f32x4*)ss4; return 1.0f / sqrtf(((p[0] + p[1]) + (p[2] + p[3])) * (1.0f / DM) + EPS); }
constexpr int LDS_SSQ = RING_BYTES + 1024;
__device__ __forceinline__ float wave_sum(float v) {
#pragma unroll
    for (int o = 1; o < 64; o <<= 1) v += __shfl_xor(v, o);
    return v;
}

namespace pg8 {
#ifndef PG8_ALIGN
#define PG8_ALIGN 1
#endif
constexpr bool ALIGN_EPI = PG8_ALIGN;
constexpr int BM = 256, BK = 64, HALF = 128, HTB = HALF * BK * 2, STAGE_BYTES = 8 * HTB, NXCD = 8, WGM = 8;
__host__ __device__ __forceinline__ int lds_byte(int r, int c) { const int st = (r >> 4) * 2 + (c >> 5), rr = r & 15, cc = c & 31, ob = rr * 64 + cc * 2; return st * 1024 + (ob ^ (((ob >> 9) & 1) << 5)); }
__host__ __device__ __forceinline__ void stage_rc(int b, int& R, int& C) { const int st = b / 1024, sb = b % 1024, swz = sb ^ (((sb >> 9) & 1) << 5); R = (st >> 1) * 16 + swz / 64; C = (st & 1) * 32 + (swz % 64) / 2; }
__host__ __device__ __forceinline__ int perm32(int rho) { const int n = rho >> 4, i = rho & 15; return 8 * (i >> 2) + 4 * n + (i & 3); }
struct Unit { int pm, pn; };
struct Gemm { const bf16_t* A; const bf16_t* Bt; int lda, M, N, K; };
struct StaticOrder {
    int nM, nN, nwg, G, c;
    __host__ __device__ void init(int M, int N, int G_, int c_) { nM = M / BM; nN = N / BM; nwg = nM * nN; G = G_; c = c_; }
    __host__ __device__ bool next(int i, Unit& u) const {
        const long L = (long)i * G + c; if (L >= nwg) return false;
        int wgid = (int)L; { const int q = nwg / NXCD, r = nwg % NXCD, xcd = wgid % NXCD, off = wgid / NXCD; wgid = (xcd < r ? xcd * (q + 1) : r * (q + 1) + (xcd - r) * q) + off; }
        const int nig = WGM * nN, gid = wgid / nig, fm = gid * WGM, gsz = (nM - fm) < WGM ? (nM - fm) : WGM;
        u.pm = fm + ((wgid % nig) % gsz); u.pn = (wgid % nig) / gsz; return true;
    }
};
typedef f32x4 Acc[2][2][4][2];

struct EpiSwiglu {
    bf16_t* H; const float* ss;
    __device__ __forceinline__ void operator()(const Acc& acc, const Unit& u, int wr, int wc, int fr, int fq) const {
        const int row0 = u.pm * BM + wr * 64 + fr, col0 = u.pn * 128 + wc * 32 + 8 * fq;
        float rs[8]; rstd8(ss, row0, 1.0f, rs);
#pragma unroll
        for (int ai = 0; ai < 2; ++ai)
#pragma unroll
            for (int m = 0; m < 4; ++m) { const int row = row0 + ai * HALF + m * 16; const float r = rs[ai * 4 + m];
                float h[8];
#pragma unroll
                for (int n = 0; n < 2; ++n)
#pragma unroll
                    for (int j = 0; j < 4; ++j) { const float g = acc[ai][0][m][n][j] * r, uu = acc[ai][1][m][n][j] * r; h[n * 4 + j] = g * fsigmoid(g) * uu; }
                u32x4 w; w.x = pk2(h[0], h[1]); w.y = pk2(h[2], h[3]); w.z = pk2(h[4], h[5]); w.w = pk2(h[6], h[7]);
                *(u32x4*)(H + (size_t)row * DFF + col0) = w; }
    }
};
struct EpiResid {
    const float* Xin; float* X; bf16_t* XB; float scale; float* SS; LAS float* lq;
    __device__ __forceinline__ void operator()(const Acc& acc, const Unit& u, int wr, int wc, int fr, int fq) const {
        const int row0 = u.pm * BM + wr * 64 + fr, col0 = u.pn * BM + wc * 32 + 8 * fq;
#pragma unroll
        for (int ai = 0; ai < 2; ++ai)
#pragma unroll
            for (int m = 0; m < 4; ++m) { const int row = row0 + ai * HALF + m * 16; const size_t off = (size_t)row * DM + col0; float sq = 0.f;
#pragma unroll
                for (int bj = 0; bj < 2; ++bj) { float* xp = X + off + bj * HALF; const float* xi = Xin + off + bj * HALF;
                    f32x4 a = *(const f32x4*)xi, b = *(const f32x4*)(xi + 4);
                    a = a + acc[ai][bj][m][0] * scale; b = b + acc[ai][bj][m][1] * scale;
                    *(f32x4*)xp = a; *(f32x4*)(xp + 4) = b;
                    sq += (a[0] * a[0] + a[1] * a[1]) + (a[2] * a[2] + a[3] * a[3]) + (b[0] * b[0] + b[1] * b[1]) + (b[2] * b[2] + b[3] * b[3]);
                    u32x4 w; w.x = pk2(a[0], a[1]); w.y = pk2(a[2], a[3]); w.z = pk2(b[0], b[1]); w.w = pk2(b[2], b[3]);
                    *(u32x4*)(XB + off + bj * HALF) = w; }
                sq += __shfl_xor(sq, 16); sq += __shfl_xor(sq, 32);
                if (fq == 0) lq[wc * 256 + (ai * HALF + wr * 64 + m * 16 + fr)] = sq;
                asm volatile("" ::: "memory"); }
        asm volatile("s_waitcnt lgkmcnt(0)" ::: "memory"); __builtin_amdgcn_s_barrier(); asm volatile("" ::: "memory");
        if (wr == 0) { const int rr = wc * 64 + fq * 16 + fr;
            SS[(size_t)(u.pm * BM + rr) * 4 + u.pn] = (lq[rr] + lq[256 + rr]) + (lq[512 + rr] + lq[768 + rr]); }
    }
};
struct EpiBf16 {
    bf16_t* O; int ldc; const float* rs;
    __device__ __forceinline__ void operator()(const Acc& acc, const Unit& u, int wr, int wc, int fr, int fq) const {
        const int row0 = u.pm * BM + wr * 64 + fr, col0 = u.pn * BM + wc * 32 + 8 * fq;
#pragma unroll
        for (int ai = 0; ai < 2; ++ai)
#pragma unroll
            for (int m = 0; m < 4; ++m) { const int row = row0 + ai * HALF + m * 16; const float r = rs ? rs[row] : 1.0f;
#pragma unroll
                for (int bj = 0; bj < 2; ++bj) { const f32x4 a = acc[ai][bj][m][0] * r, b = acc[ai][bj][m][1] * r;
                    u32x4 w; w.x = pk2(a[0], a[1]); w.y = pk2(a[2], a[3]); w.z = pk2(b[0], b[1]); w.w = pk2(b[2], b[3]);
                    *(u32x4*)(O + (size_t)row * ldc + col0 + bj * HALF) = w; } }
    }
};
constexpr float AQ_SCALE = 0.125f * 1.4426950408889634f;
struct EpiProj {
    bf16_t* O; const float* ss; bf16_t* SIDE;
    __device__ __forceinline__ void operator()(const Acc& acc, const Unit& u, int wr, int wc, int fr, int fq) const {
        const int row0 = u.pm * BM + wr * 64 + fr; int col0 = u.pn * BM + wc * 32 + 8 * fq;
        const bool sg = (u.pn >= O_G / BM) && (u.pn < O_AK / BM);
        const float qs = (u.pn >= O_AQ / BM && u.pn < O_G / BM) ? AQ_SCALE : 1.0f;
        bf16_t* base = O; int ldc = LDP;
        if (u.pn >= O_SIDE / BM) { base = SIDE; ldc = LDS_; col0 -= O_SIDE; }
        float rs[8]; rstd8(ss, row0, qs, rs);
#pragma unroll
        for (int ai = 0; ai < 2; ++ai)
#pragma unroll
            for (int m = 0; m < 4; ++m) { const int row = row0 + ai * HALF + m * 16; const float r = rs[ai * 4 + m];
#pragma unroll
                for (int bj = 0; bj < 2; ++bj) { f32x4 a = acc[ai][bj][m][0] * r, b = acc[ai][bj][m][1] * r;
                    if (sg) {
#pragma unroll
                        for (int j = 0; j < 4; ++j) { a[j] = fmaxf(fsigmoid(a[j]), 1e-10f); b[j] = fmaxf(fsigmoid(b[j]), 1e-10f); } }
                    u32x4 w; w.x = pk2(a[0], a[1]); w.y = pk2(a[2], a[3]); w.z = pk2(b[0], b[1]); w.w = pk2(b[2], b[3]);
                    *(u32x4*)(base + (size_t)row * ldc + col0 + bj * HALF) = w; } }
    }
};
struct MergeHook {
    static constexpr bool ON = true;
    const bf16_t* S;
    __device__ __forceinline__ void operator()(Acc& acc, const Unit& u, int t, int wr, int wc, int fr, int fq) const {
        if (t != 8 && t != 24) return;
        int row0 = u.pm * BM + wr * 64 + fr, col0 = u.pn * BM + wc * 32 + 8 * fq + ((t == 8) ? 0 : DM);
        asm volatile("" : "+v"(row0), "+v"(col0));
#pragma unroll
        for (int ai = 0; ai < 2; ++ai) {
            u32x4 nv[4][2], dv[4][2];
#pragma unroll
            for (int m = 0; m < 4; ++m)
#pragma unroll
                for (int bj = 0; bj < 2; ++bj) { const bf16_t* gp = S + (size_t)(row0 + ai * HALF + m * 16) * LDP + col0 + bj * HALF; nv[m][bj] = *(const u32x4*)gp; dv[m][bj] = *(const u32x4*)(gp + DM); }
            asm volatile("" : "+v"(nv[0][0]), "+v"(nv[0][1]), "+v"(nv[1][0]), "+v"(nv[1][1]), "+v"(nv[2][0]), "+v"(nv[2][1]), "+v"(nv[3][0]), "+v"(nv[3][1]),
                              "+v"(dv[0][0]), "+v"(dv[0][1]), "+v"(dv[1][0]), "+v"(dv[1][1]), "+v"(dv[2][0]), "+v"(dv[2][1]), "+v"(dv[3][0]), "+v"(dv[3][1]));
#pragma unroll
            for (int m = 0; m < 4; ++m)
#pragma unroll
                for (int bj = 0; bj < 2; ++bj) { const u32x4 n = nv[m][bj], d = dv[m][bj];
                    f32x4 ra, rb;
                    ra[0] = bflo(n.x) * __builtin_amdgcn_rcpf(bflo(d.x)); ra[1] = bfhi(n.x) * __builtin_amdgcn_rcpf(bfhi(d.x)); ra[2] = bflo(n.y) * __builtin_amdgcn_rcpf(bflo(d.y)); ra[3] = bfhi(n.y) * __builtin_amdgcn_rcpf(bfhi(d.y));
                    rb[0] = bflo(n.z) * __builtin_amdgcn_rcpf(bflo(d.z)); rb[1] = bfhi(n.z) * __builtin_amdgcn_rcpf(bfhi(d.z)); rb[2] = bflo(n.w) * __builtin_amdgcn_rcpf(bflo(d.w)); rb[3] = bfhi(n.w) * __builtin_amdgcn_rcpf(bfhi(d.w));
                    acc[ai][bj][m][0] *= ra; acc[ai][bj][m][1] *= rb; }
            asm volatile("" ::: "memory"); }
    }
};
struct NoHook { static constexpr bool ON = false; __device__ __forceinline__ void operator()(Acc&, const Unit&, int, int, int, int, int) const {} };
struct EpiMerge {
    bf16_t* O; const bf16_t* S2;
    __device__ __forceinline__ void operator()(const Acc& acc, const Unit& u, int wr, int wc, int fr, int fq) const {
        const int row0 = u.pm * BM + wr * 64 + fr, col0 = u.pn * BM + wc * 32 + 8 * fq;
#pragma unroll
        for (int ai = 0; ai < 2; ++ai)
#pragma unroll
            for (int m = 0; m < 4; ++m) { const int row = row0 + ai * HALF + m * 16;
#pragma unroll
                for (int bj = 0; bj < 2; ++bj) { const u32x4 g = *(const u32x4*)(S2 + (size_t)row * LDP + col0 + bj * HALF);
                    const f32x4 a = acc[ai][bj][m][0], b = acc[ai][bj][m][1];
                    u32x4 w;
                    w.x = pk2(a[0] * bflo(g.x), a[1] * bfhi(g.x)); w.y = pk2(a[2] * bflo(g.y), a[3] * bfhi(g.y));
                    w.z = pk2(b[0] * bflo(g.z), b[1] * bfhi(g.z)); w.w = pk2(b[2] * bflo(g.w), b[3] * bfhi(g.w));
                    *(u32x4*)(O + (size_t)row * DM + col0 + bj * HALF) = w; }
                asm volatile("" ::: "memory"); }
    }
};
struct EpiPle {
    float* X; bf16_t* XB; const bf16_t* PP; const float* ss; float* SSout; LAS float* lq;
    __device__ __forceinline__ void operator()(const Acc& acc, const Unit& u, int wr, int wc, int fr, int fq) const {
        const int row0 = u.pm * BM + wr * 64 + fr, col0 = u.pn * BM + wc * 32 + 8 * fq;
#pragma unroll
        for (int ai = 0; ai < 2; ++ai)
#pragma unroll
            for (int m = 0; m < 4; ++m) { const int row = row0 + ai * HALF + m * 16; const float r = rstd_of(ss + (size_t)row * 4); const size_t off = (size_t)row * DM + col0; float sq = 0.f;
#pragma unroll
                for (int bj = 0; bj < 2; ++bj) { float* xp = X + off + bj * HALF;
                    f32x4 a = *(const f32x4*)xp, b = *(const f32x4*)(xp + 4); const u32x4 p = *(const u32x4*)(PP + off + bj * HALF);
                    const f32x4 ga = acc[ai][bj][m][0] * r, gb = acc[ai][bj][m][1] * r;
                    a[0] += fsigmoid(ga[0]) * bflo(p.x); a[1] += fsigmoid(ga[1]) * bfhi(p.x); a[2] += fsigmoid(ga[2]) * bflo(p.y); a[3] += fsigmoid(ga[3]) * bfhi(p.y);
                    b[0] += fsigmoid(gb[0]) * bflo(p.z); b[1] += fsigmoid(gb[1]) * bfhi(p.z); b[2] += fsigmoid(gb[2]) * bflo(p.w); b[3] += fsigmoid(gb[3]) * bfhi(p.w);
                    *(f32x4*)xp = a; *(f32x4*)(xp + 4) = b;
                    sq += (a[0] * a[0] + a[1] * a[1]) + (a[2] * a[2] + a[3] * a[3]) + (b[0] * b[0] + b[1] * b[1]) + (b[2] * b[2] + b[3] * b[3]);
                    u32x4 w; w.x = pk2(a[0], a[1]); w.y = pk2(a[2], a[3]); w.z = pk2(b[0], b[1]); w.w = pk2(b[2], b[3]);
                    *(u32x4*)(XB + off + bj * HALF) = w; }
                sq += __shfl_xor(sq, 16); sq += __shfl_xor(sq, 32);
                if (fq == 0) lq[wc * 256 + (ai * HALF + wr * 64 + m * 16 + fr)] = sq;
                asm volatile("" ::: "memory"); }
        asm volatile("s_waitcnt lgkmcnt(0)" ::: "memory"); __builtin_amdgcn_s_barrier(); asm volatile("" ::: "memory");
        if (wr == 0) { const int rr = wc * 64 + fq * 16 + fr;
            SSout[(size_t)(u.pm * BM + rr) * 4 + u.pn] = (lq[rr] + lq[256 + rr]) + (lq[512 + rr] + lq[768 + rr]); }
    }
};

template <class Epi, class Hook = NoHook>
__device__ __forceinline__ void gemm_phase(LAS unsigned char* lds, const Gemm g, const StaticOrder& S, const Epi& E, const Hook H = Hook()) {
    int tid = threadIdx.x; asm volatile("" : "+v"(tid));
    const int wid = __builtin_amdgcn_readfirstlane(tid >> 6), lane = tid & 63, wr = wid >> 2, wc = wid & 3, fr = lane & 15, fq = lane >> 4;
    const int K = g.K, nt = K / BK, lda = g.lda;
    unsigned voffA[2], voffB[2];
#pragma unroll
    for (int i = 0; i < 2; ++i) { int R, C; stage_rc(tid * 16 + i * 8192, R, C); const int Rb = (R & ~31) + perm32(R & 31);
        voffA[i] = (unsigned)(R * lda + C) * 2u; voffB[i] = (unsigned)(Rb * K + C) * 2u; }
    const size_t kstep = (size_t)(BK * 2);
    const size_t hstepA = (size_t)HALF * lda * 2, tstepA = 2 * hstepA;
    const size_t hstepB = (size_t)HALF * K * 2, tstepB = 2 * hstepB;
    const unsigned ldsw = (unsigned)wid * 1024u;
    const int aoff = lds_byte(wr * 64 + fr, fq * 8), boff = lds_byte(wc * 32 + fr, fq * 8);
#define PG8_SA(b, h) (((b) * 2 + (h)) * HTB)
#define PG8_SB(b, h) ((4 + (b) * 2 + (h)) * HTB)
#define PG8_STAGE(bufoff, gbase, voff) do { _Pragma("unroll") for (int _i = 0; _i < 2; ++_i) \
        __builtin_amdgcn_global_load_lds((const unsigned*)((const char*)(gbase) + (voff)[_i]), (LAS unsigned*)(lds + (bufoff) + ldsw + _i * 8192), 16, 0, 0); } while (0)
#define PG8_LDA(dst, b, h) do { _Pragma("unroll") for (int m = 0; m < 4; ++m) _Pragma("unroll") for (int k = 0; k < 2; ++k) dst[m][k] = *(const LAS bf16x8*)(lds + PG8_SA(b, h) + aoff + m * 2048 + k * 1024); } while (0)
#define PG8_LDB(dst, b, h) do { _Pragma("unroll") for (int n = 0; n < 2; ++n) _Pragma("unroll") for (int k = 0; k < 2; ++k) dst[n][k] = *(const LAS bf16x8*)(lds + PG8_SB(b, h) + boff + n * 2048 + k * 1024); } while (0)
#define PG8_MMA(ai, bj, At, Bt) do { __builtin_amdgcn_s_setprio(1); _Pragma("unroll") for (int m = 0; m < 4; ++m) _Pragma("unroll") for (int n = 0; n < 2; ++n) _Pragma("unroll") for (int k = 0; k < 2; ++k) \
        acc[ai][bj][m][n] = __builtin_amdgcn_mfma_f32_16x16x32_bf16(Bt[n][k], At[m][k], acc[ai][bj][m][n], 0, 0, 0); __builtin_amdgcn_s_setprio(0); } while (0)
#define PG8_WAIT_V(n) asm volatile("s_waitcnt vmcnt(" #n ")" ::: "memory")
#define PG8_WAIT_L(n) asm volatile("s_waitcnt lgkmcnt(" #n ")" ::: "memory")
#define PG8_BAR __builtin_amdgcn_s_barrier()
#define PG8_SCHED __builtin_amdgcn_sched_barrier(0)
    Unit cur, nxt; int ui = 0;
    if (!S.next(0, cur)) return;
    Acc acc;
#pragma unroll
    for (int a = 0; a < 2; ++a)
#pragma unroll
        for (int b = 0; b < 2; ++b)
#pragma unroll
            for (int m = 0; m < 4; ++m)
#pragma unroll
                for (int n = 0; n < 2; ++n) acc[a][b][m][n] = (f32x4){0.f, 0.f, 0.f, 0.f};
    bf16x8 At[4][2], B0[2][2], B1[2][2];
    const char* cA = (const char*)g.A + (size_t)cur.pm * tstepA; const char* cB = (const char*)g.Bt + (size_t)cur.pn * tstepB;
    PG8_STAGE(PG8_SB(0, 0), cB, voffB); PG8_STAGE(PG8_SB(0, 1), cB + hstepB, voffB); PG8_STAGE(PG8_SA(0, 0), cA, voffA); PG8_STAGE(PG8_SA(0, 1), cA + hstepA, voffA);
    if (wr == 1) PG8_BAR;
    PG8_WAIT_V(2); PG8_BAR;
    PG8_STAGE(PG8_SB(1, 0), cB + kstep, voffB); PG8_STAGE(PG8_SA(1, 0), cA + kstep, voffA); PG8_STAGE(PG8_SB(1, 1), cB + hstepB + kstep, voffB);
    PG8_WAIT_V(6); PG8_BAR;
    for (;;) {
        const bool has_next = S.next(ui + 1, nxt);
        const char* nA = has_next ? (const char*)g.A + (size_t)nxt.pm * tstepA : cA; const char* nB = has_next ? (const char*)g.Bt + (size_t)nxt.pn * tstepB : cB;
#pragma unroll 1
        for (int t = 0; t < nt; t += 2) {
            const bool last = (t == nt - 2);
            const char* a1 = cA + (size_t)(t + 1) * kstep;
            const char* a2 = last ? nA : cA + (size_t)(t + 2) * kstep; const char* b2 = last ? nB : cB + (size_t)(t + 2) * kstep;
            const char* a3 = a2 + kstep; const char* b3 = b2 + kstep;
            if constexpr (Hook::ON) H(acc, cur, t, wr, wc, fr, fq);
            PG8_LDB(B0, 0, 0); PG8_LDB(B1, 0, 1); PG8_SCHED; PG8_LDA(At, 0, 0); PG8_STAGE(PG8_SA(1, 1), a1 + hstepA, voffA);
            PG8_WAIT_V(8); PG8_WAIT_L(0); PG8_BAR; PG8_MMA(0, 0, At, B0); PG8_MMA(0, 1, At, B1); PG8_BAR; PG8_SCHED;
            PG8_LDA(At, 0, 1); PG8_STAGE(PG8_SB(0, 0), b2, voffB); PG8_STAGE(PG8_SB(0, 1), b2 + hstepB, voffB); PG8_STAGE(PG8_SA(0, 0), a2, voffA);
            PG8_WAIT_V(8); PG8_WAIT_L(0); PG8_BAR; PG8_MMA(1, 0, At, B0); PG8_MMA(1, 1, At, B1); PG8_BAR; PG8_SCHED;
            PG8_LDB(B0, 1, 0); PG8_LDB(B1, 1, 1); PG8_SCHED; PG8_LDA(At, 1, 0); PG8_STAGE(PG8_SA(0, 1), a2 + hstepA, voffA);
            PG8_WAIT_V(8); PG8_WAIT_L(0); PG8_BAR; PG8_MMA(0, 0, At, B0); PG8_MMA(0, 1, At, B1); PG8_BAR; PG8_SCHED;
            PG8_LDA(At, 1, 1); PG8_STAGE(PG8_SB(1, 0), b3, voffB); PG8_STAGE(PG8_SB(1, 1), b3 + hstepB, voffB); PG8_STAGE(PG8_SA(1, 0), a3, voffA);
            PG8_WAIT_V(8); PG8_WAIT_L(0); PG8_BAR; PG8_MMA(1, 0, At, B0); PG8_MMA(1, 1, At, B1); PG8_BAR; PG8_SCHED;
        }
        if (ALIGN_EPI) { if (wr == 0) PG8_BAR; }
        E(acc, cur, wr, wc, fr, fq);
        if (!has_next) break;
#pragma unroll
        for (int a = 0; a < 2; ++a)
#pragma unroll
            for (int b = 0; b < 2; ++b)
#pragma unroll
                for (int m = 0; m < 4; ++m)
#pragma unroll
                    for (int n = 0; n < 2; ++n) acc[a][b][m][n] = (f32x4){0.f, 0.f, 0.f, 0.f};
        cur = nxt; cA = nA; cB = nB; ++ui;
        if (ALIGN_EPI) { if (wr == 1) PG8_BAR; }
    }
    PG8_WAIT_V(0);
    if (!ALIGN_EPI) { if (wr == 0) PG8_BAR; }
    PG8_BAR;
#undef PG8_SA
#undef PG8_SB
#undef PG8_STAGE
#undef PG8_LDA
#undef PG8_LDB
#undef PG8_MMA
#undef PG8_WAIT_V
#undef PG8_WAIT_L
#undef PG8_BAR
#undef PG8_SCHED
}
}

#define XB_TMO      128
#define XB_XCNT(j)  (256  + 64 * (j))
#define XB_XSUB(j)  (1280 + 64 * (j))
#define XB_XGEN(j)  (2304 + 64 * (j))
#define XB_TOP      3328
#define XB_TOPGEN   3392
#define XCD_BAR_WORDS 3456
#define XB_SPIN_CAP (1u << 18)
__device__ __forceinline__ unsigned xb_ld(unsigned* p)              { return __hip_atomic_load(p, __ATOMIC_RELAXED, __HIP_MEMORY_SCOPE_AGENT); }
__device__ __forceinline__ unsigned xb_add(unsigned* p, unsigned v) { return __hip_atomic_fetch_add(p, v, __ATOMIC_RELAXED, __HIP_MEMORY_SCOPE_AGENT); }
__device__ __forceinline__ unsigned xb_xcc_id() { return (unsigned)__builtin_amdgcn_s_getreg((3 << 11) | 20) & 0xFu; }
#define XB_SPIN(cond, bar) do { unsigned _sp = 0; while (cond) { __builtin_amdgcn_s_sleep(1); \
    if ((++_sp & 255u) == 0u) { if (xb_ld(&(bar)[XB_TMO])) break; if (_sp > XB_SPIN_CAP) { atomicAdd(&(bar)[XB_TMO], 1u); break; } } } } while (0)
struct XcdBarrier { unsigned* bar; unsigned x; volatile LAS unsigned* st; };
__device__ __forceinline__ XcdBarrier xcd_barrier_post(unsigned* bar, volatile LAS unsigned* st) {
    XcdBarrier b; b.bar = bar; b.x = xb_xcc_id(); b.st = st;
    if (threadIdx.x == 0) (void)xb_add(&bar[XB_XCNT(b.x)], 1u);
    return b;
}
__device__ __forceinline__ void xcd_barrier_complete(unsigned* bar, unsigned x, unsigned& nloc, unsigned& nx) {
    const unsigned G = gridDim.x * gridDim.y * gridDim.z;
    unsigned sum, cnt, mine, sp = 0u;
    for (;;) {
        sum = 0u; cnt = 0u; mine = 0u;
#pragma unroll
        for (unsigned j = 0; j < 16; ++j) { const unsigned c = xb_ld(&bar[XB_XCNT(j)]); sum += c; cnt += (c > 0u) ? 1u : 0u; mine = (j == x) ? c : mine; }
        if (sum == G) break;
        __builtin_amdgcn_s_sleep(1);
        if ((++sp & 255u) == 0u) { if (xb_ld(&bar[XB_TMO])) break; if (sp > XB_SPIN_CAP) { atomicAdd(&bar[XB_TMO], 1u); break; } }
    }
    nloc = mine > 0u ? mine : 1u; nx = cnt > 0u ? cnt : 1u;
}
__device__ __forceinline__ void xcd_barrier(const XcdBarrier& b) {
    asm volatile("s_waitcnt vmcnt(0)" ::: "memory");
    __syncthreads();
    if (threadIdx.x == 0) {
        unsigned* bar = b.bar;
        __builtin_amdgcn_s_waitcnt(0);
        unsigned nloc = b.st[0], nx = b.st[1];
        if (nloc == 0u) { xcd_barrier_complete(bar, b.x, nloc, nx); b.st[0] = nloc; b.st[1] = nx; }
        const unsigned old = xb_add(&bar[XB_XSUB(b.x)], 1u);
        const unsigned gen = old / nloc;
        if (old + 1u == (gen + 1u) * nloc) {
            __builtin_amdgcn_fence(__ATOMIC_RELEASE, "agent");
            asm volatile("s_waitcnt vmcnt(0)" ::: "memory");
            const unsigned og = xb_add(&bar[XB_TOP], 1u);
            const unsigned tg = og / nx;
            if (og + 1u == (tg + 1u) * nx) xb_add(&bar[XB_TOPGEN], 1u);
            else XB_SPIN(xb_ld(&bar[XB_TOPGEN]) == tg, bar);
            __builtin_amdgcn_fence(__ATOMIC_ACQUIRE, "agent");
            xb_add(&bar[XB_XGEN(b.x)], 1u);
            asm volatile("s_waitcnt vmcnt(0)" ::: "memory");
        } else {
            XB_SPIN(xb_ld(&bar[XB_XGEN(b.x)]) == gen, bar);
            __builtin_amdgcn_fence(__ATOMIC_ACQUIRE, "agent");
            asm volatile("s_waitcnt vmcnt(0)" ::: "memory");
        }
    }
    __syncthreads();
}

struct Args { const float* in[22]; float* out; unsigned char* ws; int ph_lo, ph_hi; };
struct Ctx { LAS unsigned char* lds; int G, bid; };
#define TID_SETUP() int tid = threadIdx.x; asm volatile("" : "+v"(tid)); const int lane = tid & 63, wave = __builtin_amdgcn_readfirstlane(tid >> 6); (void)lane; (void)wave
typedef const __attribute__((address_space(4))) Args* ArgsP;
__device__ __forceinline__ ArgsP args_ptr() { ArgsP p = (ArgsP)__builtin_amdgcn_kernarg_segment_ptr(); asm volatile("" : "+s"(p)); return p; }
#define WSP(T, off) ((T*)(A->ws + (off)))

struct MapId { __device__ __forceinline__ int operator()(int n) const { return n; } };
struct MapGU { __device__ __forceinline__ int operator()(int n) const { const int t = n >> 8, w = n & 255; return w < 128 ? 128 * t + w : DFF + 128 * t + (w - 128); } };
struct MapIn { __device__ __forceinline__ int operator()(int n) const {
    if (n < 3072) return n + 512; if (n < 3584) return n - 3072; if (n < 4608) return n; if (n < 5120) return n + 8; if (n < 8192) return n + 460; if (n < 8640) return n - 3064;
    if (n < 8644) return 4608 + (n - 8640); if (n < 8648) return 4612 + (n - 8644); if (n < 8652) return 5576 + (n - 8648); return -1; } };
template <class Map>
__device__ __forceinline__ void conv_item(const float* W, int K, int N, bf16_t* WT, int ldt, int koff, const float* gain, LAS float* scr, int item, int nblk, int lane, Map map) {
    const int kb = item / nblk, nb = item % nblk, k0 = 64 * kb, n0 = 32 * nb;
    const int c = map(n0 + (lane & 31));
    float wv[32];
#pragma unroll
    for (int i = 0; i < 32; ++i) { const int kk = 2 * i + (lane >> 5); wv[i] = (c >= 0) ? W[(size_t)(k0 + kk) * N + c] : 0.f; }
#pragma unroll
    for (int i = 0; i < 32; ++i) { const int kk = 2 * i + (lane >> 5); float v = wv[i]; if (gain) v *= gain[k0 + kk]; scr[kk * 33 + (lane & 31)] = v; }
    asm volatile("s_waitcnt lgkmcnt(0)" ::: "memory");
    const int c8 = lane & 7;
#pragma unroll
    for (int j = 0; j < 4; ++j) { const int n = (lane >> 3) + 8 * j; const LAS float* s = scr + (8 * c8) * 33 + n;
        u32x4 o; o.x = pk2(s[0 * 33], s[1 * 33]); o.y = pk2(s[2 * 33], s[3 * 33]); o.z = pk2(s[4 * 33], s[5 * 33]); o.w = pk2(s[6 * 33], s[7 * 33]);
        *(u32x4*)(WT + (size_t)(n0 + n) * ldt + koff + k0 + 8 * c8) = o; }
    asm volatile("s_waitcnt lgkmcnt(0)" ::: "memory");
}
__device__ __forceinline__ void phase_convert(const Ctx& C, int l) {
    TID_SETUP(); ArgsP A = args_ptr(); const int gw = C.bid * NWAVES + wave, NGW = C.G * NWAVES;
    LAS float* scr = (LAS float*)(C.lds + wave * 16384);
    bf16_t* W = WSP(bf16_t, WS_W);
    constexpr int I_GU = 16 * 176, I_DN = 44 * 32, I_IN = 16 * 272, I_CO = 8 * 32, I_MO = 16 * 32, I_AO = 8 * 32, I_O = 16 * 32, I_PG = 16 * 32, I_PP = 4 * 32;
    constexpr int NIT = 2 * I_GU + 2 * I_DN + I_IN + I_CO + I_MO + I_AO + I_O + I_PG + I_PP;
    for (int it = gw; it < NIT; it += NGW) {
        int r = it;
        if (r < I_GU) { conv_item(A->in[3] + (size_t)l * DM * 2 * DFF, DM, 2 * DFF, W + W_GU1, DM, 0, A->in[2] + (size_t)l * DM, scr, r, 176, lane, MapGU()); continue; } r -= I_GU;
        if (r < I_GU) { conv_item(A->in[16] + (size_t)l * DM * 2 * DFF, DM, 2 * DFF, W + W_GU2, DM, 0, A->in[15] + (size_t)l * DM, scr, r, 176, lane, MapGU()); continue; } r -= I_GU;
        if (r < I_DN) { conv_item(A->in[4] + (size_t)l * DFF * DM, DFF, DM, W + W_DN1, DFF, 0, nullptr, scr, r, 32, lane, MapId()); continue; } r -= I_DN;
        if (r < I_DN) { conv_item(A->in[17] + (size_t)l * DFF * DM, DFF, DM, W + W_DN2, DFF, 0, nullptr, scr, r, 32, lane, MapId()); continue; } r -= I_DN;
        if (r < I_IN) { conv_item(A->in[6] + (size_t)l * DM * 8652, DM, 8652, W + W_IN, DM, 0, A->in[5] + (size_t)l * DM, scr, r, 272, lane, MapIn()); continue; } r -= I_IN;
        if (r < I_CO) { conv_item(A->in[8] + (size_t)l * DCONV * DM, DCONV, DM, W + W_MRG, 2048, 0, nullptr, scr, r, 32, lane, MapId()); continue; } r -= I_CO;
        if (r < I_MO) { conv_item(A->in[12] + (size_t)l * DM * DM, DM, DM, W + W_MRG, 2048, 512, nullptr, scr, r, 32, lane, MapId()); continue; } r -= I_MO;
        if (r < I_AO) { conv_item(A->in[13] + (size_t)l * 512 * DM, 512, DM, W + W_MRG, 2048, 1536, nullptr, scr, r, 32, lane, MapId()); continue; } r -= I_AO;
        if (r < I_O) { conv_item(A->in[14] + (size_t)l * DM * DM, DM, DM, W + W_O, DM, 0, nullptr, scr, r, 32, lane, MapId()); continue; } r -= I_O;
        if (r < I_PG) { conv_item(A->in[19] + (size_t)l * DM * DM, DM, DM, W + W_PG, DM, 0, A->in[18] + (size_t)l * DM, scr, r, 32, lane, MapId()); continue; } r -= I_PG;
        conv_item(A->in[20] + (size_t)l * DPLE * DM, DPLE, DM, W + W_PP, DPLE, 0, nullptr, scr, r, 32, lane, MapId());
    }
}
__device__ __forceinline__ void phase_init_rows(const Ctx& C) {
    TID_SETUP(); ArgsP A = args_ptr(); const int gw = C.bid * NWAVES + wave, NGW = C.G * NWAVES;
    const float* x = A->in[0]; bf16_t* XB = WSP(bf16_t, WS_XB); float* SS0 = WSP(float, WS_SS0);
    for (int m0 = 4 * gw; m0 < MTOK; m0 += 4 * NGW) {
        f32x4 v[4][4];
#pragma unroll
        for (int k = 0; k < 4; ++k) { const int m = m0 + k; const f32x4* xr = (const f32x4*)(x + (size_t)m * DM) + lane;
#pragma unroll
            for (int j = 0; j < 4; ++j) v[k][j] = xr[64 * j]; }
#pragma unroll
        for (int k = 0; k < 4; ++k) { const int m = m0 + k;
            { u32x2* bo = (u32x2*)(XB + (size_t)m * DM) + lane; float s = 0.f;
#pragma unroll
                for (int j = 0; j < 4; ++j) { const f32x4 t = v[k][j]; u32x2 w; w.x = pk2(t[0], t[1]); w.y = pk2(t[2], t[3]); bo[64 * j] = w; s += (t[0] * t[0] + t[1] * t[1]) + (t[2] * t[2] + t[3] * t[3]); }
                s = wave_sum(s);
                if (lane == 0) *(f32x4*)(SS0 + (size_t)m * 4) = (f32x4){s, 0.f, 0.f, 0.f}; } }
    }
}
__device__ __forceinline__ void phase_pb(const Ctx& C, int l) {
    TID_SETUP(); ArgsP A = args_ptr();
    const f32x4* p = (const f32x4*)(A->in[1] + (size_t)l * MTOK * DPLE); u32x2* o = WSP(u32x2, WS_PB);
    const size_t n4 = (size_t)MTOK * DPLE / 4;
    for (size_t i = (size_t)C.bid * NTHR + tid; i < n4; i += (size_t)C.G * NTHR) { const f32x4 v = p[i]; u32x2 w; w.x = pk2(v[0], v[1]); w.y = pk2(v[2], v[3]); o[i] = w; }
}
__device__ __forceinline__ void phase_final(const Ctx& C) {
    TID_SETUP(); ArgsP A = args_ptr(); const int gw = C.bid * NWAVES + wave, NGW = C.G * NWAVES;
    const f32x4* gn = (const f32x4*)A->in[21] + lane; float* X = A->out; const float* SS = WSP(float, WS_SS0);
    f32x4 g4[4];
#pragma unroll
    for (int j = 0; j < 4; ++j) g4[j] = gn[64 * j];
    for (int m0 = 4 * gw; m0 < MTOK; m0 += 4 * NGW) {
        f32x4 v[4][4]; float r[4];
#pragma unroll
        for (int k = 0; k < 4; ++k) { const int m = m0 + k; const f32x4* xr = (const f32x4*)(X + (size_t)m * DM) + lane;
#pragma unroll
            for (int j = 0; j < 4; ++j) v[k][j] = xr[64 * j];
            r[k] = rstd_of(SS + (size_t)m * 4); }
#pragma unroll
        for (int k = 0; k < 4; ++k) { const int m = m0 + k;
            { f32x4* xr = (f32x4*)(X + (size_t)m * DM) + lane;
#pragma unroll
                for (int j = 0; j < 4; ++j) xr[64 * j] = v[k][j] * r[k] * g4[j]; } }
    }
}

__device__ __forceinline__ void prep_conv(const Ctx& C, int l, int b, int part, int nparts, int dry) {
    TID_SETUP(); ArgsP A = args_ptr();
    const float* cw = A->in[7] + (size_t)l * 3 * DCONV; bf16_t* PROJ = WSP(bf16_t, WS_PROJ);
    const int nit = SEQ * 64;
    for (int i = part * NTHR + tid; i < nit; i += nparts * NTHR) {
        const int ts = i >> 6, ch = (i & 63) * 8, tok = b * SEQ + ts;
        bf16_t* row = PROJ + (size_t)tok * LDP;
        const u32x4 b = *(const u32x4*)(row + O_CB + ch);
        float u[3][8];
#pragma unroll
        for (int d = 0; d < 3; ++d) {
            const int back = 2 - d;
            if (ts >= back) { const bf16_t* r2 = row - (size_t)back * LDP; const u32x4 c = *(const u32x4*)(r2 + O_CC + ch), x = *(const u32x4*)(r2 + O_CX + ch);
                const unsigned cwv[4] = {c.x, c.y, c.z, c.w}, xwv[4] = {x.x, x.y, x.z, x.w};
#pragma unroll
                for (int j = 0; j < 4; ++j) { u[d][2 * j] = bflo(cwv[j]) * bflo(xwv[j]); u[d][2 * j + 1] = bfhi(cwv[j]) * bfhi(xwv[j]); } }
            else {
#pragma unroll
                for (int j = 0; j < 8; ++j) u[d][j] = 0.f; }
        }
        const unsigned bw[4] = {b.x, b.y, b.z, b.w}; float o[8];
#pragma unroll
        for (int j = 0; j < 8; ++j) { const float bb = (j & 1) ? bfhi(bw[j >> 1]) : bflo(bw[j >> 1]);
            o[j] = bb * (u[0][j] * cw[ch + j] + u[1][j] * cw[DCONV + ch + j] + u[2][j] * cw[2 * DCONV + ch + j]); }
        u32x4 w; w.x = pk2(o[0], o[1]); w.y = pk2(o[2], o[3]); w.z = pk2(o[4], o[5]); w.w = pk2(o[6], o[7]);
        if (!dry) *(u32x4*)(row + O_CB + ch) = w;
    }
}
__device__ __forceinline__ void prep_gate(const Ctx& C, int l, int part, int nparts, int dry = 0) {
    TID_SETUP(); ArgsP A = args_ptr();
    const float* gn = A->in[11] + (size_t)l * DM; bf16_t* PROJ = WSP(bf16_t, WS_PROJ);
    const int nit = MG * 4, g = lane >> 4, li = lane & 15;
    for (int i = (part * NWAVES + wave) * 4 + g; i < nit; i += nparts * NWAVES * 4) {
        const int tok = i >> 2, hd = i & 3;
        bf16_t* row = PROJ + (size_t)tok * LDP;
        const u32x4 h0 = *(const u32x4*)(row + O_MV + hd * 256 + li * 16), h1 = *(const u32x4*)(row + O_MV + hd * 256 + li * 16 + 8);
        const u32x4 o0 = *(const u32x4*)(row + O_MO + hd * 256 + li * 16), o1 = *(const u32x4*)(row + O_MO + hd * 256 + li * 16 + 8);
        const unsigned hw[8] = {h0.x, h0.y, h0.z, h0.w, h1.x, h1.y, h1.z, h1.w}, ow[8] = {o0.x, o0.y, o0.z, o0.w, o1.x, o1.y, o1.z, o1.w};
        float ssq = 0.f;
#pragma unroll
        for (int j = 0; j < 8; ++j) { const float a = bflo(hw[j]), bb = bfhi(hw[j]); ssq += a * a + bb * bb; }
#pragma unroll
        for (int o = 1; o < 16; o <<= 1) ssq += __shfl_xor(ssq, o);
        const float r = 1.0f / sqrtf(ssq * (1.0f / 256.0f) + EPS);
        const f32x4* gp = (const f32x4*)(gn + hd * 256 + li * 16);
        unsigned w[8];
#pragma unroll
        for (int j = 0; j < 4; ++j) { const f32x4 gv = gp[j];
            w[2 * j] = pk2(fsigmoid(bflo(ow[2 * j])) * bflo(hw[2 * j]) * r * gv[0], fsigmoid(bfhi(ow[2 * j])) * bfhi(hw[2 * j]) * r * gv[1]);
            w[2 * j + 1] = pk2(fsigmoid(bflo(ow[2 * j + 1])) * bflo(hw[2 * j + 1]) * r * gv[2], fsigmoid(bfhi(ow[2 * j + 1])) * bfhi(hw[2 * j + 1]) * r * gv[3]); }
        if (!dry) { *(u32x4*)(row + O_MO + hd * 256 + li * 16) = (u32x4){w[0], w[1], w[2], w[3]}; *(u32x4*)(row + O_MO + hd * 256 + li * 16 + 8) = (u32x4){w[4], w[5], w[6], w[7]}; }
    }
}

namespace ml {
constexpr int QS = 0, KS = 17408, VS = 34816, VW = 44032, PS = 53248, CB = 62464, SC = 97280, NP = 99328, NV = 103424, MS = 103936, LEND = 104704;
constexpr int PQ = 272, PT = 144;
static_assert(LEND <= RING_BYTES, "mlstm LDS");
typedef short s16x4 __attribute__((ext_vector_type(4)));
__device__ __forceinline__ f32x4 mfma16(bf16x8 a, bf16x8 b, f32x4 c) { return __builtin_amdgcn_mfma_f32_16x16x32_bf16(a, b, c, 0, 0, 0); }
__device__ __forceinline__ bf16x8 ldsv(const LAS unsigned char* p) { return *(const LAS bf16x8*)p; }
__device__ __forceinline__ bf16x8 frag_tr(const LAS unsigned char* X, int P, int r0, int c0, int lane) {
    const int g = lane >> 4, li = lane & 15;
    const LAS unsigned char* p = X + (r0 + 8 * g + (li >> 2)) * P + (c0 + 4 * (li & 3)) * 2;
    const s16x4 lo = __builtin_amdgcn_ds_read_tr16_b64_v4i16((LAS s16x4*)p), hi = __builtin_amdgcn_ds_read_tr16_b64_v4i16((LAS s16x4*)(p + 4 * P));
    return __builtin_shufflevector(lo, hi, 0, 1, 2, 3, 4, 5, 6, 7);
}

__device__ __forceinline__ void unit(const Ctx& C, int l, int uidx, int dry) {
    TID_SETUP(); ArgsP A = args_ptr();
    const int b = uidx >> 4, hd = (uidx >> 2) & 3, vq = uidx & 3;
    LAS unsigned char* L = C.lds;
    LAS float* sc = (LAS float*)(L + SC);
    LAS float* npart = (LAS float*)(L + NP);
    LAS float* nv = (LAS float*)(L + NV);
    LAS float* ms = (LAS float*)(L + MS);
    const int w = wave, fr = lane & 15, fq = lane >> 4;
    const float bi = A->in[9][l * 4 + hd], bfg = A->in[10][l * 4 + hd];
    bf16_t* base = WSP(bf16_t, WS_PROJ) + (size_t)b * SEQ * LDP;
    float* scr = WSP(float, WS_SCR) + (size_t)uidx * (64 * 192);
    for (int c = w; c < SEQ / 64; c += NWAVES) {
        const bf16_t* rb = WSP(bf16_t, WS_SIDE) + (size_t)(b * SEQ + c * 64 + lane) * LDS_;
        const float fv = bf2f(rb[O_MF - O_SIDE + hd]) + bfg, iv = bf2f(rb[O_MI - O_SIDE + hd]) + bi;
        const float lf = fminf(fv, 0.f) - log1pf(__expf(-fabsf(fv)));
        float bt = lf;
#pragma unroll
        for (int o = 1; o < 64; o <<= 1) { const float t = __shfl_up(bt, o); if (lane >= o) bt += t; }
        const float a = iv - bt; float pm = a;
#pragma unroll
        for (int o = 1; o < 64; o <<= 1) { const float t = __shfl_up(pm, o); if (lane >= o) pm = fmaxf(pm, t); }
        scr[c * 192 + lane] = a; scr[c * 192 + 64 + lane] = pm; scr[c * 192 + 128 + lane] = bt;
        if (lane == 63) { ms[64 + c] = bt; ms[128 + c] = pm; }
    }
    f32x4 cst[4];
#pragma unroll
    for (int i = 0; i < 4; ++i) cst[i] = (f32x4){0.f, 0.f, 0.f, 0.f};
    for (int i = tid; i < 2 * 64 * PQ / 4; i += NTHR) ((LAS unsigned*)(L + CB))[i] = 0u;
    for (int i = tid; i < 8 * 128; i += NTHR) npart[i] = 0.f;
    if (tid < 128) nv[tid] = 0.f;
    __syncthreads();
    if (tid == 0) { float m = 0.f; for (int c = 0; c < SEQ / 64; ++c) { ms[c] = m; m = ms[64 + c] + fmaxf(m, ms[128 + c]); } }
    const int qr = tid >> 4, qc = (tid & 15) * 8;
    const int vr = tid >> 3, vc = (tid & 7) * 8;
    u32x4 rq[2], rk[2], rv; float ra = 0.f, rpm = 0.f, rbt = 0.f;
#define ML_ISSUE(cc) do { const bf16_t* rb = base + (size_t)((cc) * 64) * LDP; \
        rq[0] = *(const u32x4*)(rb + (size_t)qr * LDP + O_MQ + hd * 128 + qc); rq[1] = *(const u32x4*)(rb + (size_t)(qr + 32) * LDP + O_MQ + hd * 128 + qc); \
        rk[0] = *(const u32x4*)(rb + (size_t)qr * LDP + O_MK + hd * 128 + qc); rk[1] = *(const u32x4*)(rb + (size_t)(qr + 32) * LDP + O_MK + hd * 128 + qc); \
        rv = *(const u32x4*)(rb + (size_t)vr * LDP + O_MV + hd * 256 + vq * 64 + vc); \
        if (w == 0) { ra = scr[(cc) * 192 + lane]; rpm = scr[(cc) * 192 + 64 + lane]; rbt = scr[(cc) * 192 + 128 + lane]; } } while (0)
    __syncthreads();
    ML_ISSUE(0);
    float decay = 0.f;
    int cur = 0;
#pragma unroll 1
    for (int c = 0; c < SEQ / 64; ++c) {
#pragma unroll
        for (int i = 0; i < 2; ++i) {
            *(LAS u32x4*)(L + QS + (qr + 32 * i) * PQ + qc * 2) = rq[i];
            *(LAS u32x4*)(L + KS + (qr + 32 * i) * PQ + qc * 2) = rk[i];
        }
        *(LAS u32x4*)(L + VS + vr * PT + vc * 2) = rv;
        const u32x4 vkeep = rv;
        if (tid < 128) { float pn[8], nold = nv[tid];
#pragma unroll
            for (int j = 0; j < 8; ++j) pn[j] = npart[j * 128 + tid];
            asm volatile("" : "+v"(pn[0]), "+v"(pn[1]), "+v"(pn[2]), "+v"(pn[3]), "+v"(pn[4]), "+v"(pn[5]), "+v"(pn[6]), "+v"(pn[7]), "+v"(nold));
            float sn = 0.f;
#pragma unroll
            for (int j = 0; j < 8; ++j) sn += pn[j];
            nv[tid] = decay * nold + sn; }
        if (w == 0) {
            const float mc = ms[c], p63 = ms[128 + c];
            const float Mt = fmaxf(mc, rpm), M63 = fmaxf(mc, p63);
            sc[lane] = ra; sc[64 + lane] = Mt; sc[128 + lane] = __expf(mc - Mt); sc[192 + lane] = __expf(-(rbt + Mt)); sc[256 + lane] = __expf(ra - M63);
            if (lane == 0) sc[320] = __expf(mc - M63);
        }
        __syncthreads();
        decay = sc[320];
        if (c + 1 < SEQ / 64) ML_ISSUE(c + 1);
        { const float wk = sc[256 + vr]; const unsigned vw[4] = {vkeep.x, vkeep.y, vkeep.z, vkeep.w}; u32x4 o;
          o.x = pk2(bflo(vw[0]) * wk, bfhi(vw[0]) * wk); o.y = pk2(bflo(vw[1]) * wk, bfhi(vw[1]) * wk); o.z = pk2(bflo(vw[2]) * wk, bfhi(vw[2]) * wk); o.w = pk2(bflo(vw[3]) * wk, bfhi(vw[3]) * wk);
          *(LAS u32x4*)(L + VW + vr * PT + vc * 2) = o; }
        {
            const int ti = w >> 1;
            bf16x8 qa[4], kf[2][4];
#pragma unroll
            for (int kk = 0; kk < 4; ++kk) qa[kk] = ldsv(L + QS + (16 * ti + fr) * PQ + (32 * kk + 8 * fq) * 2);
#pragma unroll
            for (int s2 = 0; s2 < 2; ++s2)
#pragma unroll
                for (int kk = 0; kk < 4; ++kk) kf[s2][kk] = ldsv(L + KS + (16 * (2 * (w & 1) + s2) + fr) * PQ + (32 * kk + 8 * fq) * 2);
            f32x4 Mr = *(const LAS f32x4*)(sc + 64 + 16 * ti + 4 * fq);
            float as2[2] = {sc[16 * (2 * (w & 1)) + fr], sc[16 * (2 * (w & 1) + 1) + fr]};
            asm volatile("" : "+v"(qa[0]), "+v"(qa[1]), "+v"(qa[2]), "+v"(qa[3]), "+v"(kf[0][0]), "+v"(kf[0][1]), "+v"(kf[0][2]), "+v"(kf[0][3]),
                              "+v"(kf[1][0]), "+v"(kf[1][1]), "+v"(kf[1][2]), "+v"(kf[1][3]), "+v"(Mr), "+v"(as2[0]), "+v"(as2[1]));
#pragma unroll
            for (int s2 = 0; s2 < 2; ++s2) { const int si = 2 * (w & 1) + s2; f32x4 sa = (f32x4){0.f, 0.f, 0.f, 0.f};
#pragma unroll
                for (int kk = 0; kk < 4; ++kk) sa = mfma16(qa[kk], kf[s2][kk], sa);
                const int scol = 16 * si + fr; const float as = as2[s2];
#pragma unroll
                for (int r = 0; r < 4; ++r) { const int trow = 16 * ti + 4 * fq + r; const float p = (scol <= trow) ? sa[r] * __expf(as - Mr[r]) : 0.f;
                    *(LAS bf16_t*)(L + PS + trow * PT + scol * 2) = f2bf(p); } }
        }
        __syncthreads();
        {
            const int vi = w >> 1;
            bf16x8 va[2], kt[4][2];
#pragma unroll
            for (int kk = 0; kk < 2; ++kk) va[kk] = frag_tr(L + VW, PT, 32 * kk, 16 * vi, lane);
#pragma unroll
            for (int i = 0; i < 4; ++i)
#pragma unroll
                for (int kk = 0; kk < 2; ++kk) kt[i][kk] = frag_tr(L + KS, PQ, 32 * kk, 16 * (4 * (w & 1) + i), lane);
            asm volatile("" : "+v"(va[0]), "+v"(va[1]), "+v"(kt[0][0]), "+v"(kt[0][1]), "+v"(kt[1][0]), "+v"(kt[1][1]), "+v"(kt[2][0]), "+v"(kt[2][1]), "+v"(kt[3][0]), "+v"(kt[3][1]));
#pragma unroll
            for (int i = 0; i < 4; ++i) { const int di = 4 * (w & 1) + i; f32x4 a = cst[i] * decay;
#pragma unroll
                for (int kk = 0; kk < 2; ++kk) a = mfma16(va[kk], kt[i][kk], a);
                cst[i] = a;
#pragma unroll
                for (int r = 0; r < 4; ++r) *(LAS bf16_t*)(L + CB + (cur ^ 1) * 64 * PQ + (16 * vi + 4 * fq + r) * PQ + (16 * di + fr) * 2) = f2bf(a[r]); }
        }
        {
            float p0 = 0.f, p1 = 0.f; unsigned kw[8];
#pragma unroll
            for (int i = 0; i < 8; ++i) kw[i] = *(const LAS unsigned*)(L + KS + (8 * w + i) * PQ + lane * 4);
            f32x4 wk0 = *(const LAS f32x4*)(sc + 256 + 8 * w), wk1 = *(const LAS f32x4*)(sc + 256 + 8 * w + 4);
            asm volatile("" : "+v"(kw[0]), "+v"(kw[1]), "+v"(kw[2]), "+v"(kw[3]), "+v"(kw[4]), "+v"(kw[5]), "+v"(kw[6]), "+v"(kw[7]), "+v"(wk0), "+v"(wk1));
#pragma unroll
            for (int i = 0; i < 8; ++i) { const float wk = (i < 4) ? wk0[i & 3] : wk1[i & 3]; p0 += wk * bflo(kw[i]); p1 += wk * bfhi(kw[i]); }
            npart[w * 128 + 2 * lane] = p0; npart[w * 128 + 2 * lane + 1] = p1;
        }
        {
            const int ti = w >> 1;
            float nq = 0.f, ps = 0.f;
            { const LAS unsigned char* qrow = L + QS + (16 * ti + fr) * PQ + (32 * fq) * 2;
              const LAS unsigned char* prow = L + PS + (16 * ti + fr) * PT + (16 * fq) * 2;
              u32x4 qv[4], pv[2]; f32x4 nvv[8];
#pragma unroll
              for (int h4 = 0; h4 < 4; ++h4) qv[h4] = *(const LAS u32x4*)(qrow + h4 * 16);
#pragma unroll
              for (int i = 0; i < 8; ++i) nvv[i] = *(const LAS f32x4*)(nv + 32 * fq + 4 * i);
#pragma unroll
              for (int h2 = 0; h2 < 2; ++h2) pv[h2] = *(const LAS u32x4*)(prow + h2 * 16);
              asm volatile("" : "+v"(qv[0]), "+v"(qv[1]), "+v"(qv[2]), "+v"(qv[3]), "+v"(pv[0]), "+v"(pv[1]),
                                "+v"(nvv[0]), "+v"(nvv[1]), "+v"(nvv[2]), "+v"(nvv[3]), "+v"(nvv[4]), "+v"(nvv[5]), "+v"(nvv[6]), "+v"(nvv[7]));
#pragma unroll
              for (int h4 = 0; h4 < 4; ++h4) { const unsigned qw[4] = {qv[h4].x, qv[h4].y, qv[h4].z, qv[h4].w};
#pragma unroll
                  for (int j = 0; j < 4; ++j) { const int e0 = 8 * h4 + 2 * j; nq += nvv[e0 >> 2][e0 & 3] * bflo(qw[j]) + nvv[(e0 + 1) >> 2][(e0 + 1) & 3] * bfhi(qw[j]); } }
#pragma unroll
              for (int h2 = 0; h2 < 2; ++h2) { const unsigned pw[4] = {pv[h2].x, pv[h2].y, pv[h2].z, pv[h2].w};
#pragma unroll
                  for (int j = 0; j < 4; ++j) ps += bflo(pw[j]) + bfhi(pw[j]); } }
            { const auto a1 = __builtin_amdgcn_permlane16_swap(__float_as_uint(nq), __float_as_uint(nq), false, false); const auto b1 = __builtin_amdgcn_permlane16_swap(__float_as_uint(ps), __float_as_uint(ps), false, false);
              nq = __uint_as_float(a1[0]) + __uint_as_float(a1[1]); ps = __uint_as_float(b1[0]) + __uint_as_float(b1[1]);
              const auto a2 = __builtin_amdgcn_permlane32_swap(__float_as_uint(nq), __float_as_uint(nq), false, false); const auto b2 = __builtin_amdgcn_permlane32_swap(__float_as_uint(ps), __float_as_uint(ps), false, false);
              nq = __uint_as_float(a2[0]) + __uint_as_float(a2[1]); ps = __uint_as_float(b2[0]) + __uint_as_float(b2[1]); }
            const float den_own = sc[128 + 16 * ti + fr] * nq + ps;
            float wr4[4], em4[4], dn4[4];
#pragma unroll
            for (int r = 0; r < 4; ++r) { wr4[r] = sc[128 + 16 * ti + 4 * fq + r]; em4[r] = sc[192 + 16 * ti + 4 * fq + r]; dn4[r] = __shfl(den_own, 4 * fq + r); }
            asm volatile("" : "+v"(dn4[0]), "+v"(dn4[1]), "+v"(dn4[2]), "+v"(dn4[3]), "+v"(wr4[0]), "+v"(wr4[1]), "+v"(wr4[2]), "+v"(wr4[3]), "+v"(em4[0]), "+v"(em4[1]), "+v"(em4[2]), "+v"(em4[3]));
            bf16x8 qa[4], pa[2], cbf[2][4], vtf[2][2];
#pragma unroll
            for (int kk = 0; kk < 4; ++kk) qa[kk] = ldsv(L + QS + (16 * ti + fr) * PQ + (32 * kk + 8 * fq) * 2);
#pragma unroll
            for (int kk = 0; kk < 2; ++kk) pa[kk] = ldsv(L + PS + (16 * ti + fr) * PT + (32 * kk + 8 * fq) * 2);
#pragma unroll
            for (int v2 = 0; v2 < 2; ++v2) {
#pragma unroll
                for (int kk = 0; kk < 4; ++kk) cbf[v2][kk] = ldsv(L + CB + cur * 64 * PQ + (16 * (2 * (w & 1) + v2) + fr) * PQ + (32 * kk + 8 * fq) * 2);
#pragma unroll
                for (int kk = 0; kk < 2; ++kk) vtf[v2][kk] = frag_tr(L + VS, PT, 32 * kk, 16 * (2 * (w & 1) + v2), lane); }
            asm volatile("" : "+v"(qa[0]), "+v"(qa[1]), "+v"(qa[2]), "+v"(qa[3]), "+v"(pa[0]), "+v"(pa[1]), "+v"(cbf[0][0]), "+v"(cbf[0][1]), "+v"(cbf[0][2]), "+v"(cbf[0][3]),
                              "+v"(cbf[1][0]), "+v"(cbf[1][1]), "+v"(cbf[1][2]), "+v"(cbf[1][3]), "+v"(vtf[0][0]), "+v"(vtf[0][1]), "+v"(vtf[1][0]), "+v"(vtf[1][1]));
            const float kscale = 0.08838834764831845f;
#pragma unroll
            for (int v2 = 0; v2 < 2; ++v2) { const int vi = 2 * (w & 1) + v2; f32x4 a = (f32x4){0.f, 0.f, 0.f, 0.f};
#pragma unroll
                for (int kk = 0; kk < 4; ++kk) a = mfma16(qa[kk], cbf[v2][kk], a);
#pragma unroll
                for (int r = 0; r < 4; ++r) a[r] *= wr4[r];
#pragma unroll
                for (int kk = 0; kk < 2; ++kk) a = mfma16(pa[kk], vtf[v2][kk], a);
#pragma unroll
                for (int r = 0; r < 4; ++r) { const float hval = kscale * a[r] * __builtin_amdgcn_rcpf(fmaxf(kscale * fabsf(dn4[r]), em4[r]));
                    if (!dry) base[(size_t)(c * 64 + 16 * ti + 4 * fq + r) * LDP + O_MV + hd * 256 + vq * 64 + 16 * vi + fr] = f2bf(hval); } }
        }
        __syncthreads();
        cur ^= 1;
    }
#undef ML_ISSUE
}
}

namespace dsa {
constexpr int GT = 0, EQ = 16384, QST = 32768, HIST = 33280, HPITCH = 257, LIST = HIST + 32 * HPITCH * 4, LCAP = 64, CNT = LIST + 32 * LCAP * 4, KST = 33280, KBUF = 128 * 144, VST = KST + 2 * KBUF, LEND = VST + 2 * KBUF, EMK = LEND, EMKB = 8192;
static_assert(CNT + 512 <= LEND, "dsa LDS");
typedef short s16x4 __attribute__((ext_vector_type(4)));
static_assert(LEND <= RING_BYTES, "dsa LDS");
__device__ __forceinline__ f32x16 mfma32(bf16x8 a, bf16x8 b, f32x16 c) { return __builtin_amdgcn_mfma_f32_32x32x16_bf16(a, b, c, 0, 0, 0); }
__device__ __forceinline__ unsigned fkey(float s) { const unsigned u = __float_as_uint(s); return (u & 0x80000000u) ? ~u : (u | 0x80000000u); }
__device__ __forceinline__ unsigned lowbits(unsigned e, int k) { if (k >= (int)__popc(e)) return e; unsigned r = 0u; for (int i = 0; i < k; ++i) { const unsigned b = e & (0u - e); r |= b; e ^= b; } return r; }

#define DSA_LOADK(dst, tile) do { _Pragma("unroll") for (int kk = 0; kk < 4; ++kk) dst[kk] = *(const bf16x8*)(kbase + (size_t)((tile) * 32 + q) * LDS_ + (O_IK - O_SIDE) + kk * 16 + hf * 8); } while (0)
__device__ __forceinline__ void idx_scores(const bf16x8 (&ka)[4], const bf16x8 (&bq)[4][4], const float (&wq)[4], float (&sc)[16]) {
    f32x16 a[4];
#pragma unroll
    for (int h = 0; h < 4; ++h)
#pragma unroll
        for (int r = 0; r < 16; ++r) a[h][r] = 0.f;
#pragma unroll
    for (int kk = 0; kk < 4; ++kk)
#pragma unroll
        for (int h = 0; h < 4; ++h) a[h] = mfma32(ka[kk], bq[h][kk], a[h]);
#pragma unroll
    for (int r = 0; r < 16; ++r) {
        float v = wq[0] * __builtin_amdgcn_fmed3f(a[0][r], 0.f, 3.0e38f);
        v = fmaf(wq[1], __builtin_amdgcn_fmed3f(a[1][r], 0.f, 3.0e38f), v);
        v = fmaf(wq[2], __builtin_amdgcn_fmed3f(a[2][r], 0.f, 3.0e38f), v);
        sc[r] = fmaf(wq[3], __builtin_amdgcn_fmed3f(a[3][r], 0.f, 3.0e38f), v) + 0.0f; }
}

#define DSA_PRELOAD() do { DSA_LOADK(k0, min(w, tlast)); DSA_LOADK(k1, min(w + NWAVES, tlast)); } while (0)
#define DSA_DIAG_MASK() if (tile == qt) { _Pragma("unroll") for (int r = 0; r < 16; ++r) { const int pos = (r & 3) + 8 * (r >> 2) + 4 * hf; sc[r] = (pos <= q) ? sc[r] : -__builtin_inff(); } }
template <int PASS>
__device__ __forceinline__ void radix_pass(LAS unsigned char* L, int lane, int w, int q, int hf, int qt, int ntile, const bf16_t* kbase, const bf16x8 (&bq)[4][4], const float (&wq)[4],
                                           bf16x8 (&k0)[4], bf16x8 (&k1)[4], u32x4* kc) {
    constexpr int shift = 24 - 8 * PASS;
    LAS unsigned* hist = (LAS unsigned*)(L + HIST); LAS unsigned* qst = (LAS unsigned*)(L + QST);
    const unsigned prefix = qst[q];
    LAS unsigned* hrow = hist + q * HPITCH;
    int tile = w; const int tlast = ntile - 1;
    if constexpr (PASS == 1) {
#pragma unroll 2
        for (; tile < ntile; tile += NWAVES) {
            const u32x4 ca = *(kc + (size_t)(tile * 64 + lane) * 2), cb = *(kc + (size_t)(tile * 64 + lane) * 2 + 1);
            const unsigned cw[8] = {ca.x, ca.y, ca.z, ca.w, cb.x, cb.y, cb.z, cb.w};
#pragma unroll
            for (int r = 0; r < 16; ++r) { const unsigned h16 = (r & 1) ? (cw[r >> 1] >> 16) : (cw[r >> 1] & 0xffffu);
                const bool hit = ((h16 >> 8) == prefix); const unsigned bin = hit ? (h16 & 255u) : 256u;
                __hip_atomic_fetch_add(&hrow[bin], 1u, __ATOMIC_RELAXED, __HIP_MEMORY_SCOPE_WORKGROUP); }
        }
    } else {
#define DSA_RSTEP(KB) { \
        float sc[16]; idx_scores(KB, bq, wq, sc); \
        DSA_LOADK(KB, min(tile + 2 * NWAVES, tlast)); \
        DSA_DIAG_MASK() \
        unsigned kh[8], kl[8]; \
        _Pragma("unroll") for (int r = 0; r < 16; ++r) { const unsigned key = fkey(sc[r]); unsigned bin = (key >> shift) & 255u; bool hit = true; \
            if (PASS == 0) { if (r & 1) { kh[r >> 1] |= key & 0xffff0000u; kl[r >> 1] |= key << 16; } else { kh[r >> 1] = key >> 16; kl[r >> 1] = key & 0xffffu; } } \
            if (PASS > 0) { hit = ((key >> ((shift + 8) & 31)) == prefix); bin = hit ? bin : 256u; } \
            if (PASS < 2 || __any(hit)) __hip_atomic_fetch_add(&hrow[bin], 1u, __ATOMIC_RELAXED, __HIP_MEMORY_SCOPE_WORKGROUP); } \
        if (PASS == 0) { *(kc + (size_t)(tile * 64 + lane) * 2) = (u32x4){kh[0], kh[1], kh[2], kh[3]}; *(kc + (size_t)(tile * 64 + lane) * 2 + 1) = (u32x4){kh[4], kh[5], kh[6], kh[7]}; \
            u32x4* kcl_ = kc + (WS_KCL - WS_KC) / 16; *(kcl_ + (size_t)(tile * 64 + lane) * 2) = (u32x4){kl[0], kl[1], kl[2], kl[3]}; *(kcl_ + (size_t)(tile * 64 + lane) * 2 + 1) = (u32x4){kl[4], kl[5], kl[6], kl[7]}; } \
        tile += NWAVES; }
#pragma unroll 1
    while (tile + NWAVES < ntile) { DSA_RSTEP(k0) DSA_RSTEP(k1) }
    if (tile < ntile) DSA_RSTEP(k0)
#undef DSA_RSTEP
    }
    if constexpr (PASS != 1) DSA_PRELOAD();
    __syncthreads();
    { const int g = lane >> 4, li = lane & 15, qq = 4 * w + g; const unsigned need = qst[32 + qq];
        unsigned c[16]; unsigned t = 0u;
#pragma unroll
        for (int j = 0; j < 16; ++j) { c[j] = hist[qq * HPITCH + 16 * li + j]; t += c[j]; hist[qq * HPITCH + 16 * li + j] = 0u; }
        if (li == 15) hist[qq * HPITCH + 256] = 0u;
        unsigned sfx = t;
#pragma unroll
        for (int o = 1; o < 16; o <<= 1) { const unsigned v = __shfl_down(sfx, o, 16); if (li + o < 16) sfx += v; }
        unsigned cum = sfx - t; int found = -1; unsigned cat = 0u;
#pragma unroll
        for (int j = 15; j >= 0; --j) { if (cum < need && cum + c[j] >= need) { found = j; cat = cum; } cum += c[j]; }
        if (found >= 0) { qst[qq] = (qst[qq] << 8) | (unsigned)(16 * li + found); qst[32 + qq] = need - cat; } }
    __syncthreads();
}
__device__ __forceinline__ void tie_fixup(LAS unsigned* gt, LAS unsigned* eq, int qq, int li, int need) {
    unsigned e[8]; int cn[8]; int t = 0;
#pragma unroll
    for (int j = 0; j < 8; ++j) { e[j] = eq[qq * 128 + 8 * li + j]; cn[j] = __popc(e[j]); t += cn[j]; }
    int pre = t;
#pragma unroll
    for (int o = 1; o < 16; o <<= 1) { const int v = __shfl_up(pre, o, 16); if (li >= o) pre += v; }
    int before = pre - t;
#pragma unroll
    for (int j = 0; j < 8; ++j) { const int k = min(cn[j], max(need - before, 0)); if (e[j]) gt[qq * 128 + 8 * li + j] |= lowbits(e[j], k); before += cn[j]; }
}

__device__ __forceinline__ void unit(const Ctx& C, int b, int qt, int dry) {
    TID_SETUP(); ArgsP A = args_ptr();
    LAS unsigned char* L = C.lds;
    LAS unsigned* hist = (LAS unsigned*)(L + HIST); LAS unsigned* gt = (LAS unsigned*)(L + GT); LAS unsigned* eq = (LAS unsigned*)(L + EQ); LAS unsigned* qst = (LAS unsigned*)(L + QST);
    LAS unsigned* list = (LAS unsigned*)(L + LIST); LAS unsigned* cnt = (LAS unsigned*)(L + CNT);
    const int w = wave, q = lane & 31, hf = lane >> 5;
    const int t0 = 32 * qt, ntile = qt + 1, tlast = ntile - 1;
    const bf16_t* kbase = WSP(bf16_t, WS_SIDE) + (size_t)b * SEQ * LDS_;
    const bf16_t* srow = kbase + (size_t)(t0 + q) * LDS_;
    bf16_t* qrow = WSP(bf16_t, WS_PROJ) + (size_t)(b * SEQ + t0 + q) * LDP;
    const bool sel = (qt >= 8);
    for (int i = tid; i < 2 * 32 * 128; i += NTHR) gt[i] = 0u;
    if (sel) { for (int i = tid; i < 32 * HPITCH; i += NTHR) hist[i] = 0u; }
    if (tid < 64) qst[tid] = (tid < 32) ? 0u : 256u;
    if (tid < 128) cnt[tid] = (tid >= 32 && tid < 64) ? 0xffffffffu : 0u;
    __syncthreads();
    if (sel) {
        bf16x8 bq[4][4]; float wq[4];
#pragma unroll
        for (int h = 0; h < 4; ++h) { wq[h] = bf2f(srow[O_IW - O_SIDE + h]) * 0.0625f;
#pragma unroll
            for (int kk = 0; kk < 4; ++kk) bq[h][kk] = *(const bf16x8*)(srow + (O_IQ - O_SIDE) + h * 64 + kk * 16 + hf * 8); }
        bf16x8 k0[4], k1[4];
        u32x4* kc = WSP(u32x4, WS_KC) + (size_t)C.bid * (128 * 64 * 2);
        DSA_PRELOAD();
        radix_pass<0>(L, lane, w, q, hf, qt, ntile, kbase, bq, wq, k0, k1, kc);
        radix_pass<1>(L, lane, w, q, hf, qt, ntile, kbase, bq, wq, k0, k1, kc);
        {
            const unsigned p16 = qst[q]; const u32x4* kcl = kc + (WS_KCL - WS_KC) / 16;
#pragma unroll 2
            for (int tile = w; tile < ntile; tile += NWAVES) {
                const u32x4 ha = *(kc + (size_t)(tile * 64 + lane) * 2), hb = *(kc + (size_t)(tile * 64 + lane) * 2 + 1);
                const u32x4 la = *(kcl + (size_t)(tile * 64 + lane) * 2), lb = *(kcl + (size_t)(tile * 64 + lane) * 2 + 1);
                const unsigned hw[8] = {ha.x, ha.y, ha.z, ha.w, hb.x, hb.y, hb.z, hb.w}, lw[8] = {la.x, la.y, la.z, la.w, lb.x, lb.y, lb.z, lb.w};
                unsigned gw = 0u, ew = 0u;
#pragma unroll
                for (int r = 0; r < 16; ++r) { const int pos = (r & 3) + 8 * (r >> 2) + 4 * hf;
                    const unsigned hi = (r & 1) ? (hw[r >> 1] >> 16) : (hw[r >> 1] & 0xffffu);
                    gw |= (hi > p16) ? (1u << pos) : 0u; const bool m = (hi == p16); ew |= m ? (1u << pos) : 0u;
                    if (__any(m)) { if (m) { const unsigned low = (r & 1) ? (lw[r >> 1] >> 16) : (lw[r >> 1] & 0xffffu);
                        const unsigned slot = __hip_atomic_fetch_add(&cnt[q], 1u, __ATOMIC_RELAXED, __HIP_MEMORY_SCOPE_WORKGROUP);
                        if (slot < (unsigned)LCAP) list[q * LCAP + slot] = 0x10000000u | (low << 12) | (unsigned)(4095 - (tile * 32 + pos));
                        __hip_atomic_fetch_min(&cnt[32 + q], low, __ATOMIC_RELAXED, __HIP_MEMORY_SCOPE_WORKGROUP);
                        __hip_atomic_fetch_max(&cnt[64 + q], low, __ATOMIC_RELAXED, __HIP_MEMORY_SCOPE_WORKGROUP); } } }
                gw |= __shfl_xor(gw, 32); ew |= __shfl_xor(ew, 32);
                if (hf == 0) { gt[q * 128 + tile] = gw; eq[q * 128 + tile] = ew; }
            }
        }
        __syncthreads();
        {
            const int g = lane >> 4, li = lane & 15, qq = 4 * w + g; const int need = (int)qst[32 + qq]; const int n = (int)cnt[qq];
            if (n <= LCAP) {
                unsigned c[4]; int rank[4];
#pragma unroll
                for (int k = 0; k < 4; ++k) { const int idx = li + 16 * k; c[k] = (idx < n) ? list[qq * LCAP + idx] : 0u; rank[k] = 0; }
                for (int j = 0; j < n; ++j) { const unsigned e = list[qq * LCAP + j];
#pragma unroll
                    for (int k = 0; k < 4; ++k) rank[k] += (e > c[k]) ? 1 : 0; }
#pragma unroll
                for (int k = 0; k < 4; ++k) if (c[k] != 0u && rank[k] < need) { const int sp = 4095 - (int)(c[k] & 4095u);
                    __hip_atomic_fetch_or(&gt[qq * 128 + (sp >> 5)], 1u << (sp & 31), __ATOMIC_RELAXED, __HIP_MEMORY_SCOPE_WORKGROUP); }
            } else if (cnt[32 + qq] == cnt[64 + qq]) {
                tie_fixup(gt, eq, qq, li, need);
            } else if (li == 0) cnt[96] = 1u;
        }
        __syncthreads();
        if (cnt[96] != 0u) {
            DSA_PRELOAD();
            radix_pass<2>(L, lane, w, q, hf, qt, ntile, kbase, bq, wq, k0, k1, kc);
            radix_pass<3>(L, lane, w, q, hf, qt, ntile, kbase, bq, wq, k0, k1, kc);
            const unsigned prefix = qst[q];
            for (int tile = w; tile < ntile; tile += NWAVES) {
                bf16x8 ka[4]; DSA_LOADK(ka, tile);
                float sc[16]; idx_scores(ka, bq, wq, sc);
                DSA_DIAG_MASK()
                unsigned gw = 0u, ew = 0u;
#pragma unroll
                for (int r = 0; r < 16; ++r) { const int pos = (r & 3) + 8 * (r >> 2) + 4 * hf; const unsigned key = fkey(sc[r]);
                    gw |= (key > prefix) ? (1u << pos) : 0u; ew |= (key == prefix) ? (1u << pos) : 0u; }
                gw |= __shfl_xor(gw, 32); ew |= __shfl_xor(ew, 32);
                if (hf == 0) { gt[q * 128 + tile] = gw; eq[q * 128 + tile] = ew; }
            }
            __syncthreads();
            tie_fixup(gt, eq, 4 * w + (lane >> 4), lane & 15, (int)qst[32 + 4 * w + (lane >> 4)]);
        }
    } else {
        for (int tile = w; tile < ntile; tile += NWAVES) { unsigned gw = 0u; const bool diag = (tile == qt);
#pragma unroll
            for (int r = 0; r < 16; ++r) { const int pos = (r & 3) + 8 * (r >> 2) + 4 * hf; if (!diag || (pos <= q)) gw |= 1u << pos; }
            gw |= __shfl_xor(gw, 32);
            if (hf == 0) gt[q * 128 + tile] = gw; }
    }
    __syncthreads();
    {
        const int a = w;
        bf16x8 bqa[4];
#pragma unroll
        for (int kk = 0; kk < 4; ++kk) bqa[kk] = *(const bf16x8*)(qrow + O_AQ + a * 64 + kk * 16 + hf * 8);
        f32x16 o0, o1;
#pragma unroll
        for (int r = 0; r < 16; ++r) { o0[r] = 0.f; o1[r] = 0.f; }
        float mrun = 0.f;
        f32x4 lacc = {0.f, 0.f, 0.f, 0.f};
        u32x4 onesw; onesw.x = onesw.y = onesw.z = onesw.w = ((lane & 15) == ((lane >> 4) & 1)) ? 0x3F803F80u : 0u;
        const bf16x8 onesA = __builtin_bit_cast(bf16x8, onesw);
#define DSA_EMASK(c, buf) do { const int mw_ = (int)(gt[q * 128 + 4 * (c) + (w >> 1)] >> (4 * hf + 16 * (w & 1))); u32x4 em_; \
            em_.x = __builtin_amdgcn_perm((unsigned)__builtin_amdgcn_sbfe(mw_, 1, 1), (unsigned)__builtin_amdgcn_sbfe(mw_, 0, 1), 0x07060100u); \
            em_.y = __builtin_amdgcn_perm((unsigned)__builtin_amdgcn_sbfe(mw_, 3, 1), (unsigned)__builtin_amdgcn_sbfe(mw_, 2, 1), 0x07060100u); \
            em_.z = __builtin_amdgcn_perm((unsigned)__builtin_amdgcn_sbfe(mw_, 9, 1), (unsigned)__builtin_amdgcn_sbfe(mw_, 8, 1), 0x07060100u); \
            em_.w = __builtin_amdgcn_perm((unsigned)__builtin_amdgcn_sbfe(mw_, 11, 1), (unsigned)__builtin_amdgcn_sbfe(mw_, 10, 1), 0x07060100u); \
            *(LAS u32x4*)(L + EMK + (buf) * EMKB + (w * 64 + lane) * 16) = em_; } while (0)
        const int nch = (ntile + 3) >> 2;
        const int kr0 = tid >> 3, ks0 = tid & 7;
        u32x4 rkA[2], rvA[2], rkB[2], rvB[2];
#define DSA_ISSUE(c, RK, RV) do { _Pragma("unroll") for (int i = 0; i < 2; ++i) { const bf16_t* rp_ = kbase + (size_t)((c) * 128 + kr0 + 64 * i) * LDS_ + ks0 * 8; \
            RK[i] = *(const u32x4*)(rp_ + (O_AK - O_SIDE)); RV[i] = *(const u32x4*)(rp_ + (O_AV - O_SIDE)); } } while (0)
#define DSA_WRITE(buf, RK, RV) do { _Pragma("unroll") for (int i = 0; i < 2; ++i) { \
            *(LAS u32x4*)(L + KST + (buf) * KBUF + (kr0 + 64 * i) * 144 + ks0 * 16) = RK[i]; \
            *(LAS u32x4*)(L + VST + (buf) * KBUF + (kr0 + 64 * i) * 144 + ks0 * 16) = RV[i]; } } while (0)
        const int g16 = lane >> 4, li = lane & 15;
        const int vtoff = (4 * hf + (li >> 2)) * 144 + (16 * (g16 & 1) + 4 * (li & 3)) * 2;
#ifndef ATTN_REPS
#define ATTN_REPS 1
#endif
#pragma unroll 1
        for (int rep = 0; rep < ATTN_REPS; ++rep) {
        if (ATTN_REPS > 1) { mrun = 0.f; lacc[0] = lacc[1] = lacc[2] = lacc[3] = 0.f;
#pragma unroll
            for (int r = 0; r < 16; ++r) { o0[r] = 0.f; o1[r] = 0.f; } }
        DSA_ISSUE(0, rkA, rvA); DSA_ISSUE(min(1, nch - 1), rkB, rvB);
        DSA_WRITE(0, rkA, rvA); DSA_EMASK(0, 0);
        __syncthreads();
        asm volatile("" :: "v"(bqa[0]), "v"(bqa[1]), "v"(bqa[2]), "v"(bqa[3]));
        f32x16 nmv;
#pragma unroll
        for (int r = 0; r < 16; ++r) nmv[r] = -mrun;
#define DSA_KREAD(dst, tt_) do { const LAS unsigned char* kp_ = L + KST + buf * KBUF + (32 * (tt_) + q) * 144 + 16 * hf; \
            _Pragma("unroll") for (int kk = 0; kk < 4; ++kk) dst[kk] = *(const LAS bf16x8*)(kp_ + 32 * kk); } while (0)
#define DSA_STEP(tt, CUR, NXT, KFN, HASN) do { \
            s16x4 vlo[2][2], vhi[2][2]; \
            _Pragma("unroll") for (int ks = 0; ks < 2; ++ks) \
            _Pragma("unroll") for (int dt = 0; dt < 2; ++dt) { const LAS unsigned char* vp = L + VST + buf * KBUF + (32 * (tt) + 16 * ks) * 144 + 64 * dt + vtoff; \
                vlo[ks][dt] = __builtin_amdgcn_ds_read_tr16_b64_v4i16((LAS s16x4*)vp); vhi[ks][dt] = __builtin_amdgcn_ds_read_tr16_b64_v4i16((LAS s16x4*)(vp + 8 * 144)); } \
            u32x4 em[2]; \
            _Pragma("unroll") for (int ks = 0; ks < 2; ++ks) em[ks] = *(const LAS u32x4*)(L + EMK + buf * EMKB + ((2 * (tt) + ks) * 64 + lane) * 16); \
            float mx = CUR[0]; \
            _Pragma("unroll") for (int r = 1; r < 16; ++r) mx = fmaxf(mx, CUR[r]); \
            { const auto rr = __builtin_amdgcn_permlane32_swap(__float_as_uint(mx), __float_as_uint(mx), false, false); mx = fmaxf(__uint_as_float(rr[0]), __uint_as_float(rr[1])); } \
            const bool first = (c == 0) && ((tt) == 0); \
            if (first || __any(mx > 8.0f)) {              \
                const float d = first ? mx : fmaxf(mx, 0.f), alpha = first ? 1.0f : __builtin_amdgcn_exp2f(-d); mrun += d; \
                lacc[0] *= __shfl(alpha, lane & 15); lacc[1] *= __shfl(alpha, (lane & 15) + 16); \
                _Pragma("unroll") for (int r = 0; r < 16; ++r) { o0[r] *= alpha; o1[r] *= alpha; CUR[r] -= d; nmv[r] = -mrun; } } \
            __builtin_amdgcn_sched_barrier(0); \
            float p[16]; \
            _Pragma("unroll") for (int g = 0; g < 4; ++g) { \
                if (HASN) NXT = mfma32(KFN[g], bqa[g], (g == 0) ? nmv : NXT); \
                _Pragma("unroll") for (int r = 4 * g; r < 4 * g + 4; ++r) p[r] = __builtin_amdgcn_exp2f(CUR[r]); \
                __builtin_amdgcn_sched_barrier(0); } \
            _Pragma("unroll") for (int ks = 0; ks < 2; ++ks) { \
                u32x4 pw; pw.x = pk2(p[8 * ks], p[8 * ks + 1]) & em[ks].x; pw.y = pk2(p[8 * ks + 2], p[8 * ks + 3]) & em[ks].y; pw.z = pk2(p[8 * ks + 4], p[8 * ks + 5]) & em[ks].z; pw.w = pk2(p[8 * ks + 6], p[8 * ks + 7]) & em[ks].w; \
                const bf16x8 pb = __builtin_bit_cast(bf16x8, pw); \
                o0 = mfma32(__builtin_shufflevector(vlo[ks][0], vhi[ks][0], 0, 1, 2, 3, 4, 5, 6, 7), pb, o0); \
                o1 = mfma32(__builtin_shufflevector(vlo[ks][1], vhi[ks][1], 0, 1, 2, 3, 4, 5, 6, 7), pb, o1); \
                lacc = __builtin_amdgcn_mfma_f32_16x16x32_bf16(onesA, pb, lacc, 0, 0, 0); } \
        } while (0)
#define DSA_CHUNK(RKY, RVY, RKX, RVX) do { \
            const int buf = c & 1; \
            DSA_ISSUE(min(c + 2, nch - 1), RKY, RVY);         \
            bf16x8 kfa[4], kfb[4]; f32x16 sA, sB; \
            DSA_KREAD(kfa, 0); DSA_KREAD(kfb, 1); __builtin_amdgcn_sched_barrier(0); \
            _Pragma("unroll") for (int kk = 0; kk < 4; ++kk) sA = mfma32(kfa[kk], bqa[kk], (kk == 0) ? nmv : sA); \
            DSA_KREAD(kfa, 2); __builtin_amdgcn_sched_barrier(0); \
            DSA_STEP(0, sA, sB, kfb, true); \
            DSA_KREAD(kfb, 3); __builtin_amdgcn_sched_barrier(0); \
            DSA_STEP(1, sB, sA, kfa, true); \
            DSA_STEP(2, sA, sB, kfb, true); \
            DSA_STEP(3, sB, sA, kfa, false); \
            if (c + 1 < nch) { DSA_WRITE(buf ^ 1, RKX, RVX); DSA_EMASK(c + 1, buf ^ 1); } \
            __syncthreads(); } while (0)
#pragma unroll 1
        for (int c = 0; c < nch; ++c) {
            DSA_CHUNK(rkA, rvA, rkB, rvB);
            if (++c >= nch) break;
            DSA_CHUNK(rkB, rvB, rkA, rvA);
        }
        }
#undef DSA_CHUNK
#undef DSA_EMASK
#undef DSA_STEP
#undef DSA_KREAD
        const float l0 = __shfl(lacc[0], lane & 15), l1 = __shfl(lacc[1], lane & 15);
        const float lt = (lane & 16) ? l1 : l0, inv = 1.0f / lt;
#pragma unroll
        for (int g = 0; g < 4; ++g) {
            u32x2 w0, w1; w0.x = pk2(o0[4 * g] * inv, o0[4 * g + 1] * inv); w0.y = pk2(o0[4 * g + 2] * inv, o0[4 * g + 3] * inv);
            w1.x = pk2(o1[4 * g] * inv, o1[4 * g + 1] * inv); w1.y = pk2(o1[4 * g + 2] * inv, o1[4 * g + 3] * inv);
            if (!dry) { *(u32x2*)(qrow + O_AQ + a * 64 + 8 * g + 4 * hf) = w0; *(u32x2*)(qrow + O_AQ + a * 64 + 32 + 8 * g + 4 * hf) = w1; } }
    }
    __syncthreads();
}
}

#ifdef NO_ML
#define ML_CALL(x)
#else
#define ML_CALL(x) x
#endif
#ifdef NO_DSA
#define DSA_CALL(x)
#else
#define DSA_CALL(x) x
#endif
#if defined(NO_GEMM)
#define GEMM_CALL(k, x)
#elif defined(ONLY_GEMM)
#define GEMM_CALL(k, x) do { if ((k) == ONLY_GEMM) { x; } } while (0)
#else
#define GEMM_CALL(k, x) x
#endif
#ifndef PROBE_MIX
#define PROBE_MIX 0
#endif
constexpr int PH_PER_LAYER = 20, N_PHASES = DEPTH * PH_PER_LAYER + 1;
__global__ void __launch_bounds__(NTHR, 2) mk_fwd(Args Aval) {
    extern __shared__ __attribute__((aligned(16))) unsigned char lds_raw[];
    Ctx C;
    C.lds = (LAS unsigned char*)lds_raw;
    C.G = gridDim.x; C.bid = blockIdx.x;
    volatile LAS unsigned* MISC = (volatile LAS unsigned*)(C.lds + MISC_OFF);
    for (int u = threadIdx.x; u < (LDS_BYTES - LDSCTL_OFF) / 4; u += NTHR) ((LAS unsigned*)(C.lds + LDSCTL_OFF))[u] = 0u;
    __syncthreads();
    unsigned* barw = (unsigned*)(Aval.ws + WS_CTL) + CW_BAR;
    XcdBarrier bar; bar.bar = barw; bar.x = 0; bar.st = nullptr;
    const int lo = Aval.ph_lo, hi = Aval.ph_hi;
    if ((hi - lo) > 1) bar = xcd_barrier_post(barw, MISC + 8);
#define IN(k) (lo <= (k) && (k) < hi)
#define SEAM(k) do { if (IN((k) + 1)) xcd_barrier(bar); } while (0)
#pragma unroll 1
    for (int l = 0; l < DEPTH; ++l) {
        const int P0 = l * PH_PER_LAYER;
        if (IN(P0 + 0)) { phase_convert(C, l); phase_pb(C, l); if (l == 0) phase_init_rows(C); SEAM(P0 + 0); }
        if (IN(P0 + 1)) {
            ArgsP A = args_ptr(); bf16_t* const W = WSP(bf16_t, WS_W); pg8::Gemm g{WSP(bf16_t, WS_XB), W + W_GU1, DM, MTOK, 2 * DFF, DM}; pg8::StaticOrder S; S.init(MTOK, 2 * DFF, C.G, C.bid);
            pg8::EpiSwiglu E{WSP(bf16_t, WS_HID), WSP(float, WS_SS0)}; GEMM_CALL(0, pg8::gemm_phase(C.lds, g, S, E)); SEAM(P0 + 1); }
        if (IN(P0 + 2)) {
            ArgsP A = args_ptr(); bf16_t* const W = WSP(bf16_t, WS_W); pg8::Gemm g{WSP(bf16_t, WS_HID), W + W_DN1, DFF, MTOK, DM, DFF}; pg8::StaticOrder S; S.init(MTOK, DM, C.G, C.bid);
            pg8::EpiResid E{(l == 0) ? A->in[0] : A->out, A->out, WSP(bf16_t, WS_XB), 0.5f, WSP(float, WS_SS1), (LAS float*)(C.lds + LDS_SSQ)}; GEMM_CALL(1, pg8::gemm_phase(C.lds, g, S, E)); SEAM(P0 + 2); }
#pragma unroll 1
        for (int gi = 0; gi < NGRP; ++gi) {
            const int PG = P0 + 4 + 5 * gi; const size_t r0 = (size_t)gi * MG;
            if (IN(PG + 0)) {
                ArgsP A = args_ptr(); bf16_t* const W = WSP(bf16_t, WS_W); pg8::Gemm g{WSP(bf16_t, WS_XB) + r0 * DM, W + W_IN, DM, MG, LDP, DM}; pg8::StaticOrder S; S.init(MG, LDP, C.G, C.bid);
                pg8::EpiProj E{WSP(bf16_t, WS_PROJ), WSP(float, WS_SS1) + r0 * 4, WSP(bf16_t, WS_SIDE)}; GEMM_CALL(2, pg8::gemm_phase(C.lds, g, S, E)); SEAM(PG + 0); }
            if (IN(PG + 1)) {
                constexpr int NMLB = 16, NDSAB = 128, NCVB = 32, NITEMB = NMLB + NDSAB + NCVB;
                unsigned* qbase = (unsigned*)(Aval.ws + WS_CTL) + CW_Q + 64 * (8 * (2 * l + gi));
                const int xq = (int)(xb_xcc_id() & 7u);
                for (int hop = 0; hop < GB; ++hop) {
                    const int bq_ = (xq + hop) & (GB - 1);
                    unsigned* qhead = qbase + 64 * bq_;
                    for (;;) {
                        __syncthreads();
                        if (threadIdx.x == 0) MISC[16] = __hip_atomic_fetch_add(qhead, 1u, __ATOMIC_RELAXED, __HIP_MEMORY_SCOPE_AGENT);
                        __syncthreads();
                        const int item = (int)MISC[16];
                        if (item >= NITEMB) break;
                        if (item < NMLB) { ML_CALL(ml::unit(C, l, bq_ * 16 + item, 0)); }
                        else if (item < NMLB + NDSAB) { DSA_CALL(dsa::unit(C, bq_, 127 - (item - NMLB), 0)); }
                        else prep_conv(C, l, bq_, item - NMLB - NDSAB, NCVB, 0);
                    }
                }
                SEAM(PG + 1); }
            if (IN(PG + 2)) { prep_gate(C, l, C.bid, C.G); SEAM(PG + 2); }
            if (IN(PG + 3)) {
                ArgsP A = args_ptr(); bf16_t* const W = WSP(bf16_t, WS_W); bf16_t* PROJ = WSP(bf16_t, WS_PROJ);
                pg8::Gemm g{PROJ + O_CB, W + W_MRG, LDP, MG, DM, 2 * DM}; pg8::StaticOrder S; S.init(MG, DM, C.G, C.bid);
                pg8::EpiMerge E{WSP(bf16_t, WS_GCAT), PROJ + O_G + 2 * DM}; pg8::MergeHook H{PROJ + O_G};
                GEMM_CALL(3, (pg8::gemm_phase<pg8::EpiMerge, pg8::MergeHook>(C.lds, g, S, E, H)));
                SEAM(PG + 3); }
            if (IN(PG + 4)) {
                ArgsP A = args_ptr(); bf16_t* const W = WSP(bf16_t, WS_W); pg8::Gemm g{WSP(bf16_t, WS_GCAT), W + W_O, DM, MG, DM, DM}; pg8::StaticOrder S; S.init(MG, DM, C.G, C.bid);
                pg8::EpiResid E{A->out + r0 * DM, A->out + r0 * DM, WSP(bf16_t, WS_XB) + r0 * DM, 1.0f, WSP(float, WS_SS0) + r0 * 4, (LAS float*)(C.lds + LDS_SSQ)}; GEMM_CALL(6, pg8::gemm_phase(C.lds, g, S, E)); SEAM(PG + 4); }
        }
        if (IN(P0 + 15)) {
            ArgsP A = args_ptr(); bf16_t* const W = WSP(bf16_t, WS_W); pg8::Gemm g{WSP(bf16_t, WS_XB), W + W_GU2, DM, MTOK, 2 * DFF, DM}; pg8::StaticOrder S; S.init(MTOK, 2 * DFF, C.G, C.bid);
            pg8::EpiSwiglu E{WSP(bf16_t, WS_HID), WSP(float, WS_SS0)}; GEMM_CALL(7, pg8::gemm_phase(C.lds, g, S, E)); SEAM(P0 + 15); }
        if (IN(P0 + 16)) {
            ArgsP A = args_ptr(); bf16_t* const W = WSP(bf16_t, WS_W); pg8::Gemm g{WSP(bf16_t, WS_HID), W + W_DN2, DFF, MTOK, DM, DFF}; pg8::StaticOrder S; S.init(MTOK, DM, C.G, C.bid);
            pg8::EpiResid E{A->out, A->out, WSP(bf16_t, WS_XB), 0.5f, WSP(float, WS_SS1), (LAS float*)(C.lds + LDS_SSQ)}; GEMM_CALL(8, pg8::gemm_phase(C.lds, g, S, E)); SEAM(P0 + 16); }
        if (IN(P0 + 18)) {
            ArgsP A = args_ptr(); bf16_t* const W = WSP(bf16_t, WS_W); pg8::Gemm g{WSP(bf16_t, WS_PB), W + W_PP, DPLE, MTOK, DM, DPLE}; pg8::StaticOrder S; S.init(MTOK, DM, C.G, C.bid);
            pg8::EpiBf16 E{WSP(bf16_t, WS_PP), DM, nullptr}; GEMM_CALL(9, pg8::gemm_phase(C.lds, g, S, E)); SEAM(P0 + 18); }
        if (IN(P0 + 19)) {
            ArgsP A = args_ptr(); bf16_t* const W = WSP(bf16_t, WS_W); pg8::Gemm g{WSP(bf16_t, WS_XB), W + W_PG, DM, MTOK, DM, DM}; pg8::StaticOrder S; S.init(MTOK, DM, C.G, C.bid);
            pg8::EpiPle E{A->out, WSP(bf16_t, WS_XB), WSP(bf16_t, WS_PP), WSP(float, WS_SS1), WSP(float, WS_SS0), (LAS float*)(C.lds + LDS_SSQ)}; GEMM_CALL(10, pg8::gemm_phase(C.lds, g, S, E)); SEAM(P0 + 19); }
    }
    if (IN(N_PHASES - 1)) phase_final(C);
#undef IN
#undef SEAM
}

extern "C" void kernel_launch(void* const* d_in, const int* in_sizes, int n_in, void* d_out, int out_size, void* d_ws, size_t ws_size, hipStream_t stream) {
    static int grid = 0;
    if (grid == 0) {
        if (n_in != 22 || out_size != MTOK * DM || ws_size < WS_END) { fprintf(stderr, "kernel_launch: unexpected shapes (n_in %d out %d ws %zu, need %zu)\n", n_in, out_size, ws_size, (size_t)WS_END); grid = -1; return; }
        int dev = 0, cus = 0, per_cu = 0;
        if (hipGetDevice(&dev) != hipSuccess || hipDeviceGetAttribute(&cus, hipDeviceAttributeMultiprocessorCount, dev) != hipSuccess) { grid = -1; return; }
        if (hipFuncSetAttribute((const void*)mk_fwd, hipFuncAttributeMaxDynamicSharedMemorySize, LDS_BYTES) != hipSuccess) { fprintf(stderr, "kernel_launch: hipFuncSetAttribute failed\n"); grid = -1; return; }
        if (hipOccupancyMaxActiveBlocksPerMultiprocessor(&per_cu, (const void*)mk_fwd, NTHR, LDS_BYTES) != hipSuccess || per_cu < 1) { fprintf(stderr, "kernel_launch: occupancy query says %d\n", per_cu); (void)hipGetLastError(); grid = -1; return; }
        grid = cus;
    }
    if (grid < 0) return;
    if (hipMemsetAsync((char*)d_ws + WS_CTL, 0, CTL_ZERO_BYTES, stream) != hipSuccess) return;
    Args a{};
    for (int i = 0; i < 22; ++i) a.in[i] = (const float*)d_in[i];
    a.out = (float*)d_out; a.ws = (unsigned char*)d_ws;
#if MK_N_LAUNCHES == 1
    a.ph_lo = 0; a.ph_hi = N_PHASES;
    hipLaunchKernelGGL(mk_fwd, dim3(grid), dim3(NTHR), LDS_BYTES, stream, a);
#else
    for (int p = 0; p < N_PHASES; ++p) { a.ph_lo = p; a.ph_hi = p + 1; hipLaunchKernelGGL(mk_fwd, dim3(grid), dim3(NTHR), LDS_BYTES, stream, a); }
#endif
}
```

```cpp
#include <hip/hip_runtime.h>
#include <cstdio>
#include <cstdint>

#ifndef MK_N_LAUNCHES
#define MK_N_LAUNCHES 1
#endif

constexpr int BATCH = 16, SEQ = 4096, DM = 1024, DEPTH = 2, DPLE = 256, DFF = 2816, DCONV = 512;
constexpr int MTOK = BATCH * SEQ;
constexpr int NGRP = 2, GB = BATCH / NGRP, MG = GB * SEQ;
constexpr int LDP = 8704;
constexpr int O_CC = 0, O_CX = 512, O_MQ = 1024, O_MK = 1536, O_MV = 2048, O_CB = 3072, O_MO = 3584, O_AQ = 4608, O_G = 5120, O_AK = 8192, O_AV = 8256,
              O_IQ = 8320, O_IK = 8576, O_MI = 8640, O_MF = 8644, O_IW = 8648;
constexpr int LDS_ = 512, O_SIDE = 8192;
constexpr float EPS = 1e-6f;

constexpr size_t W_GU1 = 0, W_DN1 = W_GU1 + (size_t)5632 * 1024, W_IN = W_DN1 + (size_t)1024 * 2816, W_MRG = W_IN + (size_t)LDP * 1024,
                 W_O = W_MRG + (size_t)1024 * 2048, W_GU2 = W_O + (size_t)1024 * 1024,
                 W_DN2 = W_GU2 + (size_t)5632 * 1024, W_PG = W_DN2 + (size_t)1024 * 2816, W_PP = W_PG + (size_t)1024 * 1024, W_END = W_PP + (size_t)1024 * 256;

constexpr size_t MiB = 1u << 20;
constexpr size_t WS_CTL = 0, CTL_ZERO_BYTES = 64 * 1024;
constexpr size_t WS_W = 1 * MiB;
constexpr size_t WS_XB = 65 * MiB;
constexpr size_t WS_SS0 = 193 * MiB, WS_SS1 = 194 * MiB;
constexpr size_t WS_SCR = 198 * MiB;
constexpr size_t WS_BIG = 206 * MiB;
constexpr size_t WS_PROJ = WS_BIG;
constexpr size_t WS_GCAT = WS_BIG + 544 * MiB;
constexpr size_t WS_SIDE = WS_GCAT + 64 * MiB;
constexpr size_t WS_HID = WS_BIG;
constexpr size_t WS_PB = WS_BIG + 640 * MiB;
constexpr size_t WS_PP = WS_BIG + 384 * MiB;
constexpr size_t WS_KC = WS_BIG + 672 * MiB;
constexpr size_t WS_KCL = WS_BIG + 736 * MiB;
constexpr size_t WS_END = WS_BIG + 800 * MiB;
static_assert(W_END * 2 <= 64 * MiB, "weights fit");
constexpr int CW_BAR = 4096;
constexpr int CW_Q = 8192;

constexpr int RING_BYTES = 131072, LDSCTL_OFF = RING_BYTES, MISC_OFF = LDSCTL_OFF + 320, LDS_BYTES = 147456;
constexpr int NWAVES = 8, NTHR = 512;

#define GAS __attribute__((address_space(1)))
#define LAS __attribute__((address_space(3)))
typedef unsigned short bf16_t;
typedef short bf16x8 __attribute__((ext_vector_type(8)));
typedef short bf16x4 __attribute__((ext_vector_type(4)));
typedef float f32x4 __attribute__((ext_vector_type(4)));
typedef float f32x16 __attribute__((ext_vector_type(16)));
typedef unsigned u32x4 __attribute__((ext_vector_type(4)));
typedef unsigned u32x2 __attribute__((ext_vector_type(2)));
typedef __bf16 bf2_t __attribute__((ext_vector_type(2)));

__device__ __forceinline__ unsigned pk2(float lo, float hi) { bf2_t v = {(__bf16)lo, (__bf16)hi}; return __builtin_bit_cast(unsigned, v); }
__device__ __forceinline__ bf16_t f2bf(float x) { __bf16 v = (__bf16)x; return __builtin_bit_cast(bf16_t, v); }
__device__ __forceinline__ float bf2f(bf16_t b) { return __uint_as_float(((unsigned)b) << 16); }
__device__ __forceinline__ float bflo(unsigned w) { return __uint_as_float(w << 16); }
__device__ __forceinline__ float bfhi(unsigned w) { return __uint_as_float(w & 0xffff0000u); }
__device__ __forceinline__ float fsigmoid(float x) { return __builtin_amdgcn_rcpf(1.0f + __expf(-x)); }
__device__ __forceinline__ float rstd_from(const f32x4 p) { return __builtin_amdgcn_rsqf(((p[0] + p[1]) + (p[2] + p[3])) * (1.0f / DM) + EPS); }
__device__ __forceinline__ void rstd8(const float* ss, int row0, float mul, float (&rs)[8]) {
    f32x4 t[8];
#pragma unroll
    for (int i = 0; i < 8; ++i) t[i] = *(const f32x4*)(ss + (size_t)(row0 + (i >> 2) * 128 + (i & 3) * 16) * 4);
    asm volatile("" : "+v"(t[0]), "+v"(t[1]), "+v"(t[2]), "+v"(t[3]), "+v"(t[4]), "+v"(t[5]), "+v"(t[6]), "+v"(t[7]));
#pragma unroll
    for (int i = 0; i < 8; ++i) rs[i] = rstd_from(t[i]) * mul;
}
__device__ __forceinline__ float rstd_of(const float* ss4) { const f32x4 p = *(const f32x4*)ss4; return 1.0f / sqrtf(((p[0] + p[1]) + (p[2] + p[3])) * (1.0f / DM) + EPS); }
constexpr int LDS_SSQ = RING_BYTES + 1024;
__device__ __forceinline__ float wave_sum(float v) {
#pragma unroll
    for (int o = 1; o < 64; o <<= 1) v += __shfl_xor(v, o);
    return v;
}

namespace pg8 {
#ifndef PG8_ALIGN
#define PG8_ALIGN 1
#endif
constexpr bool ALIGN_EPI = PG8_ALIGN;
constexpr int BM = 256, BK = 64, HALF = 128, HTB = HALF * BK * 2, STAGE_BYTES = 8 * HTB, NXCD = 8, WGM = 8;
__host__ __device__ __forceinline__ int lds_byte(int r, int c) { const int st = (r >> 4) * 2 + (c >> 5), rr = r & 15, cc = c & 31, ob = rr * 64 + cc * 2; return st * 1024 + (ob ^ (((ob >> 9) & 1) << 5)); }
__host__ __device__ __forceinline__ void stage_rc(int b, int& R, int& C) { const int st = b / 1024, sb = b % 1024, swz = sb ^ (((sb >> 9) & 1) << 5); R = (st >> 1) * 16 + swz / 64; C = (st & 1) * 32 + (swz % 64) / 2; }
__host__ __device__ __forceinline__ int perm32(int rho) { const int n = rho >> 4, i = rho & 15; return 8 * (i >> 2) + 4 * n + (i & 3); }
struct Unit { int pm, pn; };
struct Gemm { const bf16_t* A; const bf16_t* Bt; int lda, M, N, K; };
struct StaticOrder {
    int nM, nN, nwg, G, c;
    __host__ __device__ void init(int M, int N, int G_, int c_) { nM = M / BM; nN = N / BM; nwg = nM * nN; G = G_; c = c_; }
    __host__ __device__ bool next(int i, Unit& u) const {
        const long L = (long)i * G + c; if (L >= nwg) return false;
        int wgid = (int)L; { const int q = nwg / NXCD, r = nwg % NXCD, xcd = wgid % NXCD, off = wgid / NXCD; wgid = (xcd < r ? xcd * (q + 1) : r * (q + 1) + (xcd - r) * q) + off; }
        const int nig = WGM * nN, gid = wgid / nig, fm = gid * WGM, gsz = (nM - fm) < WGM ? (nM - fm) : WGM;
        u.pm = fm + ((wgid % nig) % gsz); u.pn = (wgid % nig) / gsz; return true;
    }
};
typedef f32x4 Acc[2][2][4][2];

struct EpiSwiglu {
    bf16_t* H; const float* ss;
    __device__ __forceinline__ void operator()(const Acc& acc, const Unit& u, int wr, int wc, int fr, int fq) const {
        const int row0 = u.pm * BM + wr * 64 + fr, col0 = u.pn * 128 + wc * 32 + 8 * fq;
        float rs[8]; rstd8(ss, row0, 1.0f, rs);
#pragma unroll
        for (int ai = 0; ai < 2; ++ai)
#pragma unroll
            for (int m = 0; m < 4; ++m) { const int row = row0 + ai * HALF + m * 16; const float r = rs[ai * 4 + m];
                float h[8];
#pragma unroll
                for (int n = 0; n < 2; ++n)
#pragma unroll
                    for (int j = 0; j < 4; ++j) { const float g = acc[ai][0][m][n][j] * r, uu = acc[ai][1][m][n][j] * r; h[n * 4 + j] = g * fsigmoid(g) * uu; }
                u32x4 w; w.x = pk2(h[0], h[1]); w.y = pk2(h[2], h[3]); w.z = pk2(h[4], h[5]); w.w = pk2(h[6], h[7]);
                *(u32x4*)(H + (size_t)row * DFF + col0) = w; }
    }
};
struct EpiResid {
    const float* Xin; float* X; bf16_t* XB; float scale; float* SS; LAS float* lq;
    __device__ __forceinline__ void operator()(const Acc& acc, const Unit& u, int wr, int wc, int fr, int fq) const {
        const int row0 = u.pm * BM + wr * 64 + fr, col0 = u.pn * BM + wc * 32 + 8 * fq;
#pragma unroll
        for (int ai = 0; ai < 2; ++ai)
#pragma unroll
            for (int m = 0; m < 4; ++m) { const int row = row0 + ai * HALF + m * 16; const size_t off = (size_t)row * DM + col0; float sq = 0.f;
#pragma unroll
                for (int bj = 0; bj < 2; ++bj) { float* xp = X + off + bj * HALF; const float* xi = Xin + off + bj * HALF;
                    f32x4 a = *(const f32x4*)xi, b = *(const f32x4*)(xi + 4);
                    a = a + acc[ai][bj][m][0] * scale; b = b + acc[ai][bj][m][1] * scale;
                    *(f32x4*)xp = a; *(f32x4*)(xp + 4) = b;
                    sq += (a[0] * a[0] + a[1] * a[1]) + (a[2] * a[2] + a[3] * a[3]) + (b[0] * b[0] + b[1] * b[1]) + (b[2] * b[2] + b[3] * b[3]);
                    u32x4 w; w.x = pk2(a[0], a[1]); w.y = pk2(a[2], a[3]); w.z = pk2(b[0], b[1]); w.w = pk2(b[2], b[3]);
                    *(u32x4*)(XB + off + bj * HALF) = w; }
                sq += __shfl_xor(sq, 16); sq += __shfl_xor(sq, 32);
                if (fq == 0) lq[wc * 256 + (ai * HALF + wr * 64 + m * 16 + fr)] = sq;
                asm volatile("" ::: "memory"); }
        asm volatile("s_waitcnt lgkmcnt(0)" ::: "memory"); __builtin_amdgcn_s_barrier(); asm volatile("" ::: "memory");
        if (wr == 0) { const int rr = wc * 64 + fq * 16 + fr;
            SS[(size_t)(u.pm * BM + rr) * 4 + u.pn] = (lq[rr] + lq[256 + rr]) + (lq[512 + rr] + lq[768 + rr]); }
    }
};
struct EpiBf16 {
    bf16_t* O; int ldc; const float* rs;
    __device__ __forceinline__ void operator()(const Acc& acc, const Unit& u, int wr, int wc, int fr, int fq) const {
        const int row0 = u.pm * BM + wr * 64 + fr, col0 = u.pn * BM + wc * 32 + 8 * fq;
#pragma unroll
        for (int ai = 0; ai < 2; ++ai)
#pragma unroll
            for (int m = 0; m < 4; ++m) { const int row = row0 + ai * HALF + m * 16; const float r = rs ? rs[row] : 1.0f;
#pragma unroll
                for (int bj = 0; bj < 2; ++bj) { const f32x4 a = acc[ai][bj][m][0] * r, b = acc[ai][bj][m][1] * r;
                    u32x4 w; w.x = pk2(a[0], a[1]); w.y = pk2(a[2], a[3]); w.z = pk2(b[0], b[1]); w.w = pk2(b[2], b[3]);
                    *(u32x4*)(O + (size_t)row * ldc + col0 + bj * HALF) = w; } }
    }
};
constexpr float AQ_SCALE = 0.125f * 1.4426950408889634f;
struct EpiProj {
    bf16_t* O; const float* ss; bf16_t* SIDE;
    __device__ __forceinline__ void operator()(const Acc& acc, const Unit& u, int wr, int wc, int fr, int fq) const {
        const int row0 = u.pm * BM + wr * 64 + fr; int col0 = u.pn * BM + wc * 32 + 8 * fq;
        const bool sg = (u.pn >= O_G / BM) && (u.pn < O_AK / BM);
        const float qs = (u.pn >= O_AQ / BM && u.pn < O_G / BM) ? AQ_SCALE : 1.0f;
        bf16_t* base = O; int ldc = LDP;
        if (u.pn >= O_SIDE / BM) { base = SIDE; ldc = LDS_; col0 -= O_SIDE; }
        float rs[8]; rstd8(ss, row0, qs, rs);
#pragma unroll
        for (int ai = 0; ai < 2; ++ai)
#pragma unroll
            for (int m = 0; m < 4; ++m) { const int row = row0 + ai * HALF + m * 16; const float r = rs[ai * 4 + m];
#pragma unroll
                for (int bj = 0; bj < 2; ++bj) { f32x4 a = acc[ai][bj][m][0] * r, b = acc[ai][bj][m][1] * r;
                    if (sg) {
#pragma unroll
                        for (int j = 0; j < 4; ++j) { a[j] = fmaxf(fsigmoid(a[j]), 1e-10f); b[j] = fmaxf(fsigmoid(b[j]), 1e-10f); } }
                    u32x4 w; w.x = pk2(a[0], a[1]); w.y = pk2(a[2], a[3]); w.z = pk2(b[0], b[1]); w.w = pk2(b[2], b[3]);
                    *(u32x4*)(base + (size_t)row * ldc + col0 + bj * HALF) = w; } }
    }
};
struct MergeHook {
    static constexpr bool ON = true;
    const bf16_t* S;
    __device__ __forceinline__ void operator()(Acc& acc, const Unit& u, int t, int wr, int wc, int fr, int fq) const {
        if (t != 8 && t != 24) return;
        int row0 = u.pm * BM + wr * 64 + fr, col0 = u.pn * BM + wc * 32 + 8 * fq + ((t == 8) ? 0 : DM);
        asm volatile("" : "+v"(row0), "+v"(col0));
#pragma unroll
        for (int ai = 0; ai < 2; ++ai) {
            u32x4 nv[4][2], dv[4][2];
#pragma unroll
            for (int m = 0; m < 4; ++m)
#pragma unroll
                for (int bj = 0; bj < 2; ++bj) { const bf16_t* gp = S + (size_t)(row0 + ai * HALF + m * 16) * LDP + col0 + bj * HALF; nv[m][bj] = *(const u32x4*)gp; dv[m][bj] = *(const u32x4*)(gp + DM); }
            asm volatile("" : "+v"(nv[0][0]), "+v"(nv[0][1]), "+v"(nv[1][0]), "+v"(nv[1][1]), "+v"(nv[2][0]), "+v"(nv[2][1]), "+v"(nv[3][0]), "+v"(nv[3][1]),
                              "+v"(dv[0][0]), "+v"(dv[0][1]), "+v"(dv[1][0]), "+v"(dv[1][1]), "+v"(dv[2][0]), "+v"(dv[2][1]), "+v"(dv[3][0]), "+v"(dv[3][1]));
#pragma unroll
            for (int m = 0; m < 4; ++m)
#pragma unroll
                for (int bj = 0; bj < 2; ++bj) { const u32x4 n = nv[m][bj], d = dv[m][bj];
                    f32x4 ra, rb;
                    ra[0] = bflo(n.x) * __builtin_amdgcn_rcpf(bflo(d.x)); ra[1] = bfhi(n.x) * __builtin_amdgcn_rcpf(bfhi(d.x)); ra[2] = bflo(n.y) * __builtin_amdgcn_rcpf(bflo(d.y)); ra[3] = bfhi(n.y) * __builtin_amdgcn_rcpf(bfhi(d.y));
                    rb[0] = bflo(n.z) * __builtin_amdgcn_rcpf(bflo(d.z)); rb[1] = bfhi(n.z) * __builtin_amdgcn_rcpf(bfhi(d.z)); rb[2] = bflo(n.w) * __builtin_amdgcn_rcpf(bflo(d.w)); rb[3] = bfhi(n.w) * __builtin_amdgcn_rcpf(bfhi(d.w));
                    acc[ai][bj][m][0] *= ra; acc[ai][bj][m][1] *= rb; }
            asm volatile("" ::: "memory"); }
    }
};
struct NoHook { static constexpr bool ON = false; __device__ __forceinline__ void operator()(Acc&, const Unit&, int, int, int, int, int) const {} };
struct EpiMerge {
    bf16_t* O; const bf16_t* S2;
    __device__ __forceinline__ void operator()(const Acc& acc, const Unit& u, int wr, int wc, int fr, int fq) const {
        const int row0 = u.pm * BM + wr * 64 + fr, col0 = u.pn * BM + wc * 32 + 8 * fq;
#pragma unroll
        for (int ai = 0; ai < 2; ++ai)
#pragma unroll
            for (int m = 0; m < 4; ++m) { const int row = row0 + ai * HALF + m * 16;
#pragma unroll
                for (int bj = 0; bj < 2; ++bj) { const u32x4 g = *(const u32x4*)(S2 + (size_t)row * LDP + col0 + bj * HALF);
                    const f32x4 a = acc[ai][bj][m][0], b = acc[ai][bj][m][1];
                    u32x4 w;
                    w.x = pk2(a[0] * bflo(g.x), a[1] * bfhi(g.x)); w.y = pk2(a[2] * bflo(g.y), a[3] * bfhi(g.y));
                    w.z = pk2(b[0] * bflo(g.z), b[1] * bfhi(g.z)); w.w = pk2(b[2] * bflo(g.w), b[3] * bfhi(g.w));
                    *(u32x4*)(O + (size_t)row * DM + col0 + bj * HALF) = w; }
                asm volatile("" ::: "memory"); }
    }
};
struct EpiPle {
    float* X; bf16_t* XB; const bf16_t* PP; const float* ss; float* SSout; LAS float* lq;
    __device__ __forceinline__ void operator()(const Acc& acc, const Unit& u, int wr, int wc, int fr, int fq) const {
        const int row0 = u.pm * BM + wr * 64 + fr, col0 = u.pn * BM + wc * 32 + 8 * fq;
#pragma unroll
        for (int ai = 0; ai < 2; ++ai)
#pragma unroll
            for (int m = 0; m < 4; ++m) { const int row = row0 + ai * HALF + m * 16; const float r = rstd_of(ss + (size_t)row * 4); const size_t off = (size_t)row * DM + col0; float sq = 0.f;
#pragma unroll
                for (int bj = 0; bj < 2; ++bj) { float* xp = X + off + bj * HALF;
                    f32x4 a = *(const f32x4*)xp, b = *(const f32x4*)(xp + 4); const u32x4 p = *(const u32x4*)(PP + off + bj * HALF);
                    const f32x4 ga = acc[ai][bj][m][0] * r, gb = acc[ai][bj][m][1] * r;
                    a[0] += fsigmoid(ga[0]) * bflo(p.x); a[1] += fsigmoid(ga[1]) * bfhi(p.x); a[2] += fsigmoid(ga[2]) * bflo(p.y); a[3] += fsigmoid(ga[3]) * bfhi(p.y);
                    b[0] += fsigmoid(gb[0]) * bflo(p.z); b[1] += fsigmoid(gb[1]) * bfhi(p.z); b[2] += fsigmoid(gb[2]) * bflo(p.w); b[3] += fsigmoid(gb[3]) * bfhi(p.w);
                    *(f32x4*)xp = a; *(f32x4*)(xp + 4) = b;
                    sq += (a[0] * a[0] + a[1] * a[1]) + (a[2] * a[2] + a[3] * a[3]) + (b[0] * b[0] + b[1] * b[1]) + (b[2] * b[2] + b[3] * b[3]);
                    u32x4 w; w.x = pk2(a[0], a[1]); w.y = pk2(a[2], a[3]); w.z = pk2(b[0], b[1]); w.w = pk2(b[2], b[3]);
                    *(u32x4*)(XB + off + bj * HALF) = w; }
                sq += __shfl_xor(sq, 16); sq += __shfl_xor(sq, 32);
                if (fq == 0) lq[wc * 256 + (ai * HALF + wr * 64 + m * 16 + fr)] = sq;
                asm volatile("" ::: "memory"); }
        asm volatile("s_waitcnt lgkmcnt(0)" ::: "memory"); __builtin_amdgcn_s_barrier(); asm volatile("" ::: "memory");
        if (wr == 0) { const int rr = wc * 64 + fq * 16 + fr;
            SSout[(size_t)(u.pm * BM + rr) * 4 + u.pn] = (lq[rr] + lq[256 + rr]) + (lq[512 + rr] + lq[768 + rr]); }
    }
};

template <class Epi, class Hook = NoHook>
__device__ __forceinline__ void gemm_phase(LAS unsigned char* lds, const Gemm g, const StaticOrder& S, const Epi& E, const Hook H = Hook()) {
    int tid = threadIdx.x; asm volatile("" : "+v"(tid));
    const int wid = __builtin_amdgcn_readfirstlane(tid >> 6), lane = tid & 63, wr = wid >> 2, wc = wid & 3, fr = lane & 15, fq = lane >> 4;
    const int K = g.K, nt = K / BK, lda = g.lda;
    unsigned voffA[2], voffB[2];
#pragma unroll
    for (int i = 0; i < 2; ++i) { int R, C; stage_rc(tid * 16 + i * 8192, R, C); const int Rb = (R & ~31) + perm32(R & 31);
        voffA[i] = (unsigned)(R * lda + C) * 2u; voffB[i] = (unsigned)(Rb * K + C) * 2u; }
    const size_t kstep = (size_t)(BK * 2);
    const size_t hstepA = (size_t)HALF * lda * 2, tstepA = 2 * hstepA;
    const size_t hstepB = (size_t)HALF * K * 2, tstepB = 2 * hstepB;
    const unsigned ldsw = (unsigned)wid * 1024u;
    const int aoff = lds_byte(wr * 64 + fr, fq * 8), boff = lds_byte(wc * 32 + fr, fq * 8);
#define PG8_SA(b, h) (((b) * 2 + (h)) * HTB)
#define PG8_SB(b, h) ((4 + (b) * 2 + (h)) * HTB)
#define PG8_STAGE(bufoff, gbase, voff) do { _Pragma("unroll") for (int _i = 0; _i < 2; ++_i) \
        __builtin_amdgcn_global_load_lds((const unsigned*)((const char*)(gbase) + (voff)[_i]), (LAS unsigned*)(lds + (bufoff) + ldsw + _i * 8192), 16, 0, 0); } while (0)
#define PG8_LDA(dst, b, h) do { _Pragma("unroll") for (int m = 0; m < 4; ++m) _Pragma("unroll") for (int k = 0; k < 2; ++k) dst[m][k] = *(const LAS bf16x8*)(lds + PG8_SA(b, h) + aoff + m * 2048 + k * 1024); } while (0)
#define PG8_LDB(dst, b, h) do { _Pragma("unroll") for (int n = 0; n < 2; ++n) _Pragma("unroll") for (int k = 0; k < 2; ++k) dst[n][k] = *(const LAS bf16x8*)(lds + PG8_SB(b, h) + boff + n * 2048 + k * 1024); } while (0)
#define PG8_MMA(ai, bj, At, Bt) do { __builtin_amdgcn_s_setprio(1); _Pragma("unroll") for (int m = 0; m < 4; ++m) _Pragma("unroll") for (int n = 0; n < 2; ++n) _Pragma("unroll") for (int k = 0; k < 2; ++k) \
        acc[ai][bj][m][n] = __builtin_amdgcn_mfma_f32_16x16x32_bf16(Bt[n][k], At[m][k], acc[ai][bj][m][n], 0, 0, 0); __builtin_amdgcn_s_setprio(0); } while (0)
#define PG8_WAIT_V(n) asm volatile("s_waitcnt vmcnt(" #n ")" ::: "memory")
#define PG8_WAIT_L(n) asm volatile("s_waitcnt lgkmcnt(" #n ")" ::: "memory")
#define PG8_BAR __builtin_amdgcn_s_barrier()
#define PG8_SCHED __builtin_amdgcn_sched_barrier(0)
    Unit cur, nxt; int ui = 0;
    if (!S.next(0, cur)) return;
    Acc acc;
#pragma unroll
    for (int a = 0; a < 2; ++a)
#pragma unroll
        for (int b = 0; b < 2; ++b)
#pragma unroll
            for (int m = 0; m < 4; ++m)
#pragma unroll
                for (int n = 0; n < 2; ++n) acc[a][b][m][n] = (f32x4){0.f, 0.f, 0.f, 0.f};
    bf16x8 At[4][2], B0[2][2], B1[2][2];
    const char* cA = (const char*)g.A + (size_t)cur.pm * tstepA; const char* cB = (const char*)g.Bt + (size_t)cur.pn * tstepB;
    PG8_STAGE(PG8_SB(0, 0), cB, voffB); PG8_STAGE(PG8_SB(0, 1), cB + hstepB, voffB); PG8_STAGE(PG8_SA(0, 0), cA, voffA); PG8_STAGE(PG8_SA(0, 1), cA + hstepA, voffA);
    if (wr == 1) PG8_BAR;
    PG8_WAIT_V(2); PG8_BAR;
    PG8_STAGE(PG8_SB(1, 0), cB + kstep, voffB); PG8_STAGE(PG8_SA(1, 0), cA + kstep, voffA); PG8_STAGE(PG8_SB(1, 1), cB + hstepB + kstep, voffB);
    PG8_WAIT_V(6); PG8_BAR;
    for (;;) {
        const bool has_next = S.next(ui + 1, nxt);
        const char* nA = has_next ? (const char*)g.A + (size_t)nxt.pm * tstepA : cA; const char* nB = has_next ? (const char*)g.Bt + (size_t)nxt.pn * tstepB : cB;
#pragma unroll 1
        for (int t = 0; t < nt; t += 2) {
            const bool last = (t == nt - 2);
            const char* a1 = cA + (size_t)(t + 1) * kstep;
            const char* a2 = last ? nA : cA + (size_t)(t + 2) * kstep; const char* b2 = last ? nB : cB + (size_t)(t + 2) * kstep;
            const char* a3 = a2 + kstep; const char* b3 = b2 + kstep;
            if constexpr (Hook::ON) H(acc, cur, t, wr, wc, fr, fq);
            PG8_LDB(B0, 0, 0); PG8_LDB(B1, 0, 1); PG8_SCHED; PG8_LDA(At, 0, 0); PG8_STAGE(PG8_SA(1, 1), a1 + hstepA, voffA);
            PG8_WAIT_V(8); PG8_WAIT_L(0); PG8_BAR; PG8_MMA(0, 0, At, B0); PG8_MMA(0, 1, At, B1); PG8_BAR; PG8_SCHED;
            PG8_LDA(At, 0, 1); PG8_STAGE(PG8_SB(0, 0), b2, voffB); PG8_STAGE(PG8_SB(0, 1), b2 + hstepB, voffB); PG8_STAGE(PG8_SA(0, 0), a2, voffA);
            PG8_WAIT_V(8); PG8_WAIT_L(0); PG8_BAR; PG8_MMA(1, 0, At, B0); PG8_MMA(1, 1, At, B1); PG8_BAR; PG8_SCHED;
            PG8_LDB(B0, 1, 0); PG8_LDB(B1, 1, 1); PG8_SCHED; PG8_LDA(At, 1, 0); PG8_STAGE(PG8_SA(0, 1), a2 + hstepA, voffA);
            PG8_WAIT_V(8); PG8_WAIT_L(0); PG8_BAR; PG8_MMA(0, 0, At, B0); PG8_MMA(0, 1, At, B1); PG8_BAR; PG8_SCHED;
            PG8_LDA(At, 1, 1); PG8_STAGE(PG8_SB(1, 0), b3, voffB); PG8_STAGE(PG8_SB(1, 1), b3 + hstepB, voffB); PG8_STAGE(PG8_SA(1, 0), a3, voffA);
            PG8_WAIT_V(8); PG8_WAIT_L(0); PG8_BAR; PG8_MMA(1, 0, At, B0); PG8_MMA(1, 1, At, B1); PG8_BAR; PG8_SCHED;
        }
        if (ALIGN_EPI) { if (wr == 0) PG8_BAR; }
        E(acc, cur, wr, wc, fr, fq);
        if (!has_next) break;
#pragma unroll
        for (int a = 0; a < 2; ++a)
#pragma unroll
            for (int b = 0; b < 2; ++b)
#pragma unroll
                for (int m = 0; m < 4; ++m)
#pragma unroll
                    for (int n = 0; n < 2; ++n) acc[a][b][m][n] = (f32x4){0.f, 0.f, 0.f, 0.f};
        cur = nxt; cA = nA; cB = nB; ++ui;
        if (ALIGN_EPI) { if (wr == 1) PG8_BAR; }
    }
    PG8_WAIT_V(0);
    if (!ALIGN_EPI) { if (wr == 0) PG8_BAR; }
    PG8_BAR;
#undef PG8_SA
#undef PG8_SB
#undef PG8_STAGE
#undef PG8_LDA
#undef PG8_LDB
#undef PG8_MMA
#undef PG8_WAIT_V
#undef PG8_WAIT_L
#undef PG8_BAR
#undef PG8_SCHED
}
}

#define XB_TMO      128
#define XB_XCNT(j)  (256  + 64 * (j))
#define XB_XSUB(j)  (1280 + 64 * (j))
#define XB_XGEN(j)  (2304 + 64 * (j))
#define XB_TOP      3328
#define XB_TOPGEN   3392
#define XCD_BAR_WORDS 3456
#define XB_SPIN_CAP (1u << 18)
__device__ __forceinline__ unsigned xb_ld(unsigned* p)              { return __hip_atomic_load(p, __ATOMIC_RELAXED, __HIP_MEMORY_SCOPE_AGENT); }
__device__ __forceinline__ unsigned xb_add(unsigned* p, unsigned v) { return __hip_atomic_fetch_add(p, v, __ATOMIC_RELAXED, __HIP_MEMORY_SCOPE_AGENT); }
__device__ __forceinline__ unsigned xb_xcc_id() { return (unsigned)__builtin_amdgcn_s_getreg((3 << 11) | 20) & 0xFu; }
#define XB_SPIN(cond, bar) do { unsigned _sp = 0; while (cond) { __builtin_amdgcn_s_sleep(1); \
    if ((++_sp & 255u) == 0u) { if (xb_ld(&(bar)[XB_TMO])) break; if (_sp > XB_SPIN_CAP) { atomicAdd(&(bar)[XB_TMO], 1u); break; } } } } while (0)
struct XcdBarrier { unsigned* bar; unsigned x; volatile LAS unsigned* st; };
__device__ __forceinline__ XcdBarrier xcd_barrier_post(unsigned* bar, volatile LAS unsigned* st) {
    XcdBarrier b; b.bar = bar; b.x = xb_xcc_id(); b.st = st;
    if (threadIdx.x == 0) (void)xb_add(&bar[XB_XCNT(b.x)], 1u);
    return b;
}
__device__ __forceinline__ void xcd_barrier_complete(unsigned* bar, unsigned x, unsigned& nloc, unsigned& nx) {
    const unsigned G = gridDim.x * gridDim.y * gridDim.z;
    unsigned sum, cnt, mine, sp = 0u;
    for (;;) {
        sum = 0u; cnt = 0u; mine = 0u;
#pragma unroll
        for (unsigned j = 0; j < 16; ++j) { const unsigned c = xb_ld(&bar[XB_XCNT(j)]); sum += c; cnt += (c > 0u) ? 1u : 0u; mine = (j == x) ? c : mine; }
        if (sum == G) break;
        __builtin_amdgcn_s_sleep(1);
        if ((++sp & 255u) == 0u) { if (xb_ld(&bar[XB_TMO])) break; if (sp > XB_SPIN_CAP) { atomicAdd(&bar[XB_TMO], 1u); break; } }
    }
    nloc = mine > 0u ? mine : 1u; nx = cnt > 0u ? cnt : 1u;
}
__device__ __forceinline__ void xcd_barrier(const XcdBarrier& b) {
    asm volatile("s_waitcnt vmcnt(0)" ::: "memory");
    __syncthreads();
    if (threadIdx.x == 0) {
        unsigned* bar = b.bar;
        __builtin_amdgcn_s_waitcnt(0);
        unsigned nloc = b.st[0], nx = b.st[1];
        if (nloc == 0u) { xcd_barrier_complete(bar, b.x, nloc, nx); b.st[0] = nloc; b.st[1] = nx; }
        const unsigned old = xb_add(&bar[XB_XSUB(b.x)], 1u);
        const unsigned gen = old / nloc;
        if (old + 1u == (gen + 1u) * nloc) {
            __builtin_amdgcn_fence(__ATOMIC_RELEASE, "agent");
            asm volatile("s_waitcnt vmcnt(0)" ::: "memory");
            const unsigned og = xb_add(&bar[XB_TOP], 1u);
            const unsigned tg = og / nx;
            if (og + 1u == (tg + 1u) * nx) xb_add(&bar[XB_TOPGEN], 1u);
            else XB_SPIN(xb_ld(&bar[XB_TOPGEN]) == tg, bar);
            __builtin_amdgcn_fence(__ATOMIC_ACQUIRE, "agent");
            xb_add(&bar[XB_XGEN(b.x)], 1u);
            asm volatile("s_waitcnt vmcnt(0)" ::: "memory");
        } else {
            XB_SPIN(xb_ld(&bar[XB_XGEN(b.x)]) == gen, bar);
            __builtin_amdgcn_fence(__ATOMIC_ACQUIRE, "agent");
            asm volatile("s_waitcnt vmcnt(0)" ::: "memory");
        }
    }
    __syncthreads();
}

struct Args { const float* in[22]; float* out; unsigned char* ws; int ph_lo, ph_hi; };
struct Ctx { LAS unsigned char* lds; int G, bid; };
#define TID_SETUP() int tid = threadIdx.x; asm volatile("" : "+v"(tid)); const int lane = tid & 63, wave = __builtin_amdgcn_readfirstlane(tid >> 6); (void)lane; (void)wave
typedef const __attribute__((address_space(4))) Args* ArgsP;
__device__ __forceinline__ ArgsP args_ptr() { ArgsP p = (ArgsP)__builtin_amdgcn_kernarg_segment_ptr(); asm volatile("" : "+s"(p)); return p; }
#define WSP(T, off) ((T*)(A->ws + (off)))

struct MapId { __device__ __forceinline__ int operator()(int n) const { return n; } };
struct MapGU { __device__ __forceinline__ int operator()(int n) const { const int t = n >> 8, w = n & 255; return w < 128 ? 128 * t + w : DFF + 128 * t + (w - 128); } };
struct MapIn { __device__ __forceinline__ int operator()(int n) const {
    if (n < 3072) return n + 512; if (n < 3584) return n - 3072; if (n < 4608) return n; if (n < 5120) return n + 8; if (n < 8192) return n + 460; if (n < 8640) return n - 3064;
    if (n < 8644) return 4608 + (n - 8640); if (n < 8648) return 4612 + (n - 8644); if (n < 8652) return 5576 + (n - 8648); return -1; } };
template <class Map>
__device__ __forceinline__ void conv_item(const float* W, int K, int N, bf16_t* WT, int ldt, int koff, const float* gain, LAS float* scr, int item, int nblk, int lane, Map map) {
    const int kb = item / nblk, nb = item % nblk, k0 = 64 * kb, n0 = 32 * nb;
    const int c = map(n0 + (lane & 31));
    float wv[32];
#pragma unroll
    for (int i = 0; i < 32; ++i) { const int kk = 2 * i + (lane >> 5); wv[i] = (c >= 0) ? W[(size_t)(k0 + kk) * N + c] : 0.f; }
#pragma unroll
    for (int i = 0; i < 32; ++i) { const int kk = 2 * i + (lane >> 5); float v = wv[i]; if (gain) v *= gain[k0 + kk]; scr[kk * 33 + (lane & 31)] = v; }
    asm volatile("s_waitcnt lgkmcnt(0)" ::: "memory");
    const int c8 = lane & 7;
#pragma unroll
    for (int j = 0; j < 4; ++j) { const int n = (lane >> 3) + 8 * j; const LAS float* s = scr + (8 * c8) * 33 + n;
        u32x4 o; o.x = pk2(s[0 * 33], s[1 * 33]); o.y = pk2(s[2 * 33], s[3 * 33]); o.z = pk2(s[4 * 33], s[5 * 33]); o.w = pk2(s[6 * 33], s[7 * 33]);
        *(u32x4*)(WT + (size_t)(n0 + n) * ldt + koff + k0 + 8 * c8) = o; }
    asm volatile("s_waitcnt lgkmcnt(0)" ::: "memory");
}
__device__ __forceinline__ void phase_convert(const Ctx& C, int l) {
    TID_SETUP(); ArgsP A = args_ptr(); const int gw = C.bid * NWAVES + wave, NGW = C.G * NWAVES;
    LAS float* scr = (LAS float*)(C.lds + wave * 16384);
    bf16_t* W = WSP(bf16_t, WS_W);
    constexpr int I_GU = 16 * 176, I_DN = 44 * 32, I_IN = 16 * 272, I_CO = 8 * 32, I_MO = 16 * 32, I_AO = 8 * 32, I_O = 16 * 32, I_PG = 16 * 32, I_PP = 4 * 32;
    constexpr int NIT = 2 * I_GU + 2 * I_DN + I_IN + I_CO + I_MO + I_AO + I_O + I_PG + I_PP;
    for (int it = gw; it < NIT; it += NGW) {
        int r = it;
        if (r < I_GU) { conv_item(A->in[3] + (size_t)l * DM * 2 * DFF, DM, 2 * DFF, W + W_GU1, DM, 0, A->in[2] + (size_t)l * DM, scr, r, 176, lane, MapGU()); continue; } r -= I_GU;
        if (r < I_GU) { conv_item(A->in[16] + (size_t)l * DM * 2 * DFF, DM, 2 * DFF, W + W_GU2, DM, 0, A->in[15] + (size_t)l * DM, scr, r, 176, lane, MapGU()); continue; } r -= I_GU;
        if (r < I_DN) { conv_item(A->in[4] + (size_t)l * DFF * DM, DFF, DM, W + W_DN1, DFF, 0, nullptr, scr, r, 32, lane, MapId()); continue; } r -= I_DN;
        if (r < I_DN) { conv_item(A->in[17] + (size_t)l * DFF * DM, DFF, DM, W + W_DN2, DFF, 0, nullptr, scr, r, 32, lane, MapId()); continue; } r -= I_DN;
        if (r < I_IN) { conv_item(A->in[6] + (size_t)l * DM * 8652, DM, 8652, W + W_IN, DM, 0, A->in[5] + (size_t)l * DM, scr, r, 272, lane, MapIn()); continue; } r -= I_IN;
        if (r < I_CO) { conv_item(A->in[8] + (size_t)l * DCONV * DM, DCONV, DM, W + W_MRG, 2048, 0, nullptr, scr, r, 32, lane, MapId()); continue; } r -= I_CO;
        if (r < I_MO) { conv_item(A->in[12] + (size_t)l * DM * DM, DM, DM, W + W_MRG, 2048, 512, nullptr, scr, r, 32, lane, MapId()); continue; } r -= I_MO;
        if (r < I_AO) { conv_item(A->in[13] + (size_t)l * 512 * DM, 512, DM, W + W_MRG, 2048, 1536, nullptr, scr, r, 32, lane, MapId()); continue; } r -= I_AO;
        if (r < I_O) { conv_item(A->in[14] + (size_t)l * DM * DM, DM, DM, W + W_O, DM, 0, nullptr, scr, r, 32, lane, MapId()); continue; } r -= I_O;
        if (r < I_PG) { conv_item(A->in[19] + (size_t)l * DM * DM, DM, DM, W + W_PG, DM, 0, A->in[18] + (size_t)l * DM, scr, r, 32, lane, MapId()); continue; } r -= I_PG;
        conv_item(A->in[20] + (size_t)l * DPLE * DM, DPLE, DM, W + W_PP, DPLE, 0, nullptr, scr, r, 32, lane, MapId());
    }
}
__device__ __forceinline__ void phase_init_rows(const Ctx& C) {
    TID_SETUP(); ArgsP A = args_ptr(); const int gw = C.bid * NWAVES + wave, NGW = C.G * NWAVES;
    const float* x = A->in[0]; bf16_t* XB = WSP(bf16_t, WS_XB); float* SS0 = WSP(float, WS_SS0);
    for (int m0 = 4 * gw; m0 < MTOK; m0 += 4 * NGW) {
        f32x4 v[4][4];
#pragma unroll
        for (int k = 0; k < 4; ++k) { const int m = m0 + k; const f32x4* xr = (const f32x4*)(x + (size_t)m * DM) + lane;
#pragma unroll
            for (int j = 0; j < 4; ++j) v[k][j] = xr[64 * j]; }
#pragma unroll
        for (int k = 0; k < 4; ++k) { const int m = m0 + k;
            { u32x2* bo = (u32x2*)(XB + (size_t)m * DM) + lane; float s = 0.f;
#pragma unroll
                for (int j = 0; j < 4; ++j) { const f32x4 t = v[k][j]; u32x2 w; w.x = pk2(t[0], t[1]); w.y = pk2(t[2], t[3]); bo[64 * j] = w; s += (t[0] * t[0] + t[1] * t[1]) + (t[2] * t[2] + t[3] * t[3]); }
                s = wave_sum(s);
                if (lane == 0) *(f32x4*)(SS0 + (size_t)m * 4) = (f32x4){s, 0.f, 0.f, 0.f}; } }
    }
}
__device__ __forceinline__ void phase_pb(const Ctx& C, int l) {
    TID_SETUP(); ArgsP A = args_ptr();
    const f32x4* p = (const f32x4*)(A->in[1] + (size_t)l * MTOK * DPLE); u32x2* o = WSP(u32x2, WS_PB);
    const size_t n4 = (size_t)MTOK * DPLE / 4;
    for (size_t i = (size_t)C.bid * NTHR + tid; i < n4; i += (size_t)C.G * NTHR) { const f32x4 v = p[i]; u32x2 w; w.x = pk2(v[0], v[1]); w.y = pk2(v[2], v[3]); o[i] = w; }
}
__device__ __forceinline__ void phase_final(const Ctx& C) {
    TID_SETUP(); ArgsP A = args_ptr(); const int gw = C.bid * NWAVES + wave, NGW = C.G * NWAVES;
    const f32x4* gn = (const f32x4*)A->in[21] + lane; float* X = A->out; const float* SS = WSP(float, WS_SS0);
    f32x4 g4[4];
#pragma unroll
    for (int j = 0; j < 4; ++j) g4[j] = gn[64 * j];
    for (int m0 = 4 * gw; m0 < MTOK; m0 += 4 * NGW) {
        f32x4 v[4][4]; float r[4];
#pragma unroll
        for (int k = 0; k < 4; ++k) { const int m = m0 + k; const f32x4* xr = (const f32x4*)(X + (size_t)m * DM) + lane;
#pragma unroll
            for (int j = 0; j < 4; ++j) v[k][j] = xr[64 * j];
            r[k] = rstd_of(SS + (size_t)m * 4); }
#pragma unroll
        for (int k = 0; k < 4; ++k) { const int m = m0 + k;
            { f32x4* xr = (f32x4*)(X + (size_t)m * DM) + lane;
#pragma unroll
                for (int j = 0; j < 4; ++j) xr[64 * j] = v[k][j] * r[k] * g4[j]; } }
    }
}

__device__ __forceinline__ void prep_conv(const Ctx& C, int l, int b, int part, int nparts, int dry) {
    TID_SETUP(); ArgsP A = args_ptr();
    const float* cw = A->in[7] + (size_t)l * 3 * DCONV; bf16_t* PROJ = WSP(bf16_t, WS_PROJ);
    const int nit = SEQ * 64;
    for (int i = part * NTHR + tid; i < nit; i += nparts * NTHR) {
        const int ts = i >> 6, ch = (i & 63) * 8, tok = b * SEQ + ts;
        bf16_t* row = PROJ + (size_t)tok * LDP;
        const u32x4 b = *(const u32x4*)(row + O_CB + ch);
        float u[3][8];
#pragma unroll
        for (int d = 0; d < 3; ++d) {
            const int back = 2 - d;
            if (ts >= back) { const bf16_t* r2 = row - (size_t)back * LDP; const u32x4 c = *(const u32x4*)(r2 + O_CC + ch), x = *(const u32x4*)(r2 + O_CX + ch);
                const unsigned cwv[4] = {c.x, c.y, c.z, c.w}, xwv[4] = {x.x, x.y, x.z, x.w};
#pragma unroll
                for (int j = 0; j < 4; ++j) { u[d][2 * j] = bflo(cwv[j]) * bflo(xwv[j]); u[d][2 * j + 1] = bfhi(cwv[j]) * bfhi(xwv[j]); } }
            else {
#pragma unroll
                for (int j = 0; j < 8; ++j) u[d][j] = 0.f; }
        }
        const unsigned bw[4] = {b.x, b.y, b.z, b.w}; float o[8];
#pragma unroll
        for (int j = 0; j < 8; ++j) { const float bb = (j & 1) ? bfhi(bw[j >> 1]) : bflo(bw[j >> 1]);
            o[j] = bb * (u[0][j] * cw[ch + j] + u[1][j] * cw[DCONV + ch + j] + u[2][j] * cw[2 * DCONV + ch + j]); }
        u32x4 w; w.x = pk2(o[0], o[1]); w.y = pk2(o[2], o[3]); w.z = pk2(o[4], o[5]); w.w = pk2(o[6], o[7]);
        if (!dry) *(u32x4*)(row + O_CB + ch) = w;
    }
}
__device__ __forceinline__ void prep_gate(const Ctx& C, int l, int part, int nparts, int dry = 0) {
    TID_SETUP(); ArgsP A = args_ptr();
    const float* gn = A->in[11] + (size_t)l * DM; bf16_t* PROJ = WSP(bf16_t, WS_PROJ);
    const int nit = MG * 4, g = lane >> 4, li = lane & 15;
    for (int i = (part * NWAVES + wave) * 4 + g; i < nit; i += nparts * NWAVES * 4) {
        const int tok = i >> 2, hd = i & 3;
        bf16_t* row = PROJ + (size_t)tok * LDP;
        const u32x4 h0 = *(const u32x4*)(row + O_MV + hd * 256 + li * 16), h1 = *(const u32x4*)(row + O_MV + hd * 256 + li * 16 + 8);
        const u32x4 o0 = *(const u32x4*)(row + O_MO + hd * 256 + li * 16), o1 = *(const u32x4*)(row + O_MO + hd * 256 + li * 16 + 8);
        const unsigned hw[8] = {h0.x, h0.y, h0.z, h0.w, h1.x, h1.y, h1.z, h1.w}, ow[8] = {o0.x, o0.y, o0.z, o0.w, o1.x, o1.y, o1.z, o1.w};
        float ssq = 0.f;
#pragma unroll
        for (int j = 0; j < 8; ++j) { const float a = bflo(hw[j]), bb = bfhi(hw[j]); ssq += a * a + bb * bb; }
#pragma unroll
        for (int o = 1; o < 16; o <<= 1) ssq += __shfl_xor(ssq, o);
        const float r = 1.0f / sqrtf(ssq * (1.0f / 256.0f) + EPS);
        const f32x4* gp = (const f32x4*)(gn + hd * 256 + li * 16);
        unsigned w[8];
#pragma unroll
        for (int j = 0; j < 4; ++j) { const f32x4 gv = gp[j];
            w[2 * j] = pk2(fsigmoid(bflo(ow[2 * j])) * bflo(hw[2 * j]) * r * gv[0], fsigmoid(bfhi(ow[2 * j])) * bfhi(hw[2 * j]) * r * gv[1]);
            w[2 * j + 1] = pk2(fsigmoid(bflo(ow[2 * j + 1])) * bflo(hw[2 * j + 1]) * r * gv[2], fsigmoid(bfhi(ow[2 * j + 1])) * bfhi(hw[2 * j + 1]) * r * gv[3]); }
        if (!dry) { *(u32x4*)(row + O_MO + hd * 256 + li * 16) = (u32x4){w[0], w[1], w[2], w[3]}; *(u32x4*)(row + O_MO + hd * 256 + li * 16 + 8) = (u32x4){w[4], w[5], w[6], w[7]}; }
    }
}

namespace ml {
constexpr int QS = 0, KS = 17408, VS = 34816, VW = 44032, PS = 53248, CB = 62464, SC = 97280, NP = 99328, NV = 103424, MS = 103936, LEND = 104704;
constexpr int PQ = 272, PT = 144;
static_assert(LEND <= RING_BYTES, "mlstm LDS");
typedef short s16x4 __attribute__((ext_vector_type(4)));
__device__ __forceinline__ f32x4 mfma16(bf16x8 a, bf16x8 b, f32x4 c) { return __builtin_amdgcn_mfma_f32_16x16x32_bf16(a, b, c, 0, 0, 0); }
__device__ __forceinline__ bf16x8 ldsv(const LAS unsigned char* p) { return *(const LAS bf16x8*)p; }
__device__ __forceinline__ bf16x8 frag_tr(const LAS unsigned char* X, int P, int r0, int c0, int lane) {
    const int g = lane >> 4, li = lane & 15;
    const LAS unsigned char* p = X + (r0 + 8 * g + (li >> 2)) * P + (c0 + 4 * (li & 3)) * 2;
    const s16x4 lo = __builtin_amdgcn_ds_read_tr16_b64_v4i16((LAS s16x4*)p), hi = __builtin_amdgcn_ds_read_tr16_b64_v4i16((LAS s16x4*)(p + 4 * P));
    return __builtin_shufflevector(lo, hi, 0, 1, 2, 3, 4, 5, 6, 7);
}

__device__ __forceinline__ void unit(const Ctx& C, int l, int uidx, int dry) {
    TID_SETUP(); ArgsP A = args_ptr();
    const int b = uidx >> 4, hd = (uidx >> 2) & 3, vq = uidx & 3;
    LAS unsigned char* L = C.lds;
    LAS float* sc = (LAS float*)(L + SC);
    LAS float* npart = (LAS float*)(L + NP);
    LAS float* nv = (LAS float*)(L + NV);
    LAS float* ms = (LAS float*)(L + MS);
    const int w = wave, fr = lane & 15, fq = lane >> 4;
    const float bi = A->in[9][l * 4 + hd], bfg = A->in[10][l * 4 + hd];
    bf16_t* base = WSP(bf16_t, WS_PROJ) + (size_t)b * SEQ * LDP;
    float* scr = WSP(float, WS_SCR) + (size_t)uidx * (64 * 192);
    for (int c = w; c < SEQ / 64; c += NWAVES) {
        const bf16_t* rb = WSP(bf16_t, WS_SIDE) + (size_t)(b * SEQ + c * 64 + lane) * LDS_;
        const float fv = bf2f(rb[O_MF - O_SIDE + hd]) + bfg, iv = bf2f(rb[O_MI - O_SIDE + hd]) + bi;
        const float lf = fminf(fv, 0.f) - log1pf(__expf(-fabsf(fv)));
        float bt = lf;
#pragma unroll
        for (int o = 1; o < 64; o <<= 1) { const float t = __shfl_up(bt, o); if (lane >= o) bt += t; }
        const float a = iv - bt; float pm = a;
#pragma unroll
        for (int o = 1; o < 64; o <<= 1) { const float t = __shfl_up(pm, o); if (lane >= o) pm = fmaxf(pm, t); }
        scr[c * 192 + lane] = a; scr[c * 192 + 64 + lane] = pm; scr[c * 192 + 128 + lane] = bt;
        if (lane == 63) { ms[64 + c] = bt; ms[128 + c] = pm; }
    }
    f32x4 cst[4];
#pragma unroll
    for (int i = 0; i < 4; ++i) cst[i] = (f32x4){0.f, 0.f, 0.f, 0.f};
    for (int i = tid; i < 2 * 64 * PQ / 4; i += NTHR) ((LAS unsigned*)(L + CB))[i] = 0u;
    for (int i = tid; i < 8 * 128; i += NTHR) npart[i] = 0.f;
    if (tid < 128) nv[tid] = 0.f;
    __syncthreads();
    if (tid == 0) { float m = 0.f; for (int c = 0; c < SEQ / 64; ++c) { ms[c] = m; m = ms[64 + c] + fmaxf(m, ms[128 + c]); } }
    const int qr = tid >> 4, qc = (tid & 15) * 8;
    const int vr = tid >> 3, vc = (tid & 7) * 8;
    u32x4 rq[2], rk[2], rv; float ra = 0.f, rpm = 0.f, rbt = 0.f;
#define ML_ISSUE(cc) do { const bf16_t* rb = base + (size_t)((cc) * 64) * LDP; \
        rq[0] = *(const u32x4*)(rb + (size_t)qr * LDP + O_MQ + hd * 128 + qc); rq[1] = *(const u32x4*)(rb + (size_t)(qr + 32) * LDP + O_MQ + hd * 128 + qc); \
        rk[0] = *(const u32x4*)(rb + (size_t)qr * LDP + O_MK + hd * 128 + qc); rk[1] = *(const u32x4*)(rb + (size_t)(qr + 32) * LDP + O_MK + hd * 128 + qc); \
        rv = *(const u32x4*)(rb + (size_t)vr * LDP + O_MV + hd * 256 + vq * 64 + vc); \
        if (w == 0) { ra = scr[(cc) * 192 + lane]; rpm = scr[(cc) * 192 + 64 + lane]; rbt = scr[(cc) * 192 + 128 + lane]; } } while (0)
    __syncthreads();
    ML_ISSUE(0);
    float decay = 0.f;
    int cur = 0;
#pragma unroll 1
    for (int c = 0; c < SEQ / 64; ++c) {
#pragma unroll
        for (int i = 0; i < 2; ++i) {
            *(LAS u32x4*)(L + QS + (qr + 32 * i) * PQ + qc * 2) = rq[i];
            *(LAS u32x4*)(L + KS + (qr + 32 * i) * PQ + qc * 2) = rk[i];
        }
        *(LAS u32x4*)(L + VS + vr * PT + vc * 2) = rv;
        const u32x4 vkeep = rv;
        if (tid < 128) { float pn[8], nold = nv[tid];
#pragma unroll
            for (int j = 0; j < 8; ++j) pn[j] = npart[j * 128 + tid];
            asm volatile("" : "+v"(pn[0]), "+v"(pn[1]), "+v"(pn[2]), "+v"(pn[3]), "+v"(pn[4]), "+v"(pn[5]), "+v"(pn[6]), "+v"(pn[7]), "+v"(nold));
            float sn = 0.f;
#pragma unroll
            for (int j = 0; j < 8; ++j) sn += pn[j];
            nv[tid] = decay * nold + sn; }
        if (w == 0) {
            const float mc = ms[c], p63 = ms[128 + c];
            const float Mt = fmaxf(mc, rpm), M63 = fmaxf(mc, p63);
            sc[lane] = ra; sc[64 + lane] = Mt; sc[128 + lane] = __expf(mc - Mt); sc[192 + lane] = __expf(-(rbt + Mt)); sc[256 + lane] = __expf(ra - M63);
            if (lane == 0) sc[320] = __expf(mc - M63);
        }
        __syncthreads();
        decay = sc[320];
        if (c + 1 < SEQ / 64) ML_ISSUE(c + 1);
        { const float wk = sc[256 + vr]; const unsigned vw[4] = {vkeep.x, vkeep.y, vkeep.z, vkeep.w}; u32x4 o;
          o.x = pk2(bflo(vw[0]) * wk, bfhi(vw[0]) * wk); o.y = pk2(bflo(vw[1]) * wk, bfhi(vw[1]) * wk); o.z = pk2(bflo(vw[2]) * wk, bfhi(vw[2]) * wk); o.w = pk2(bflo(vw[3]) * wk, bfhi(vw[3]) * wk);
          *(LAS u32x4*)(L + VW + vr * PT + vc * 2) = o; }
        {
            const int ti = w >> 1;
            bf16x8 qa[4], kf[2][4];
#pragma unroll
            for (int kk = 0; kk < 4; ++kk) qa[kk] = ldsv(L + QS + (16 * ti + fr) * PQ + (32 * kk + 8 * fq) * 2);
#pragma unroll
            for (int s2 = 0; s2 < 2; ++s2)
#pragma unroll
                for (int kk = 0; kk < 4; ++kk) kf[s2][kk] = ldsv(L + KS + (16 * (2 * (w & 1) + s2) + fr) * PQ + (32 * kk + 8 * fq) * 2);
            f32x4 Mr = *(const LAS f32x4*)(sc + 64 + 16 * ti + 4 * fq);
            float as2[2] = {sc[16 * (2 * (w & 1)) + fr], sc[16 * (2 * (w & 1) + 1) + fr]};
            asm volatile("" : "+v"(qa[0]), "+v"(qa[1]), "+v"(qa[2]), "+v"(qa[3]), "+v"(kf[0][0]), "+v"(kf[0][1]), "+v"(kf[0][2]), "+v"(kf[0][3]),
                              "+v"(kf[1][0]), "+v"(kf[1][1]), "+v"(kf[1][2]), "+v"(kf[1][3]), "+v"(Mr), "+v"(as2[0]), "+v"(as2[1]));
#pragma unroll
            for (int s2 = 0; s2 < 2; ++s2) { const int si = 2 * (w & 1) + s2; f32x4 sa = (f32x4){0.f, 0.f, 0.f, 0.f};
#pragma unroll
                for (int kk = 0; kk < 4; ++kk) sa = mfma16(qa[kk], kf[s2][kk], sa);
                const int scol = 16 * si + fr; const float as = as2[s2];
#pragma unroll
                for (int r = 0; r < 4; ++r) { const int trow = 16 * ti + 4 * fq + r; const float p = (scol <= trow) ? sa[r] * __expf(as - Mr[r]) : 0.f;
                    *(LAS bf16_t*)(L + PS + trow * PT + scol * 2) = f2bf(p); } }
        }
        __syncthreads();
        {
            const int vi = w >> 1;
            bf16x8 va[2], kt[4][2];
#pragma unroll
            for (int kk = 0; kk < 2; ++kk) va[kk] = frag_tr(L + VW, PT, 32 * kk, 16 * vi, lane);
#pragma unroll
            for (int i = 0; i < 4; ++i)
#pragma unroll
                for (int kk = 0; kk < 2; ++kk) kt[i][kk] = frag_tr(L + KS, PQ, 32 * kk, 16 * (4 * (w & 1) + i), lane);
            asm volatile("" : "+v"(va[0]), "+v"(va[1]), "+v"(kt[0][0]), "+v"(kt[0][1]), "+v"(kt[1][0]), "+v"(kt[1][1]), "+v"(kt[2][0]), "+v"(kt[2][1]), "+v"(kt[3][0]), "+v"(kt[3][1]));
#pragma unroll
            for (int i = 0; i < 4; ++i) { const int di = 4 * (w & 1) + i; f32x4 a = cst[i] * decay;
#pragma unroll
                for (int kk = 0; kk < 2; ++kk) a = mfma16(va[kk], kt[i][kk], a);
                cst[i] = a;
#pragma unroll
                for (int r = 0; r < 4; ++r) *(LAS bf16_t*)(L + CB + (cur ^ 1) * 64 * PQ + (16 * vi + 4 * fq + r) * PQ + (16 * di + fr) * 2) = f2bf(a[r]); }
        }
        {
            float p0 = 0.f, p1 = 0.f; unsigned kw[8];
#pragma unroll
            for (int i = 0; i < 8; ++i) kw[i] = *(const LAS unsigned*)(L + KS + (8 * w + i) * PQ + lane * 4);
            f32x4 wk0 = *(const LAS f32x4*)(sc + 256 + 8 * w), wk1 = *(const LAS f32x4*)(sc + 256 + 8 * w + 4);
            asm volatile("" : "+v"(kw[0]), "+v"(kw[1]), "+v"(kw[2]), "+v"(kw[3]), "+v"(kw[4]), "+v"(kw[5]), "+v"(kw[6]), "+v"(kw[7]), "+v"(wk0), "+v"(wk1));
#pragma unroll
            for (int i = 0; i < 8; ++i) { const float wk = (i < 4) ? wk0[i & 3] : wk1[i & 3]; p0 += wk * bflo(kw[i]); p1 += wk * bfhi(kw[i]); }
            npart[w * 128 + 2 * lane] = p0; npart[w * 128 + 2 * lane + 1] = p1;
        }
        {
            const int ti = w >> 1;
            float nq = 0.f, ps = 0.f;
            { const LAS unsigned char* qrow = L + QS + (16 * ti + fr) * PQ + (32 * fq) * 2;
              const LAS unsigned char* prow = L + PS + (16 * ti + fr) * PT + (16 * fq) * 2;
              u32x4 qv[4], pv[2]; f32x4 nvv[8];
#pragma unroll
              for (int h4 = 0; h4 < 4; ++h4) qv[h4] = *(const LAS u32x4*)(qrow + h4 * 16);
#pragma unroll
              for (int i = 0; i < 8; ++i) nvv[i] = *(const LAS f32x4*)(nv + 32 * fq + 4 * i);
#pragma unroll
              for (int h2 = 0; h2 < 2; ++h2) pv[h2] = *(const LAS u32x4*)(prow + h2 * 16);
              asm volatile("" : "+v"(qv[0]), "+v"(qv[1]), "+v"(qv[2]), "+v"(qv[3]), "+v"(pv[0]), "+v"(pv[1]),
                                "+v"(nvv[0]), "+v"(nvv[1]), "+v"(nvv[2]), "+v"(nvv[3]), "+v"(nvv[4]), "+v"(nvv[5]), "+v"(nvv[6]), "+v"(nvv[7]));
#pragma unroll
              for (int h4 = 0; h4 < 4; ++h4) { const unsigned qw[4] = {qv[h4].x, qv[h4].y, qv[h4].z, qv[h4].w};
#pragma unroll
                  for (int j = 0; j < 4; ++j) { const int e0 = 8 * h4 + 2 * j; nq += nvv[e0 >> 2][e0 & 3] * bflo(qw[j]) + nvv[(e0 + 1) >> 2][(e0 + 1) & 3] * bfhi(qw[j]); } }
#pragma unroll
              for (int h2 = 0; h2 < 2; ++h2) { const unsigned pw[4] = {pv[h2].x, pv[h2].y, pv[h2].z, pv[h2].w};
#pragma unroll
                  for (int j = 0; j < 4; ++j) ps += bflo(pw[j]) + bfhi(pw[j]); } }
            { const auto a1 = __builtin_amdgcn_permlane16_swap(__float_as_uint(nq), __float_as_uint(nq), false, false); const auto b1 = __builtin_amdgcn_permlane16_swap(__float_as_uint(ps), __float_as_uint(ps), false, false);
              nq = __uint_as_float(a1[0]) + __uint_as_float(a1[1]); ps = __uint_as_float(b1[0]) + __uint_as_float(b1[1]);
              const auto a2 = __builtin_amdgcn_permlane32_swap(__float_as_uint(nq), __float_as_uint(nq), false, false); const auto b2 = __builtin_amdgcn_permlane32_swap(__float_as_uint(ps), __float_as_uint(ps), false, false);
              nq = __uint_as_float(a2[0]) + __uint_as_float(a2[1]); ps = __uint_as_float(b2[0]) + __uint_as_float(b2[1]); }
            const float den_own = sc[128 + 16 * ti + fr] * nq + ps;
            float wr4[4], em4[4], dn4[4];
#pragma unroll
            for (int r = 0; r < 4; ++r) { wr4[r] = sc[128 + 16 * ti + 4 * fq + r]; em4[r] = sc[192 + 16 * ti + 4 * fq + r]; dn4[r] = __shfl(den_own, 4 * fq + r); }
            asm volatile("" : "+v"(dn4[0]), "+v"(dn4[1]), "+v"(dn4[2]), "+v"(dn4[3]), "+v"(wr4[0]), "+v"(wr4[1]), "+v"(wr4[2]), "+v"(wr4[3]), "+v"(em4[0]), "+v"(em4[1]), "+v"(em4[2]), "+v"(em4[3]));
            bf16x8 qa[4], pa[2], cbf[2][4], vtf[2][2];
#pragma unroll
            for (int kk = 0; kk < 4; ++kk) qa[kk] = ldsv(L + QS + (16 * ti + fr) * PQ + (32 * kk + 8 * fq) * 2);
#pragma unroll
            for (int kk = 0; kk < 2; ++kk) pa[kk] = ldsv(L + PS + (16 * ti + fr) * PT + (32 * kk + 8 * fq) * 2);
#pragma unroll
            for (int v2 = 0; v2 < 2; ++v2) {
#pragma unroll
                for (int kk = 0; kk < 4; ++kk) cbf[v2][kk] = ldsv(L + CB + cur * 64 * PQ + (16 * (2 * (w & 1) + v2) + fr) * PQ + (32 * kk + 8 * fq) * 2);
#pragma unroll
                for (int kk = 0; kk < 2; ++kk) vtf[v2][kk] = frag_tr(L + VS, PT, 32 * kk, 16 * (2 * (w & 1) + v2), lane); }
            asm volatile("" : "+v"(qa[0]), "+v"(qa[1]), "+v"(qa[2]), "+v"(qa[3]), "+v"(pa[0]), "+v"(pa[1]), "+v"(cbf[0][0]), "+v"(cbf[0][1]), "+v"(cbf[0][2]), "+v"(cbf[0][3]),
                              "+v"(cbf[1][0]), "+v"(cbf[1][1]), "+v"(cbf[1][2]), "+v"(cbf[1][3]), "+v"(vtf[0][0]), "+v"(vtf[0][1]), "+v"(vtf[1][0]), "+v"(vtf[1][1]));
            const float kscale = 0.08838834764831845f;
#pragma unroll
            for (int v2 = 0; v2 < 2; ++v2) { const int vi = 2 * (w & 1) + v2; f32x4 a = (f32x4){0.f, 0.f, 0.f, 0.f};
#pragma unroll
                for (int kk = 0; kk < 4; ++kk) a = mfma16(qa[kk], cbf[v2][kk], a);
#pragma unroll
                for (int r = 0; r < 4; ++r) a[r] *= wr4[r];
#pragma unroll
                for (int kk = 0; kk < 2; ++kk) a = mfma16(pa[kk], vtf[v2][kk], a);
#pragma unroll
                for (int r = 0; r < 4; ++r) { const float hval = kscale * a[r] * __builtin_amdgcn_rcpf(fmaxf(kscale * fabsf(dn4[r]), em4[r]));
                    if (!dry) base[(size_t)(c * 64 + 16 * ti + 4 * fq + r) * LDP + O_MV + hd * 256 + vq * 64 + 16 * vi + fr] = f2bf(hval); } }
        }
        __syncthreads();
        cur ^= 1;
    }
#undef ML_ISSUE
}
}

namespace dsa {
constexpr int GT = 0, EQ = 16384, QST = 32768, HIST = 33280, HPITCH = 257, LIST = HIST + 32 * HPITCH * 4, LCAP = 64, CNT = LIST + 32 * LCAP * 4, KST = 33280, KBUF = 128 * 144, VST = KST + 2 * KBUF, LEND = VST + 2 * KBUF, EMK = LEND, EMKB = 8192;
static_assert(CNT + 512 <= LEND, "dsa LDS");
typedef short s16x4 __attribute__((ext_vector_type(4)));
static_assert(LEND <= RING_BYTES, "dsa LDS");
__device__ __forceinline__ f32x16 mfma32(bf16x8 a, bf16x8 b, f32x16 c) { return __builtin_amdgcn_mfma_f32_32x32x16_bf16(a, b, c, 0, 0, 0); }
__device__ __forceinline__ unsigned fkey(float s) { const unsigned u = __float_as_uint(s); return (u & 0x80000000u) ? ~u : (u | 0x80000000u); }
__device__ __forceinline__ unsigned lowbits(unsigned e, int k) { if (k >= (int)__popc(e)) return e; unsigned r = 0u; for (int i = 0; i < k; ++i) { const unsigned b = e & (0u - e); r |= b; e ^= b; } return r; }

#define DSA_LOADK(dst, tile) do { _Pragma("unroll") for (int kk = 0; kk < 4; ++kk) dst[kk] = *(const bf16x8*)(kbase + (size_t)((tile) * 32 + q) * LDS_ + (O_IK - O_SIDE) + kk * 16 + hf * 8); } while (0)
__device__ __forceinline__ void idx_scores(const bf16x8 (&ka)[4], const bf16x8 (&bq)[4][4], const float (&wq)[4], float (&sc)[16]) {
    f32x16 a[4];
#pragma unroll
    for (int h = 0; h < 4; ++h)
#pragma unroll
        for (int r = 0; r < 16; ++r) a[h][r] = 0.f;
#pragma unroll
    for (int kk = 0; kk < 4; ++kk)
#pragma unroll
        for (int h = 0; h < 4; ++h) a[h] = mfma32(ka[kk], bq[h][kk], a[h]);
#pragma unroll
    for (int r = 0; r < 16; ++r) {
        float v = wq[0] * __builtin_amdgcn_fmed3f(a[0][r], 0.f, 3.0e38f);
        v = fmaf(wq[1], __builtin_amdgcn_fmed3f(a[1][r], 0.f, 3.0e38f), v);
        v = fmaf(wq[2], __builtin_amdgcn_fmed3f(a[2][r], 0.f, 3.0e38f), v);
        sc[r] = fmaf(wq[3], __builtin_amdgcn_fmed3f(a[3][r], 0.f, 3.0e38f), v) + 0.0f; }
}

#define DSA_PRELOAD() do { DSA_LOADK(k0, min(w, tlast)); DSA_LOADK(k1, min(w + NWAVES, tlast)); } while (0)
#define DSA_DIAG_MASK() if (tile == qt) { _Pragma("unroll") for (int r = 0; r < 16; ++r) { const int pos = (r & 3) + 8 * (r >> 2) + 4 * hf; sc[r] = (pos <= q) ? sc[r] : -__builtin_inff(); } }
template <int PASS>
__device__ __forceinline__ void radix_pass(LAS unsigned char* L, int lane, int w, int q, int hf, int qt, int ntile, const bf16_t* kbase, const bf16x8 (&bq)[4][4], const float (&wq)[4],
                                           bf16x8 (&k0)[4], bf16x8 (&k1)[4], u32x4* kc) {
    constexpr int shift = 24 - 8 * PASS;
    LAS unsigned* hist = (LAS unsigned*)(L + HIST); LAS unsigned* qst = (LAS unsigned*)(L + QST);
    const unsigned prefix = qst[q];
    LAS unsigned* hrow = hist + q * HPITCH;
    int tile = w; const int tlast = ntile - 1;
    if constexpr (PASS == 1) {
#pragma unroll 1
        for (; tile < ntile; tile += 4 * NWAVES) {
            u32x4 ca[4], cb[4];
#pragma unroll
            for (int j = 0; j < 4; ++j) { const int tl = min(tile + j * NWAVES, tlast); ca[j] = *(kc + (size_t)(tl * 64 + lane) * 2); cb[j] = *(kc + (size_t)(tl * 64 + lane) * 2 + 1); }
#pragma unroll
            for (int j = 0; j < 4; ++j) if (tile + j * NWAVES < ntile) {
                const unsigned cw[8] = {ca[j].x, ca[j].y, ca[j].z, ca[j].w, cb[j].x, cb[j].y, cb[j].z, cb[j].w};
#pragma unroll
                for (int r = 0; r < 16; ++r) { const unsigned h16 = (r & 1) ? (cw[r >> 1] >> 16) : (cw[r >> 1] & 0xffffu);
                    const bool hit = ((h16 >> 8) == prefix); const unsigned bin = hit ? (h16 & 255u) : 256u;
                    __hip_atomic_fetch_add(&hrow[bin], 1u, __ATOMIC_RELAXED, __HIP_MEMORY_SCOPE_WORKGROUP); } }
        }
    } else {
#define DSA_RSTEP(KB) { \
        float sc[16]; idx_scores(KB, bq, wq, sc); \
        DSA_LOADK(KB, min(tile + 2 * NWAVES, tlast)); \
        DSA_DIAG_MASK() \
        unsigned kh[8], kl[8]; \
        _Pragma("unroll") for (int r = 0; r < 16; ++r) { const unsigned key = fkey(sc[r]); unsigned bin = (key >> shift) & 255u; bool hit = true; \
            if (PASS == 0) { if (r & 1) { kh[r >> 1] |= key & 0xffff0000u; kl[r >> 1] |= key << 16; } else { kh[r >> 1] = key >> 16; kl[r >> 1] = key & 0xffffu; } } \
            if (PASS > 0) { hit = ((key >> ((shift + 8) & 31)) == prefix); bin = hit ? bin : 256u; } \
            if (PASS < 2 || __any(hit)) __hip_atomic_fetch_add(&hrow[bin], 1u, __ATOMIC_RELAXED, __HIP_MEMORY_SCOPE_WORKGROUP); } \
        if (PASS == 0) { *(kc + (size_t)(tile * 64 + lane) * 2) = (u32x4){kh[0], kh[1], kh[2], kh[3]}; *(kc + (size_t)(tile * 64 + lane) * 2 + 1) = (u32x4){kh[4], kh[5], kh[6], kh[7]}; \
            u32x4* kcl_ = kc + (WS_KCL - WS_KC) / 16; *(kcl_ + (size_t)(tile * 64 + lane) * 2) = (u32x4){kl[0], kl[1], kl[2], kl[3]}; *(kcl_ + (size_t)(tile * 64 + lane) * 2 + 1) = (u32x4){kl[4], kl[5], kl[6], kl[7]}; } \
        tile += NWAVES; }
#pragma unroll 1
    while (tile + NWAVES < ntile) { DSA_RSTEP(k0) DSA_RSTEP(k1) }
    if (tile < ntile) DSA_RSTEP(k0)
#undef DSA_RSTEP
    }
    if constexpr (PASS != 1) DSA_PRELOAD();
    __syncthreads();
    { const int g = lane >> 4, li = lane & 15, qq = 4 * w + g; const unsigned need = qst[32 + qq];
        unsigned c[16]; unsigned t = 0u;
#pragma unroll
        for (int j = 0; j < 16; ++j) { c[j] = hist[qq * HPITCH + 16 * li + j]; t += c[j]; hist[qq * HPITCH + 16 * li + j] = 0u; }
        if (li == 15) hist[qq * HPITCH + 256] = 0u;
        unsigned sfx = t;
#pragma unroll
        for (int o = 1; o < 16; o <<= 1) { const unsigned v = __shfl_down(sfx, o, 16); if (li + o < 16) sfx += v; }
        unsigned cum = sfx - t; int found = -1; unsigned cat = 0u;
#pragma unroll
        for (int j = 15; j >= 0; --j) { if (cum < need && cum + c[j] >= need) { found = j; cat = cum; } cum += c[j]; }
        if (found >= 0) { qst[qq] = (qst[qq] << 8) | (unsigned)(16 * li + found); qst[32 + qq] = need - cat; } }
    __syncthreads();
}
__device__ __forceinline__ void tie_fixup(LAS unsigned* gt, LAS unsigned* eq, int qq, int li, int need) {
    unsigned e[8]; int cn[8]; int t = 0;
#pragma unroll
    for (int j = 0; j < 8; ++j) { e[j] = eq[qq * 128 + 8 * li + j]; cn[j] = __popc(e[j]); t += cn[j]; }
    int pre = t;
#pragma unroll
    for (int o = 1; o < 16; o <<= 1) { const int v = __shfl_up(pre, o, 16); if (li >= o) pre += v; }
    int before = pre - t;
#pragma unroll
    for (int j = 0; j < 8; ++j) { const int k = min(cn[j], max(need - before, 0)); if (e[j]) gt[qq * 128 + 8 * li + j] |= lowbits(e[j], k); before += cn[j]; }
}

__device__ __forceinline__ void unit(const Ctx& C, int b, int qt, int dry) {
    TID_SETUP(); ArgsP A = args_ptr();
    LAS unsigned char* L = C.lds;
    LAS unsigned* hist = (LAS unsigned*)(L + HIST); LAS unsigned* gt = (LAS unsigned*)(L + GT); LAS unsigned* eq = (LAS unsigned*)(L + EQ); LAS unsigned* qst = (LAS unsigned*)(L + QST);
    LAS unsigned* list = (LAS unsigned*)(L + LIST); LAS unsigned* cnt = (LAS unsigned*)(L + CNT);
    const int w = wave, q = lane & 31, hf = lane >> 5;
    const int t0 = 32 * qt, ntile = qt + 1, tlast = ntile - 1;
    const bf16_t* kbase = WSP(bf16_t, WS_SIDE) + (size_t)b * SEQ * LDS_;
    const bf16_t* srow = kbase + (size_t)(t0 + q) * LDS_;
    bf16_t* qrow = WSP(bf16_t, WS_PROJ) + (size_t)(b * SEQ + t0 + q) * LDP;
    const bool sel = (qt >= 8);
    for (int i = tid; i < 2 * 32 * 128; i += NTHR) gt[i] = 0u;
    if (sel) { for (int i = tid; i < 32 * HPITCH; i += NTHR) hist[i] = 0u; }
    if (tid < 64) qst[tid] = (tid < 32) ? 0u : 256u;
    if (tid < 128) cnt[tid] = (tid >= 32 && tid < 64) ? 0xffffffffu : 0u;
    __syncthreads();
    if (sel) {
        bf16x8 bq[4][4]; float wq[4];
#pragma unroll
        for (int h = 0; h < 4; ++h) { wq[h] = bf2f(srow[O_IW - O_SIDE + h]) * 0.0625f;
#pragma unroll
            for (int kk = 0; kk < 4; ++kk) bq[h][kk] = *(const bf16x8*)(srow + (O_IQ - O_SIDE) + h * 64 + kk * 16 + hf * 8); }
        bf16x8 k0[4], k1[4];
        u32x4* kc = WSP(u32x4, WS_KC) + (size_t)C.bid * (128 * 64 * 2);
        DSA_PRELOAD();
        radix_pass<0>(L, lane, w, q, hf, qt, ntile, kbase, bq, wq, k0, k1, kc);
        radix_pass<1>(L, lane, w, q, hf, qt, ntile, kbase, bq, wq, k0, k1, kc);
        {
            const unsigned p16 = qst[q]; const u32x4* kcl = kc + (WS_KCL - WS_KC) / 16;
            unsigned lmin = 0xffffffffu, lmax = 0u;
#pragma unroll 1
            for (int tb = w; tb < ntile; tb += 4 * NWAVES) {
                u32x4 ha[4], hb[4];
#pragma unroll
                for (int j = 0; j < 4; ++j) { const size_t o_ = (size_t)(min(tb + j * NWAVES, tlast) * 64 + lane) * 2; ha[j] = *(kc + o_); hb[j] = *(kc + o_ + 1); }
#pragma unroll
                for (int j = 0; j < 4; ++j) { const int tile = tb + j * NWAVES;
                    if (tile < ntile) {
                        const unsigned hw[8] = {ha[j].x, ha[j].y, ha[j].z, ha[j].w, hb[j].x, hb[j].y, hb[j].z, hb[j].w};
                        unsigned gw = 0u, ew = 0u;
#pragma unroll
                        for (int r = 0; r < 16; ++r) { const int pos = (r & 3) + 8 * (r >> 2) + 4 * hf;
                            const unsigned hi = (r & 1) ? (hw[r >> 1] >> 16) : (hw[r >> 1] & 0xffffu);
                            gw |= (hi > p16) ? (1u << pos) : 0u; ew |= (hi == p16) ? (1u << pos) : 0u; }
                        unsigned rem = ew;
                        while (__any(rem != 0u)) {
                            if (rem != 0u) { const int pos = __ffs((int)rem) - 1; rem &= rem - 1u; const int r = 4 * ((pos - 4 * hf) >> 3) + (pos & 3);
                                const unsigned low = *(const unsigned short*)((const char*)(kcl + (size_t)(tile * 64 + lane) * 2) + 2 * r);
                                const unsigned slot = __hip_atomic_fetch_add(&cnt[q], 1u, __ATOMIC_RELAXED, __HIP_MEMORY_SCOPE_WORKGROUP);
                                if (slot < (unsigned)LCAP) list[q * LCAP + slot] = 0x10000000u | (low << 12) | (unsigned)(4095 - (tile * 32 + pos));
                                lmin = min(lmin, low); lmax = max(lmax, low); } }
                        { const auto g2 = __builtin_amdgcn_permlane32_swap(gw, gw, false, false); gw = g2[0] | g2[1]; const auto e2 = __builtin_amdgcn_permlane32_swap(ew, ew, false, false); ew = e2[0] | e2[1]; }
                        if (hf == 0) { gt[q * 128 + tile] = gw; eq[q * 128 + tile] = ew; } } }
            }
            if (lmin <= lmax) { __hip_atomic_fetch_min(&cnt[32 + q], lmin, __ATOMIC_RELAXED, __HIP_MEMORY_SCOPE_WORKGROUP); __hip_atomic_fetch_max(&cnt[64 + q], lmax, __ATOMIC_RELAXED, __HIP_MEMORY_SCOPE_WORKGROUP); }
        }
        __syncthreads();
        {
            const int g = lane >> 4, li = lane & 15, qq = 4 * w + g; const int need = (int)qst[32 + qq]; const int n = (int)cnt[qq];
            if (n <= LCAP) {
                unsigned c[4]; int rank[4];
#pragma unroll
                for (int k = 0; k < 4; ++k) { const int idx = li + 16 * k; c[k] = (idx < n) ? list[qq * LCAP + idx] : 0u; rank[k] = 0; }
                for (int j = 0; j < n; j += 4) { const u32x4 e4 = *(const LAS u32x4*)(list + qq * LCAP + j);
                    const unsigned ev[4] = {e4.x, (j + 1 < n) ? e4.y : 0u, (j + 2 < n) ? e4.z : 0u, (j + 3 < n) ? e4.w : 0u};
#pragma unroll
                    for (int i = 0; i < 4; ++i)
#pragma unroll
                        for (int k = 0; k < 4; ++k) rank[k] += (ev[i] > c[k]) ? 1 : 0; }
#pragma unroll
                for (int k = 0; k < 4; ++k) if (c[k] != 0u && rank[k] < need) { const int sp = 4095 - (int)(c[k] & 4095u);
                    __hip_atomic_fetch_or(&gt[qq * 128 + (sp >> 5)], 1u << (sp & 31), __ATOMIC_RELAXED, __HIP_MEMORY_SCOPE_WORKGROUP); }
            } else if (cnt[32 + qq] == cnt[64 + qq]) {
                tie_fixup(gt, eq, qq, li, need);
            } else if (li == 0) cnt[96] = 1u;
        }
        __syncthreads();
        if (cnt[96] != 0u) {
            DSA_PRELOAD();
            radix_pass<2>(L, lane, w, q, hf, qt, ntile, kbase, bq, wq, k0, k1, kc);
            radix_pass<3>(L, lane, w, q, hf, qt, ntile, kbase, bq, wq, k0, k1, kc);
            const unsigned prefix = qst[q];
            for (int tile = w; tile < ntile; tile += NWAVES) {
                bf16x8 ka[4]; DSA_LOADK(ka, tile);
                float sc[16]; idx_scores(ka, bq, wq, sc);
                DSA_DIAG_MASK()
                unsigned gw = 0u, ew = 0u;
#pragma unroll
                for (int r = 0; r < 16; ++r) { const int pos = (r & 3) + 8 * (r >> 2) + 4 * hf; const unsigned key = fkey(sc[r]);
                    gw |= (key > prefix) ? (1u << pos) : 0u; ew |= (key == prefix) ? (1u << pos) : 0u; }
                gw |= __shfl_xor(gw, 32); ew |= __shfl_xor(ew, 32);
                if (hf == 0) { gt[q * 128 + tile] = gw; eq[q * 128 + tile] = ew; }
            }
            __syncthreads();
            tie_fixup(gt, eq, 4 * w + (lane >> 4), lane & 15, (int)qst[32 + 4 * w + (lane >> 4)]);
        }
    } else {
        for (int tile = w; tile < ntile; tile += NWAVES) { unsigned gw = 0u; const bool diag = (tile == qt);
#pragma unroll
            for (int r = 0; r < 16; ++r) { const int pos = (r & 3) + 8 * (r >> 2) + 4 * hf; if (!diag || (pos <= q)) gw |= 1u << pos; }
            gw |= __shfl_xor(gw, 32);
            if (hf == 0) gt[q * 128 + tile] = gw; }
    }
    __syncthreads();
    {
        const int a = w;
        bf16x8 bqa[4];
#pragma unroll
        for (int kk = 0; kk < 4; ++kk) bqa[kk] = *(const bf16x8*)(qrow + O_AQ + a * 64 + kk * 16 + hf * 8);
        f32x16 o0, o1;
#pragma unroll
        for (int r = 0; r < 16; ++r) { o0[r] = 0.f; o1[r] = 0.f; }
        float mrun = 0.f;
        f32x4 lacc = {0.f, 0.f, 0.f, 0.f};
        u32x4 onesw; onesw.x = onesw.y = onesw.z = onesw.w = ((lane & 15) == ((lane >> 4) & 1)) ? 0x3F803F80u : 0u;
        const bf16x8 onesA = __builtin_bit_cast(bf16x8, onesw);
#define DSA_EMASK(c, buf) do { const int mw_ = (int)(gt[q * 128 + 4 * (c) + (w >> 1)] >> (4 * hf + 16 * (w & 1))); u32x4 em_; \
            em_.x = __builtin_amdgcn_perm((unsigned)__builtin_amdgcn_sbfe(mw_, 1, 1), (unsigned)__builtin_amdgcn_sbfe(mw_, 0, 1), 0x07060100u); \
            em_.y = __builtin_amdgcn_perm((unsigned)__builtin_amdgcn_sbfe(mw_, 3, 1), (unsigned)__builtin_amdgcn_sbfe(mw_, 2, 1), 0x07060100u); \
            em_.z = __builtin_amdgcn_perm((unsigned)__builtin_amdgcn_sbfe(mw_, 9, 1), (unsigned)__builtin_amdgcn_sbfe(mw_, 8, 1), 0x07060100u); \
            em_.w = __builtin_amdgcn_perm((unsigned)__builtin_amdgcn_sbfe(mw_, 11, 1), (unsigned)__builtin_amdgcn_sbfe(mw_, 10, 1), 0x07060100u); \
            *(LAS u32x4*)(L + EMK + (buf) * EMKB + (w * 64 + lane) * 16) = em_; } while (0)
        const int nch = (ntile + 3) >> 2;
        const int kr0 = tid >> 3, ks0 = tid & 7;
        u32x4 rkA[2], rvA[2], rkB[2], rvB[2];
#define DSA_ISSUE(c, RK, RV) do { _Pragma("unroll") for (int i = 0; i < 2; ++i) { const bf16_t* rp_ = kbase + (size_t)((c) * 128 + kr0 + 64 * i) * LDS_ + ks0 * 8; \
            RK[i] = *(const u32x4*)(rp_ + (O_AK - O_SIDE)); RV[i] = *(const u32x4*)(rp_ + (O_AV - O_SIDE)); } } while (0)
#define DSA_WRITE(buf, RK, RV) do { _Pragma("unroll") for (int i = 0; i < 2; ++i) { \
            *(LAS u32x4*)(L + KST + (buf) * KBUF + (kr0 + 64 * i) * 144 + ks0 * 16) = RK[i]; \
            *(LAS u32x4*)(L + VST + (buf) * KBUF + (kr0 + 64 * i) * 144 + ks0 * 16) = RV[i]; } } while (0)
        const int g16 = lane >> 4, li = lane & 15;
        const int vtoff = (4 * hf + (li >> 2)) * 144 + (16 * (g16 & 1) + 4 * (li & 3)) * 2;
#ifndef ATTN_REPS
#define ATTN_REPS 1
#endif
#pragma unroll 1
        for (int rep = 0; rep < ATTN_REPS; ++rep) {
        if (ATTN_REPS > 1) { mrun = 0.f; lacc[0] = lacc[1] = lacc[2] = lacc[3] = 0.f;
#pragma unroll
            for (int r = 0; r < 16; ++r) { o0[r] = 0.f; o1[r] = 0.f; } }
        DSA_ISSUE(0, rkA, rvA); DSA_ISSUE(min(1, nch - 1), rkB, rvB);
        DSA_WRITE(0, rkA, rvA); DSA_EMASK(0, 0);
        __syncthreads();
        asm volatile("" :: "v"(bqa[0]), "v"(bqa[1]), "v"(bqa[2]), "v"(bqa[3]));
        f32x16 nmv;
#pragma unroll
        for (int r = 0; r < 16; ++r) nmv[r] = -mrun;
#define DSA_KREAD(dst, tt_) do { const LAS unsigned char* kp_ = L + KST + buf * KBUF + (32 * (tt_) + q) * 144 + 16 * hf; \
            _Pragma("unroll") for (int kk = 0; kk < 4; ++kk) dst[kk] = *(const LAS bf16x8*)(kp_ + 32 * kk); } while (0)
#define DSA_STEP(tt, CUR, NXT, KFN, HASN) do { \
            s16x4 vlo[2][2], vhi[2][2]; \
            _Pragma("unroll") for (int ks = 0; ks < 2; ++ks) \
            _Pragma("unroll") for (int dt = 0; dt < 2; ++dt) { const LAS unsigned char* vp = L + VST + buf * KBUF + (32 * (tt) + 16 * ks) * 144 + 64 * dt + vtoff; \
                vlo[ks][dt] = __builtin_amdgcn_ds_read_tr16_b64_v4i16((LAS s16x4*)vp); vhi[ks][dt] = __builtin_amdgcn_ds_read_tr16_b64_v4i16((LAS s16x4*)(vp + 8 * 144)); } \
            u32x4 em[2]; \
            _Pragma("unroll") for (int ks = 0; ks < 2; ++ks) em[ks] = *(const LAS u32x4*)(L + EMK + buf * EMKB + ((2 * (tt) + ks) * 64 + lane) * 16); \
            float mx = CUR[0]; \
            _Pragma("unroll") for (int r = 1; r < 16; ++r) mx = fmaxf(mx, CUR[r]); \
            { const auto rr = __builtin_amdgcn_permlane32_swap(__float_as_uint(mx), __float_as_uint(mx), false, false); mx = fmaxf(__uint_as_float(rr[0]), __uint_as_float(rr[1])); } \
            const bool first = (c == 0) && ((tt) == 0); \
            if (first || __any(mx > 8.0f)) {              \
                const float d = first ? mx : fmaxf(mx, 0.f), alpha = first ? 1.0f : __builtin_amdgcn_exp2f(-d); mrun += d; \
                lacc[0] *= __shfl(alpha, lane & 15); lacc[1] *= __shfl(alpha, (lane & 15) + 16); \
                _Pragma("unroll") for (int r = 0; r < 16; ++r) { o0[r] *= alpha; o1[r] *= alpha; CUR[r] -= d; nmv[r] = -mrun; } } \
            __builtin_amdgcn_sched_barrier(0); \
            float p[16]; \
            _Pragma("unroll") for (int g = 0; g < 4; ++g) { \
                if (HASN) NXT = mfma32(KFN[g], bqa[g], (g == 0) ? nmv : NXT); \
                _Pragma("unroll") for (int r = 4 * g; r < 4 * g + 4; ++r) p[r] = __builtin_amdgcn_exp2f(CUR[r]); \
                __builtin_amdgcn_sched_barrier(0); } \
            _Pragma("unroll") for (int ks = 0; ks < 2; ++ks) { \
                u32x4 pw; pw.x = pk2(p[8 * ks], p[8 * ks + 1]) & em[ks].x; pw.y = pk2(p[8 * ks + 2], p[8 * ks + 3]) & em[ks].y; pw.z = pk2(p[8 * ks + 4], p[8 * ks + 5]) & em[ks].z; pw.w = pk2(p[8 * ks + 6], p[8 * ks + 7]) & em[ks].w; \
                const bf16x8 pb = __builtin_bit_cast(bf16x8, pw); \
                o0 = mfma32(__builtin_shufflevector(vlo[ks][0], vhi[ks][0], 0, 1, 2, 3, 4, 5, 6, 7), pb, o0); \
                o1 = mfma32(__builtin_shufflevector(vlo[ks][1], vhi[ks][1], 0, 1, 2, 3, 4, 5, 6, 7), pb, o1); \
                lacc = __builtin_amdgcn_mfma_f32_16x16x32_bf16(onesA, pb, lacc, 0, 0, 0); } \
        } while (0)
#define DSA_CHUNK(RKY, RVY, RKX, RVX) do { \
            const int buf = c & 1; \
            DSA_ISSUE(min(c + 2, nch - 1), RKY, RVY);         \
            bf16x8 kfa[4], kfb[4]; f32x16 sA, sB; \
            DSA_KREAD(kfa, 0); DSA_KREAD(kfb, 1); __builtin_amdgcn_sched_barrier(0); \
            _Pragma("unroll") for (int kk = 0; kk < 4; ++kk) sA = mfma32(kfa[kk], bqa[kk], (kk == 0) ? nmv : sA); \
            DSA_KREAD(kfa, 2); __builtin_amdgcn_sched_barrier(0); \
            DSA_STEP(0, sA, sB, kfb, true); \
            DSA_KREAD(kfb, 3); __builtin_amdgcn_sched_barrier(0); \
            DSA_STEP(1, sB, sA, kfa, true); \
            DSA_STEP(2, sA, sB, kfb, true); \
            DSA_STEP(3, sB, sA, kfa, false); \
            if (c + 1 < nch) { DSA_WRITE(buf ^ 1, RKX, RVX); DSA_EMASK(c + 1, buf ^ 1); } \
            __syncthreads(); } while (0)
#pragma unroll 1
        for (int c = 0; c < nch; ++c) {
            DSA_CHUNK(rkA, rvA, rkB, rvB);
            if (++c >= nch) break;
            DSA_CHUNK(rkB, rvB, rkA, rvA);
        }
        }
#undef DSA_CHUNK
#undef DSA_EMASK
#undef DSA_STEP
#undef DSA_KREAD
        const float l0 = __shfl(lacc[0], lane & 15), l1 = __shfl(lacc[1], lane & 15);
        const float lt = (lane & 16) ? l1 : l0, inv = 1.0f / lt;
#pragma unroll
        for (int g = 0; g < 4; ++g) {
            u32x2 w0, w1; w0.x = pk2(o0[4 * g] * inv, o0[4 * g + 1] * inv); w0.y = pk2(o0[4 * g + 2] * inv, o0[4 * g + 3] * inv);
            w1.x = pk2(o1[4 * g] * inv, o1[4 * g + 1] * inv); w1.y = pk2(o1[4 * g + 2] * inv, o1[4 * g + 3] * inv);
            if (!dry) { *(u32x2*)(qrow + O_AQ + a * 64 + 8 * g + 4 * hf) = w0; *(u32x2*)(qrow + O_AQ + a * 64 + 32 + 8 * g + 4 * hf) = w1; } }
    }
    __syncthreads();
}
}

#ifdef NO_ML
#define ML_CALL(x)
#else
#define ML_CALL(x) x
#endif
#ifdef NO_DSA
#define DSA_CALL(x)
#else
#define DSA_CALL(x) x
#endif
#if defined(NO_GEMM)
#define GEMM_CALL(k, x)
#elif defined(ONLY_GEMM)
#define GEMM_CALL(k, x) do { if ((k) == ONLY_GEMM) { x; } } while (0)
#else
#define GEMM_CALL(k, x) x
#endif
#ifndef PROBE_MIX
#define PROBE_MIX 0
#endif
constexpr int PH_PER_LAYER = 20, N_PHASES = DEPTH * PH_PER_LAYER + 1;
__global__ void __launch_bounds__(NTHR, 2) mk_fwd(Args Aval) {
    extern __shared__ __attribute__((aligned(16))) unsigned char lds_raw[];
    Ctx C;
    C.lds = (LAS unsigned char*)lds_raw;
    C.G = gridDim.x; C.bid = blockIdx.x;
    volatile LAS unsigned* MISC = (volatile LAS unsigned*)(C.lds + MISC_OFF);
    for (int u = threadIdx.x; u < (LDS_BYTES - LDSCTL_OFF) / 4; u += NTHR) ((LAS unsigned*)(C.lds + LDSCTL_OFF))[u] = 0u;
    __syncthreads();
    unsigned* barw = (unsigned*)(Aval.ws + WS_CTL) + CW_BAR;
    XcdBarrier bar; bar.bar = barw; bar.x = 0; bar.st = nullptr;
    const int lo = Aval.ph_lo, hi = Aval.ph_hi;
    if ((hi - lo) > 1) bar = xcd_barrier_post(barw, MISC + 8);
#define IN(k) (lo <= (k) && (k) < hi)
#define SEAM(k) do { if (IN((k) + 1)) xcd_barrier(bar); } while (0)
#pragma unroll 1
    for (int l = 0; l < DEPTH; ++l) {
        const int P0 = l * PH_PER_LAYER;
        if (IN(P0 + 0)) { phase_convert(C, l); phase_pb(C, l); if (l == 0) phase_init_rows(C); SEAM(P0 + 0); }
        if (IN(P0 + 1)) {
            ArgsP A = args_ptr(); bf16_t* const W = WSP(bf16_t, WS_W); pg8::Gemm g{WSP(bf16_t, WS_XB), W + W_GU1, DM, MTOK, 2 * DFF, DM}; pg8::StaticOrder S; S.init(MTOK, 2 * DFF, C.G, C.bid);
            pg8::EpiSwiglu E{WSP(bf16_t, WS_HID), WSP(float, WS_SS0)}; GEMM_CALL(0, pg8::gemm_phase(C.lds, g, S, E)); SEAM(P0 + 1); }
        if (IN(P0 + 2)) {
            ArgsP A = args_ptr(); bf16_t* const W = WSP(bf16_t, WS_W); pg8::Gemm g{WSP(bf16_t, WS_HID), W + W_DN1, DFF, MTOK, DM, DFF}; pg8::StaticOrder S; S.init(MTOK, DM, C.G, C.bid);
            pg8::EpiResid E{(l == 0) ? A->in[0] : A->out, A->out, WSP(bf16_t, WS_XB), 0.5f, WSP(float, WS_SS1), (LAS float*)(C.lds + LDS_SSQ)}; GEMM_CALL(1, pg8::gemm_phase(C.lds, g, S, E)); SEAM(P0 + 2); }
#pragma unroll 1
        for (int gi = 0; gi < NGRP; ++gi) {
            const int PG = P0 + 4 + 5 * gi; const size_t r0 = (size_t)gi * MG;
            if (IN(PG + 0)) {
                ArgsP A = args_ptr(); bf16_t* const W = WSP(bf16_t, WS_W); pg8::Gemm g{WSP(bf16_t, WS_XB) + r0 * DM, W + W_IN, DM, MG, LDP, DM}; pg8::StaticOrder S; S.init(MG, LDP, C.G, C.bid);
                pg8::EpiProj E{WSP(bf16_t, WS_PROJ), WSP(float, WS_SS1) + r0 * 4, WSP(bf16_t, WS_SIDE)}; GEMM_CALL(2, pg8::gemm_phase(C.lds, g, S, E)); SEAM(PG + 0); }
            if (IN(PG + 1)) {
                constexpr int NMLB = 16, NDSAB = 128, NCVB = 32, NITEMB = NMLB + NDSAB + NCVB;
                unsigned* qbase = (unsigned*)(Aval.ws + WS_CTL) + CW_Q + 64 * (8 * (2 * l + gi));
                const int xq = (int)(xb_xcc_id() & 7u);
                for (int hop = 0; hop < GB; ++hop) {
                    const int bq_ = (xq + hop) & (GB - 1);
                    unsigned* qhead = qbase + 64 * bq_;
                    for (;;) {
                        __syncthreads();
                        if (threadIdx.x == 0) MISC[16] = __hip_atomic_fetch_add(qhead, 1u, __ATOMIC_RELAXED, __HIP_MEMORY_SCOPE_AGENT);
                        __syncthreads();
                        const int item = (int)MISC[16];
                        if (item >= NITEMB) break;
                        if (item < NMLB) { ML_CALL(ml::unit(C, l, bq_ * 16 + item, 0)); }
                        else if (item < NMLB + NDSAB) { DSA_CALL(dsa::unit(C, bq_, 127 - (item - NMLB), 0)); }
                        else prep_conv(C, l, bq_, item - NMLB - NDSAB, NCVB, 0);
                    }
                }
                SEAM(PG + 1); }
            if (IN(PG + 2)) { prep_gate(C, l, C.bid, C.G); SEAM(PG + 2); }
            if (IN(PG + 3)) {
                ArgsP A = args_ptr(); bf16_t* const W = WSP(bf16_t, WS_W); bf16_t* PROJ = WSP(bf16_t, WS_PROJ);
                pg8::Gemm g{PROJ + O_CB, W + W_MRG, LDP, MG, DM, 2 * DM}; pg8::StaticOrder S; S.init(MG, DM, C.G, C.bid);
                pg8::EpiMerge E{WSP(bf16_t, WS_GCAT), PROJ + O_G + 2 * DM}; pg8::MergeHook H{PROJ + O_G};
                GEMM_CALL(3, (pg8::gemm_phase<pg8::EpiMerge, pg8::MergeHook>(C.lds, g, S, E, H)));
                SEAM(PG + 3); }
            if (IN(PG + 4)) {
                ArgsP A = args_ptr(); bf16_t* const W = WSP(bf16_t, WS_W); pg8::Gemm g{WSP(bf16_t, WS_GCAT), W + W_O, DM, MG, DM, DM}; pg8::StaticOrder S; S.init(MG, DM, C.G, C.bid);
                pg8::EpiResid E{A->out + r0 * DM, A->out + r0 * DM, WSP(bf16_t, WS_XB) + r0 * DM, 1.0f, WSP(float, WS_SS0) + r0 * 4, (LAS float*)(C.lds + LDS_SSQ)}; GEMM_CALL(6, pg8::gemm_phase(C.lds, g, S, E)); SEAM(PG + 4); }
        }
        if (IN(P0 + 15)) {
            ArgsP A = args_ptr(); bf16_t* const W = WSP(bf16_t, WS_W); pg8::Gemm g{WSP(bf16_t, WS_XB), W + W_GU2, DM, MTOK, 2 * DFF, DM}; pg8::StaticOrder S; S.init(MTOK, 2 * DFF, C.G, C.bid);
            pg8::EpiSwiglu E{WSP(bf16_t, WS_HID), WSP(float, WS_SS0)}; GEMM_CALL(7, pg8::gemm_phase(C.lds, g, S, E)); SEAM(P0 + 15); }
        if (IN(P0 + 16)) {
            ArgsP A = args_ptr(); bf16_t* const W = WSP(bf16_t, WS_W); pg8::Gemm g{WSP(bf16_t, WS_HID), W + W_DN2, DFF, MTOK, DM, DFF}; pg8::StaticOrder S; S.init(MTOK, DM, C.G, C.bid);
            pg8::EpiResid E{A->out, A->out, WSP(bf16_t, WS_XB), 0.5f, WSP(float, WS_SS1), (LAS float*)(C.lds + LDS_SSQ)}; GEMM_CALL(8, pg8::gemm_phase(C.lds, g, S, E)); SEAM(P0 + 16); }
        if (IN(P0 + 18)) {
            ArgsP A = args_ptr(); bf16_t* const W = WSP(bf16_t, WS_W); pg8::Gemm g{WSP(bf16_t, WS_PB), W + W_PP, DPLE, MTOK, DM, DPLE}; pg8::StaticOrder S; S.init(MTOK, DM, C.G, C.bid);
            pg8::EpiBf16 E{WSP(bf16_t, WS_PP), DM, nullptr}; GEMM_CALL(9, pg8::gemm_phase(C.lds, g, S, E)); SEAM(P0 + 18); }
        if (IN(P0 + 19)) {
            ArgsP A = args_ptr(); bf16_t* const W = WSP(bf16_t, WS_W); pg8::Gemm g{WSP(bf16_t, WS_XB), W + W_PG, DM, MTOK, DM, DM}; pg8::StaticOrder S; S.init(MTOK, DM, C.G, C.bid);
            pg8::EpiPle E{A->out, WSP(bf16_t, WS_XB), WSP(bf16_t, WS_PP), WSP(float, WS_SS1), WSP(float, WS_SS0), (LAS float*)(C.lds + LDS_SSQ)}; GEMM_CALL(10, pg8::gemm_phase(C.lds, g, S, E)); SEAM(P0 + 19); }
    }
    if (IN(N_PHASES - 1)) phase_final(C);
#undef IN
#undef SEAM
}

extern "C" void kernel_launch(void* const* d_in, const int* in_sizes, int n_in, void* d_out, int out_size, void* d_ws, size_t ws_size, hipStream_t stream) {
    static int grid = 0;
    if (grid == 0) {
        if (n_in != 22 || out_size != MTOK * DM || ws_size < WS_END) { fprintf(stderr, "kernel_launch: unexpected shapes (n_in %d out %d ws %zu, need %zu)\n", n_in, out_size, ws_size, (size_t)WS_END); grid = -1; return; }
        int dev = 0, cus = 0, per_cu = 0;
        if (hipGetDevice(&dev) != hipSuccess || hipDeviceGetAttribute(&cus, hipDeviceAttributeMultiprocessorCount, dev) != hipSuccess) { grid = -1; return; }
        if (hipFuncSetAttribute((const void*)mk_fwd, hipFuncAttributeMaxDynamicSharedMemorySize, LDS_BYTES) != hipSuccess) { fprintf(stderr, "kernel_launch: hipFuncSetAttribute failed\n"); grid = -1; return; }
        if (hipOccupancyMaxActiveBlocksPerMultiprocessor(&per_cu, (const void*)mk_fwd, NTHR, LDS_BYTES) != hipSuccess || per_cu < 1) { fprintf(stderr, "kernel_launch: occupancy query says %d\n", per_cu); (void)hipGetLastError(); grid = -1; return; }
        grid = cus;
    }
    if (grid < 0) return;
    if (hipMemsetAsync((char*)d_ws + WS_CTL, 0, CTL_ZERO_BYTES, stream) != hipSuccess) return;
    Args a{};
    for (int i = 0; i < 22; ++i) a.in[i] = (const float*)d_in[i];
    a.out = (float*)d_out; a.ws = (unsigned char*)d_ws;
#if MK_N_LAUNCHES == 1
    a.ph_lo = 0; a.ph_hi = N_PHASES;
    hipLaunchKernelGGL(mk_fwd, dim3(grid), dim3(NTHR), LDS_BYTES, stream, a);
#else
    for (int p = 0; p < N_PHASES; ++p) { a.ph_lo = p; a.ph_hi = p + 1; hipLaunchKernelGGL(mk_fwd, dim3(grid), dim3(NTHR), LDS_BYTES, stream, a); }
#endif
}
```

```cpp
#include <hip/hip_runtime.h>
#include <cstdio>
#include <cstdint>

#ifndef MK_N_LAUNCHES
#define MK_N_LAUNCHES 1
#endif

constexpr int BATCH = 16, SEQ = 4096, DM = 1024, DEPTH = 2, DPLE = 256, DFF = 2816, DCONV = 512;
constexpr int MTOK = BATCH * SEQ;
constexpr int NGRP = 2, GB = BATCH / NGRP, MG = GB * SEQ;
constexpr int LDP = 8704;
constexpr int O_CC = 0, O_CX = 512, O_MQ = 1024, O_MK = 1536, O_MV = 2048, O_CB = 3072, O_MO = 3584, O_AQ = 4608, O_G = 5120, O_AK = 8192, O_AV = 8256,
              O_IQ = 8320, O_IK = 8576, O_MI = 8640, O_MF = 8644, O_IW = 8648;
constexpr int LDS_ = 512, O_SIDE = 8192;
constexpr float EPS = 1e-6f;

constexpr size_t W_GU1 = 0, W_DN1 = W_GU1 + (size_t)5632 * 1024, W_IN = W_DN1 + (size_t)1024 * 2816, W_MRG = W_IN + (size_t)LDP * 1024,
                 W_O = W_MRG + (size_t)1024 * 2048, W_GU2 = W_O + (size_t)1024 * 1024,
                 W_DN2 = W_GU2 + (size_t)5632 * 1024, W_PG = W_DN2 + (size_t)1024 * 2816, W_PP = W_PG + (size_t)1024 * 1024, W_END = W_PP + (size_t)1024 * 256;

constexpr size_t MiB = 1u << 20;
constexpr size_t WS_CTL = 0, CTL_ZERO_BYTES = 64 * 1024;
constexpr size_t WS_W = 1 * MiB;
constexpr size_t WS_XB = 65 * MiB;
constexpr size_t WS_SS0 = 193 * MiB, WS_SS1 = 194 * MiB;
constexpr size_t WS_SCR = 198 * MiB;
constexpr size_t WS_BIG = 206 * MiB;
constexpr size_t WS_PROJ = WS_BIG;
constexpr size_t WS_GCAT = WS_BIG + 544 * MiB;
constexpr size_t WS_SIDE = WS_GCAT + 64 * MiB;
constexpr size_t WS_HID = WS_BIG;
constexpr size_t WS_PB = WS_BIG + 640 * MiB;
constexpr size_t WS_PP = WS_BIG + 384 * MiB;
constexpr size_t WS_KC = WS_BIG + 672 * MiB;
constexpr size_t WS_KCL = WS_BIG + 736 * MiB;
constexpr size_t WS_END = WS_BIG + 800 * MiB;
static_assert(W_END * 2 <= 64 * MiB, "weights fit");
constexpr int CW_BAR = 4096;
constexpr int CW_Q = 8192;

constexpr int RING_BYTES = 131072, LDSCTL_OFF = RING_BYTES, MISC_OFF = LDSCTL_OFF + 320, LDS_BYTES = 147456;
constexpr int NWAVES = 8, NTHR = 512;

#define GAS __attribute__((address_space(1)))
#define LAS __attribute__((address_space(3)))
typedef unsigned short bf16_t;
typedef short bf16x8 __attribute__((ext_vector_type(8)));
typedef short bf16x4 __attribute__((ext_vector_type(4)));
typedef float f32x4 __attribute__((ext_vector_type(4)));
typedef float f32x16 __attribute__((ext_vector_type(16)));
typedef unsigned u32x4 __attribute__((ext_vector_type(4)));
typedef unsigned u32x2 __attribute__((ext_vector_type(2)));
typedef __bf16 bf2_t __attribute__((ext_vector_type(2)));

__device__ __forceinline__ unsigned pk2(float lo, float hi) { bf2_t v = {(__bf16)lo, (__bf16)hi}; return __builtin_bit_cast(unsigned, v); }
__device__ __forceinline__ bf16_t f2bf(float x) { __bf16 v = (__bf16)x; return __builtin_bit_cast(bf16_t, v); }
__device__ __forceinline__ float bf2f(bf16_t b) { return __uint_as_float(((unsigned)b) << 16); }
__device__ __forceinline__ float bflo(unsigned w) { return __uint_as_float(w << 16); }
__device__ __forceinline__ float bfhi(unsigned w) { return __uint_as_float(w & 0xffff0000u); }
__device__ __forceinline__ float fsigmoid(float x) { return __builtin_amdgcn_rcpf(1.0f + __expf(-x)); }
__device__ __forceinline__ float rstd_from(const f32x4 p) { return __builtin_amdgcn_rsqf(((p[0] + p[1]) + (p[2] + p[3])) * (1.0f / DM) + EPS); }
__device__ __forceinline__ void rstd8(const float* ss, int row0, float mul, float (&rs)[8]) {
    f32x4 t[8];
#pragma unroll
    for (int i = 0; i < 8; ++i) t[i] = *(const f32x4*)(ss + (size_t)(row0 + (i >> 2) * 128 + (i & 3) * 16) * 4);
    asm volatile("" : "+v"(t[0]), "+v"(t[1]), "+v"(t[2]), "+v"(t[3]), "+v"(t[4]), "+v"(t[5]), "+v"(t[6]), "+v"(t[7]));
#pragma unroll
    for (int i = 0; i < 8; ++i) rs[i] = rstd_from(t[i]) * mul;
}
__device__ __forceinline__ float rstd_of(const float* ss4) { const f32x4 p = *(const f32x4*)ss4; return 1.0f / sqrtf(((p[0] + p[1]) + (p[2] + p[3])) * (1.0f / DM) + EPS); }
constexpr int LDS_SSQ = RING_BYTES + 1024;
__device__ __forceinline__ float wave_sum(float v) {
#pragma unroll
    for (int o = 1; o < 64; o <<= 1) v += __shfl_xor(v, o);
    return v;
}

namespace pg8 {
#ifndef PG8_ALIGN
#define PG8_ALIGN 1
#endif
constexpr bool ALIGN_EPI = PG8_ALIGN;
constexpr int BM = 256, BK = 64, HALF = 128, HTB = HALF * BK * 2, STAGE_BYTES = 8 * HTB, NXCD = 8, WGM = 8;
__host__ __device__ __forceinline__ int lds_byte(int r, int c) { const int st = (r >> 4) * 2 + (c >> 5), rr = r & 15, cc = c & 31, ob = rr * 64 + cc * 2; return st * 1024 + (ob ^ (((ob >> 9) & 1) << 5)); }
__host__ __device__ __forceinline__ void stage_rc(int b, int& R, int& C) { const int st = b / 1024, sb = b % 1024, swz = sb ^ (((sb >> 9) & 1) << 5); R = (st >> 1) * 16 + swz / 64; C = (st & 1) * 32 + (swz % 64) / 2; }
__host__ __device__ __forceinline__ int perm32(int rho) { const int n = rho >> 4, i = rho & 15; return 8 * (i >> 2) + 4 * n + (i & 3); }
struct Unit { int pm, pn; };
struct Gemm { const bf16_t* A; const bf16_t* Bt; int lda, M, N, K; };
struct StaticOrder {
    int nM, nN, nwg, G, c;
    __host__ __device__ void init(int M, int N, int G_, int c_) { nM = M / BM; nN = N / BM; nwg = nM * nN; G = G_; c = c_; }
    __host__ __device__ bool next(int i, Unit& u) const {
        const long L = (long)i * G + c; if (L >= nwg) return false;
        int wgid = (int)L; { const int q = nwg / NXCD, r = nwg % NXCD, xcd = wgid % NXCD, off = wgid / NXCD; wgid = (xcd < r ? xcd * (q + 1) : r * (q + 1) + (xcd - r) * q) + off; }
        const int nig = WGM * nN, gid = wgid / nig, fm = gid * WGM, gsz = (nM - fm) < WGM ? (nM - fm) : WGM;
        u.pm = fm + ((wgid % nig) % gsz); u.pn = (wgid % nig) / gsz; return true;
    }
};
typedef f32x4 Acc[2][2][4][2];

struct EpiSwiglu {
    bf16_t* H; const float* ss;
    __device__ __forceinline__ void operator()(const Acc& acc, const Unit& u, int wr, int wc, int fr, int fq) const {
        const int row0 = u.pm * BM + wr * 64 + fr, col0 = u.pn * 128 + wc * 32 + 8 * fq;
        float rs[8]; rstd8(ss, row0, 1.0f, rs);
#pragma unroll
        for (int ai = 0; ai < 2; ++ai)
#pragma unroll
            for (int m = 0; m < 4; ++m) { const int row = row0 + ai * HALF + m * 16; const float r = rs[ai * 4 + m];
                float h[8];
#pragma unroll
                for (int n = 0; n < 2; ++n)
#pragma unroll
                    for (int j = 0; j < 4; ++j) { const float g = acc[ai][0][m][n][j] * r, uu = acc[ai][1][m][n][j] * r; h[n * 4 + j] = g * fsigmoid(g) * uu; }
                u32x4 w; w.x = pk2(h[0], h[1]); w.y = pk2(h[2], h[3]); w.z = pk2(h[4], h[5]); w.w = pk2(h[6], h[7]);
                *(u32x4*)(H + (size_t)row * DFF + col0) = w; }
    }
};
struct EpiResid {
    const float* Xin; float* X; bf16_t* XB; float scale; float* SS; LAS float* lq;
    __device__ __forceinline__ void operator()(const Acc& acc, const Unit& u, int wr, int wc, int fr, int fq) const {
        const int row0 = u.pm * BM + wr * 64 + fr, col0 = u.pn * BM + wc * 32 + 8 * fq;
#pragma unroll
        for (int ai = 0; ai < 2; ++ai)
#pragma unroll
            for (int m = 0; m < 4; ++m) { const int row = row0 + ai * HALF + m * 16; const size_t off = (size_t)row * DM + col0; float sq = 0.f;
#pragma unroll
                for (int bj = 0; bj < 2; ++bj) { float* xp = X + off + bj * HALF; const float* xi = Xin + off + bj * HALF;
                    f32x4 a = *(const f32x4*)xi, b = *(const f32x4*)(xi + 4);
                    a = a + acc[ai][bj][m][0] * scale; b = b + acc[ai][bj][m][1] * scale;
                    *(f32x4*)xp = a; *(f32x4*)(xp + 4) = b;
                    sq += (a[0] * a[0] + a[1] * a[1]) + (a[2] * a[2] + a[3] * a[3]) + (b[0] * b[0] + b[1] * b[1]) + (b[2] * b[2] + b[3] * b[3]);
                    u32x4 w; w.x = pk2(a[0], a[1]); w.y = pk2(a[2], a[3]); w.z = pk2(b[0], b[1]); w.w = pk2(b[2], b[3]);
                    *(u32x4*)(XB + off + bj * HALF) = w; }
                { const auto s1 = __builtin_amdgcn_permlane16_swap(__float_as_uint(sq), __float_as_uint(sq), false, false); sq = __uint_as_float(s1[0]) + __uint_as_float(s1[1]);
                  const auto s2 = __builtin_amdgcn_permlane32_swap(__float_as_uint(sq), __float_as_uint(sq), false, false); sq = __uint_as_float(s2[0]) + __uint_as_float(s2[1]); }
                if (fq == 0) lq[wc * 256 + (ai * HALF + wr * 64 + m * 16 + fr)] = sq;
                asm volatile("" ::: "memory"); }
        asm volatile("s_waitcnt lgkmcnt(0)" ::: "memory"); __builtin_amdgcn_s_barrier(); asm volatile("" ::: "memory");
        if (wr == 0) { const int rr = wc * 64 + fq * 16 + fr;
            SS[(size_t)(u.pm * BM + rr) * 4 + u.pn] = (lq[rr] + lq[256 + rr]) + (lq[512 + rr] + lq[768 + rr]); }
    }
};
struct EpiBf16 {
    bf16_t* O; int ldc; const float* rs;
    __device__ __forceinline__ void operator()(const Acc& acc, const Unit& u, int wr, int wc, int fr, int fq) const {
        const int row0 = u.pm * BM + wr * 64 + fr, col0 = u.pn * BM + wc * 32 + 8 * fq;
#pragma unroll
        for (int ai = 0; ai < 2; ++ai)
#pragma unroll
            for (int m = 0; m < 4; ++m) { const int row = row0 + ai * HALF + m * 16; const float r = rs ? rs[row] : 1.0f;
#pragma unroll
                for (int bj = 0; bj < 2; ++bj) { const f32x4 a = acc[ai][bj][m][0] * r, b = acc[ai][bj][m][1] * r;
                    u32x4 w; w.x = pk2(a[0], a[1]); w.y = pk2(a[2], a[3]); w.z = pk2(b[0], b[1]); w.w = pk2(b[2], b[3]);
                    *(u32x4*)(O + (size_t)row * ldc + col0 + bj * HALF) = w; } }
    }
};
constexpr float AQ_SCALE = 0.125f * 1.4426950408889634f;
struct EpiProj {
    bf16_t* O; const float* ss; bf16_t* SIDE;
    __device__ __forceinline__ void operator()(const Acc& acc, const Unit& u, int wr, int wc, int fr, int fq) const {
        const int row0 = u.pm * BM + wr * 64 + fr; int col0 = u.pn * BM + wc * 32 + 8 * fq;
        const bool sg = (u.pn >= O_G / BM) && (u.pn < O_AK / BM);
        const float qs = (u.pn >= O_AQ / BM && u.pn < O_G / BM) ? AQ_SCALE : 1.0f;
        bf16_t* base = O; int ldc = LDP;
        if (u.pn >= O_SIDE / BM) { base = SIDE; ldc = LDS_; col0 -= O_SIDE; }
        float rs[8]; rstd8(ss, row0, qs, rs);
#pragma unroll
        for (int ai = 0; ai < 2; ++ai)
#pragma unroll
            for (int m = 0; m < 4; ++m) { const int row = row0 + ai * HALF + m * 16; const float r = rs[ai * 4 + m];
#pragma unroll
                for (int bj = 0; bj < 2; ++bj) { f32x4 a = acc[ai][bj][m][0] * r, b = acc[ai][bj][m][1] * r;
                    if (sg) {
#pragma unroll
                        for (int j = 0; j < 4; ++j) { a[j] = fmaxf(fsigmoid(a[j]), 1e-10f); b[j] = fmaxf(fsigmoid(b[j]), 1e-10f); } }
                    u32x4 w; w.x = pk2(a[0], a[1]); w.y = pk2(a[2], a[3]); w.z = pk2(b[0], b[1]); w.w = pk2(b[2], b[3]);
                    *(u32x4*)(base + (size_t)row * ldc + col0 + bj * HALF) = w; } }
    }
};
struct MergeHook {
    static constexpr bool ON = true;
    const bf16_t* S;
    __device__ __forceinline__ void operator()(Acc& acc, const Unit& u, int t, int wr, int wc, int fr, int fq) const {
        if (t != 8 && t != 24) return;
        int row0 = u.pm * BM + wr * 64 + fr, col0 = u.pn * BM + wc * 32 + 8 * fq + ((t == 8) ? 0 : DM);
        asm volatile("" : "+v"(row0), "+v"(col0));
#pragma unroll
        for (int ai = 0; ai < 2; ++ai) {
            u32x4 nv[4][2], dv[4][2];
#pragma unroll
            for (int m = 0; m < 4; ++m)
#pragma unroll
                for (int bj = 0; bj < 2; ++bj) { const bf16_t* gp = S + (size_t)(row0 + ai * HALF + m * 16) * LDP + col0 + bj * HALF; nv[m][bj] = *(const u32x4*)gp; dv[m][bj] = *(const u32x4*)(gp + DM); }
            asm volatile("" : "+v"(nv[0][0]), "+v"(nv[0][1]), "+v"(nv[1][0]), "+v"(nv[1][1]), "+v"(nv[2][0]), "+v"(nv[2][1]), "+v"(nv[3][0]), "+v"(nv[3][1]),
                              "+v"(dv[0][0]), "+v"(dv[0][1]), "+v"(dv[1][0]), "+v"(dv[1][1]), "+v"(dv[2][0]), "+v"(dv[2][1]), "+v"(dv[3][0]), "+v"(dv[3][1]));
#pragma unroll
            for (int m = 0; m < 4; ++m)
#pragma unroll
                for (int bj = 0; bj < 2; ++bj) { const u32x4 n = nv[m][bj], d = dv[m][bj];
                    f32x4 ra, rb;
                    ra[0] = bflo(n.x) * __builtin_amdgcn_rcpf(bflo(d.x)); ra[1] = bfhi(n.x) * __builtin_amdgcn_rcpf(bfhi(d.x)); ra[2] = bflo(n.y) * __builtin_amdgcn_rcpf(bflo(d.y)); ra[3] = bfhi(n.y) * __builtin_amdgcn_rcpf(bfhi(d.y));
                    rb[0] = bflo(n.z) * __builtin_amdgcn_rcpf(bflo(d.z)); rb[1] = bfhi(n.z) * __builtin_amdgcn_rcpf(bfhi(d.z)); rb[2] = bflo(n.w) * __builtin_amdgcn_rcpf(bflo(d.w)); rb[3] = bfhi(n.w) * __builtin_amdgcn_rcpf(bfhi(d.w));
                    acc[ai][bj][m][0] *= ra; acc[ai][bj][m][1] *= rb; }
            asm volatile("" ::: "memory"); }
    }
};
struct NoHook { static constexpr bool ON = false; __device__ __forceinline__ void operator()(Acc&, const Unit&, int, int, int, int, int) const {} };
struct EpiMerge {
    bf16_t* O; const bf16_t* S2;
    __device__ __forceinline__ void operator()(const Acc& acc, const Unit& u, int wr, int wc, int fr, int fq) const {
        const int row0 = u.pm * BM + wr * 64 + fr, col0 = u.pn * BM + wc * 32 + 8 * fq;
#pragma unroll
        for (int ai = 0; ai < 2; ++ai) {
            u32x4 gv[4][2];
#pragma unroll
            for (int m = 0; m < 4; ++m)
#pragma unroll
                for (int bj = 0; bj < 2; ++bj) gv[m][bj] = *(const u32x4*)(S2 + (size_t)(row0 + ai * HALF + m * 16) * LDP + col0 + bj * HALF);
            asm volatile("" : "+v"(gv[0][0]), "+v"(gv[0][1]), "+v"(gv[1][0]), "+v"(gv[1][1]), "+v"(gv[2][0]), "+v"(gv[2][1]), "+v"(gv[3][0]), "+v"(gv[3][1]));
#pragma unroll
            for (int m = 0; m < 4; ++m) { const int row = row0 + ai * HALF + m * 16;
#pragma unroll
                for (int bj = 0; bj < 2; ++bj) { const u32x4 g = gv[m][bj];
                    const f32x4 a = acc[ai][bj][m][0], b = acc[ai][bj][m][1];
                    u32x4 w;
                    w.x = pk2(a[0] * bflo(g.x), a[1] * bfhi(g.x)); w.y = pk2(a[2] * bflo(g.y), a[3] * bfhi(g.y));
                    w.z = pk2(b[0] * bflo(g.z), b[1] * bfhi(g.z)); w.w = pk2(b[2] * bflo(g.w), b[3] * bfhi(g.w));
                    *(u32x4*)(O + (size_t)row * DM + col0 + bj * HALF) = w; } }
            asm volatile("" ::: "memory"); }
    }
};
struct EpiPle {
    float* X; bf16_t* XB; const bf16_t* PP; const float* ss; float* SSout; LAS float* lq; int wxb;
    __device__ __forceinline__ void operator()(const Acc& acc, const Unit& u, int wr, int wc, int fr, int fq) const {
        const int row0 = u.pm * BM + wr * 64 + fr, col0 = u.pn * BM + wc * 32 + 8 * fq;
#pragma unroll
        for (int ai = 0; ai < 2; ++ai)
#pragma unroll
            for (int m = 0; m < 4; ++m) { const int row = row0 + ai * HALF + m * 16; const float r = rstd_of(ss + (size_t)row * 4); const size_t off = (size_t)row * DM + col0; float sq = 0.f;
#pragma unroll
                for (int bj = 0; bj < 2; ++bj) { float* xp = X + off + bj * HALF;
                    f32x4 a = *(const f32x4*)xp, b = *(const f32x4*)(xp + 4); const u32x4 p = *(const u32x4*)(PP + off + bj * HALF);
                    const f32x4 ga = acc[ai][bj][m][0] * r, gb = acc[ai][bj][m][1] * r;
                    a[0] += fsigmoid(ga[0]) * bflo(p.x); a[1] += fsigmoid(ga[1]) * bfhi(p.x); a[2] += fsigmoid(ga[2]) * bflo(p.y); a[3] += fsigmoid(ga[3]) * bfhi(p.y);
                    b[0] += fsigmoid(gb[0]) * bflo(p.z); b[1] += fsigmoid(gb[1]) * bfhi(p.z); b[2] += fsigmoid(gb[2]) * bflo(p.w); b[3] += fsigmoid(gb[3]) * bfhi(p.w);
                    *(f32x4*)xp = a; *(f32x4*)(xp + 4) = b;
                    sq += (a[0] * a[0] + a[1] * a[1]) + (a[2] * a[2] + a[3] * a[3]) + (b[0] * b[0] + b[1] * b[1]) + (b[2] * b[2] + b[3] * b[3]);
                    u32x4 w; w.x = pk2(a[0], a[1]); w.y = pk2(a[2], a[3]); w.z = pk2(b[0], b[1]); w.w = pk2(b[2], b[3]);
                    if (wxb) *(u32x4*)(XB + off + bj * HALF) = w; }
                { const auto s1 = __builtin_amdgcn_permlane16_swap(__float_as_uint(sq), __float_as_uint(sq), false, false); sq = __uint_as_float(s1[0]) + __uint_as_float(s1[1]);
                  const auto s2 = __builtin_amdgcn_permlane32_swap(__float_as_uint(sq), __float_as_uint(sq), false, false); sq = __uint_as_float(s2[0]) + __uint_as_float(s2[1]); }
                if (fq == 0) lq[wc * 256 + (ai * HALF + wr * 64 + m * 16 + fr)] = sq;
                asm volatile("" ::: "memory"); }
        asm volatile("s_waitcnt lgkmcnt(0)" ::: "memory"); __builtin_amdgcn_s_barrier(); asm volatile("" ::: "memory");
        if (wr == 0) { const int rr = wc * 64 + fq * 16 + fr;
            SSout[(size_t)(u.pm * BM + rr) * 4 + u.pn] = (lq[rr] + lq[256 + rr]) + (lq[512 + rr] + lq[768 + rr]); }
    }
};

template <class Epi, class Hook = NoHook>
__device__ __forceinline__ void gemm_phase(LAS unsigned char* lds, const Gemm g, const StaticOrder& S, const Epi& E, const Hook H = Hook()) {
    int tid = threadIdx.x; asm volatile("" : "+v"(tid));
    const int wid = __builtin_amdgcn_readfirstlane(tid >> 6), lane = tid & 63, wr = wid >> 2, wc = wid & 3, fr = lane & 15, fq = lane >> 4;
    const int K = g.K, nt = K / BK, lda = g.lda;
    unsigned voffA[2], voffB[2];
#pragma unroll
    for (int i = 0; i < 2; ++i) { int R, C; stage_rc(tid * 16 + i * 8192, R, C); const int Rb = (R & ~31) + perm32(R & 31);
        voffA[i] = (unsigned)(R * lda + C) * 2u; voffB[i] = (unsigned)(Rb * K + C) * 2u; }
    const size_t kstep = (size_t)(BK * 2);
    const size_t hstepA = (size_t)HALF * lda * 2, tstepA = 2 * hstepA;
    const size_t hstepB = (size_t)HALF * K * 2, tstepB = 2 * hstepB;
    const unsigned ldsw = (unsigned)wid * 1024u;
    const int aoff = lds_byte(wr * 64 + fr, fq * 8), boff = lds_byte(wc * 32 + fr, fq * 8);
#define PG8_SA(b, h) (((b) * 2 + (h)) * HTB)
#define PG8_SB(b, h) ((4 + (b) * 2 + (h)) * HTB)
#define PG8_STAGE(bufoff, gbase, voff) do { _Pragma("unroll") for (int _i = 0; _i < 2; ++_i) \
        __builtin_amdgcn_global_load_lds((const unsigned*)((const char*)(gbase) + (voff)[_i]), (LAS unsigned*)(lds + (bufoff) + ldsw + _i * 8192), 16, 0, 0); } while (0)
#define PG8_LDA(dst, b, h) do { _Pragma("unroll") for (int m = 0; m < 4; ++m) _Pragma("unroll") for (int k = 0; k < 2; ++k) dst[m][k] = *(const LAS bf16x8*)(lds + PG8_SA(b, h) + aoff + m * 2048 + k * 1024); } while (0)
#define PG8_LDB(dst, b, h) do { _Pragma("unroll") for (int n = 0; n < 2; ++n) _Pragma("unroll") for (int k = 0; k < 2; ++k) dst[n][k] = *(const LAS bf16x8*)(lds + PG8_SB(b, h) + boff + n * 2048 + k * 1024); } while (0)
#define PG8_MMA(ai, bj, At, Bt) do { __builtin_amdgcn_s_setprio(1); _Pragma("unroll") for (int m = 0; m < 4; ++m) _Pragma("unroll") for (int n = 0; n < 2; ++n) _Pragma("unroll") for (int k = 0; k < 2; ++k) \
        acc[ai][bj][m][n] = __builtin_amdgcn_mfma_f32_16x16x32_bf16(Bt[n][k], At[m][k], acc[ai][bj][m][n], 0, 0, 0); __builtin_amdgcn_s_setprio(0); } while (0)
#define PG8_WAIT_V(n) asm volatile("s_waitcnt vmcnt(" #n ")" ::: "memory")
#define PG8_WAIT_L(n) asm volatile("s_waitcnt lgkmcnt(" #n ")" ::: "memory")
#define PG8_BAR __builtin_amdgcn_s_barrier()
#define PG8_SCHED __builtin_amdgcn_sched_barrier(0)
    Unit cur, nxt; int ui = 0;
    if (!S.next(0, cur)) return;
    Acc acc;
#pragma unroll
    for (int a = 0; a < 2; ++a)
#pragma unroll
        for (int b = 0; b < 2; ++b)
#pragma unroll
            for (int m = 0; m < 4; ++m)
#pragma unroll
                for (int n = 0; n < 2; ++n) acc[a][b][m][n] = (f32x4){0.f, 0.f, 0.f, 0.f};
    bf16x8 At[4][2], B0[2][2], B1[2][2];
    const char* cA = (const char*)g.A + (size_t)cur.pm * tstepA; const char* cB = (const char*)g.Bt + (size_t)cur.pn * tstepB;
    PG8_STAGE(PG8_SB(0, 0), cB, voffB); PG8_STAGE(PG8_SB(0, 1), cB + hstepB, voffB); PG8_STAGE(PG8_SA(0, 0), cA, voffA); PG8_STAGE(PG8_SA(0, 1), cA + hstepA, voffA);
    if (wr == 1) PG8_BAR;
    PG8_WAIT_V(2); PG8_BAR;
    PG8_STAGE(PG8_SB(1, 0), cB + kstep, voffB); PG8_STAGE(PG8_SA(1, 0), cA + kstep, voffA); PG8_STAGE(PG8_SB(1, 1), cB + hstepB + kstep, voffB);
    PG8_WAIT_V(6); PG8_BAR;
    for (;;) {
        const bool has_next = S.next(ui + 1, nxt);
        const char* nA = has_next ? (const char*)g.A + (size_t)nxt.pm * tstepA : cA; const char* nB = has_next ? (const char*)g.Bt + (size_t)nxt.pn * tstepB : cB;
#pragma unroll 1
        for (int t = 0; t < nt; t += 2) {
            const bool last = (t == nt - 2);
            const char* a1 = cA + (size_t)(t + 1) * kstep;
            const char* a2 = last ? nA : cA + (size_t)(t + 2) * kstep; const char* b2 = last ? nB : cB + (size_t)(t + 2) * kstep;
            const char* a3 = a2 + kstep; const char* b3 = b2 + kstep;
            if constexpr (Hook::ON) H(acc, cur, t, wr, wc, fr, fq);
            PG8_LDB(B0, 0, 0); PG8_LDB(B1, 0, 1); PG8_SCHED; PG8_LDA(At, 0, 0); PG8_STAGE(PG8_SA(1, 1), a1 + hstepA, voffA);
            PG8_WAIT_V(8); PG8_WAIT_L(0); PG8_BAR; PG8_MMA(0, 0, At, B0); PG8_MMA(0, 1, At, B1); PG8_BAR; PG8_SCHED;
            PG8_LDA(At, 0, 1); PG8_STAGE(PG8_SB(0, 0), b2, voffB); PG8_STAGE(PG8_SB(0, 1), b2 + hstepB, voffB); PG8_STAGE(PG8_SA(0, 0), a2, voffA);
            PG8_WAIT_V(8); PG8_WAIT_L(0); PG8_BAR; PG8_MMA(1, 0, At, B0); PG8_MMA(1, 1, At, B1); PG8_BAR; PG8_SCHED;
            PG8_LDB(B0, 1, 0); PG8_LDB(B1, 1, 1); PG8_SCHED; PG8_LDA(At, 1, 0); PG8_STAGE(PG8_SA(0, 1), a2 + hstepA, voffA);
            PG8_WAIT_V(8); PG8_WAIT_L(0); PG8_BAR; PG8_MMA(0, 0, At, B0); PG8_MMA(0, 1, At, B1); PG8_BAR; PG8_SCHED;
            PG8_LDA(At, 1, 1); PG8_STAGE(PG8_SB(1, 0), b3, voffB); PG8_STAGE(PG8_SB(1, 1), b3 + hstepB, voffB); PG8_STAGE(PG8_SA(1, 0), a3, voffA);
            PG8_WAIT_V(8); PG8_WAIT_L(0); PG8_BAR; PG8_MMA(1, 0, At, B0); PG8_MMA(1, 1, At, B1); PG8_BAR; PG8_SCHED;
        }
        if (ALIGN_EPI) { if (wr == 0) PG8_BAR; }
        E(acc, cur, wr, wc, fr, fq);
        if (!has_next) break;
#pragma unroll
        for (int a = 0; a < 2; ++a)
#pragma unroll
            for (int b = 0; b < 2; ++b)
#pragma unroll
                for (int m = 0; m < 4; ++m)
#pragma unroll
                    for (int n = 0; n < 2; ++n) acc[a][b][m][n] = (f32x4){0.f, 0.f, 0.f, 0.f};
        cur = nxt; cA = nA; cB = nB; ++ui;
        if (ALIGN_EPI) { if (wr == 1) PG8_BAR; }
    }
    PG8_WAIT_V(0);
    if (!ALIGN_EPI) { if (wr == 0) PG8_BAR; }
    PG8_BAR;
#undef PG8_SA
#undef PG8_SB
#undef PG8_STAGE
#undef PG8_LDA
#undef PG8_LDB
#undef PG8_MMA
#undef PG8_WAIT_V
#undef PG8_WAIT_L
#undef PG8_BAR
#undef PG8_SCHED
}
}

#define XB_TMO      128
#define XB_XCNT(j)  (256  + 64 * (j))
#define XB_XSUB(j)  (1280 + 64 * (j))
#define XB_XGEN(j)  (2304 + 64 * (j))
#define XB_TOP      3328
#define XB_TOPGEN   3392
#define XCD_BAR_WORDS 3456
#define XB_SPIN_CAP (1u << 18)
__device__ __forceinline__ unsigned xb_ld(unsigned* p)              { return __hip_atomic_load(p, __ATOMIC_RELAXED, __HIP_MEMORY_SCOPE_AGENT); }
__device__ __forceinline__ unsigned xb_add(unsigned* p, unsigned v) { return __hip_atomic_fetch_add(p, v, __ATOMIC_RELAXED, __HIP_MEMORY_SCOPE_AGENT); }
__device__ __forceinline__ unsigned xb_xcc_id() { return (unsigned)__builtin_amdgcn_s_getreg((3 << 11) | 20) & 0xFu; }
#define XB_SPIN(cond, bar) do { unsigned _sp = 0; while (cond) { __builtin_amdgcn_s_sleep(1); \
    if ((++_sp & 255u) == 0u) { if (xb_ld(&(bar)[XB_TMO])) break; if (_sp > XB_SPIN_CAP) { atomicAdd(&(bar)[XB_TMO], 1u); break; } } } } while (0)
struct XcdBarrier { unsigned* bar; unsigned x; volatile LAS unsigned* st; };
__device__ __forceinline__ XcdBarrier xcd_barrier_post(unsigned* bar, volatile LAS unsigned* st) {
    XcdBarrier b; b.bar = bar; b.x = xb_xcc_id(); b.st = st;
    if (threadIdx.x == 0) (void)xb_add(&bar[XB_XCNT(b.x)], 1u);
    return b;
}
__device__ __forceinline__ void xcd_barrier_complete(unsigned* bar, unsigned x, unsigned& nloc, unsigned& nx) {
    const unsigned G = gridDim.x * gridDim.y * gridDim.z;
    unsigned sum, cnt, mine, sp = 0u;
    for (;;) {
        sum = 0u; cnt = 0u; mine = 0u;
#pragma unroll
        for (unsigned j = 0; j < 16; ++j) { const unsigned c = xb_ld(&bar[XB_XCNT(j)]); sum += c; cnt += (c > 0u) ? 1u : 0u; mine = (j == x) ? c : mine; }
        if (sum == G) break;
        __builtin_amdgcn_s_sleep(1);
        if ((++sp & 255u) == 0u) { if (xb_ld(&bar[XB_TMO])) break; if (sp > XB_SPIN_CAP) { atomicAdd(&bar[XB_TMO], 1u); break; } }
    }
    nloc = mine > 0u ? mine : 1u; nx = cnt > 0u ? cnt : 1u;
}
__device__ __forceinline__ void xcd_barrier(const XcdBarrier& b) {
    asm volatile("s_waitcnt vmcnt(0)" ::: "memory");
    __syncthreads();
    if (threadIdx.x == 0) {
        unsigned* bar = b.bar;
        __builtin_amdgcn_s_waitcnt(0);
        unsigned nloc = b.st[0], nx = b.st[1];
        if (nloc == 0u) { xcd_barrier_complete(bar, b.x, nloc, nx); b.st[0] = nloc; b.st[1] = nx; }
        const unsigned old = xb_add(&bar[XB_XSUB(b.x)], 1u);
        const unsigned gen = old / nloc;
        if (old + 1u == (gen + 1u) * nloc) {
            __builtin_amdgcn_fence(__ATOMIC_RELEASE, "agent");
            asm volatile("s_waitcnt vmcnt(0)" ::: "memory");
            const unsigned og = xb_add(&bar[XB_TOP], 1u);
            const unsigned tg = og / nx;
            if (og + 1u == (tg + 1u) * nx) xb_add(&bar[XB_TOPGEN], 1u);
            else XB_SPIN(xb_ld(&bar[XB_TOPGEN]) == tg, bar);
            __builtin_amdgcn_fence(__ATOMIC_ACQUIRE, "agent");
            xb_add(&bar[XB_XGEN(b.x)], 1u);
            asm volatile("s_waitcnt vmcnt(0)" ::: "memory");
        } else {
            XB_SPIN(xb_ld(&bar[XB_XGEN(b.x)]) == gen, bar);
            __builtin_amdgcn_fence(__ATOMIC_ACQUIRE, "agent");
            asm volatile("s_waitcnt vmcnt(0)" ::: "memory");
        }
    }
    __syncthreads();
}

struct Args { const float* in[22]; float* out; unsigned char* ws; int ph_lo, ph_hi; };
struct Ctx { LAS unsigned char* lds; int G, bid; };
#define TID_SETUP() int tid = threadIdx.x; asm volatile("" : "+v"(tid)); const int lane = tid & 63, wave = __builtin_amdgcn_readfirstlane(tid >> 6); (void)lane; (void)wave
typedef const __attribute__((address_space(4))) Args* ArgsP;
__device__ __forceinline__ ArgsP args_ptr() { ArgsP p = (ArgsP)__builtin_amdgcn_kernarg_segment_ptr(); asm volatile("" : "+s"(p)); return p; }
#define WSP(T, off) ((T*)(A->ws + (off)))

struct MapId { __device__ __forceinline__ int operator()(int n) const { return n; } };
struct MapGU { __device__ __forceinline__ int operator()(int n) const { const int t = n >> 8, w = n & 255; return w < 128 ? 128 * t + w : DFF + 128 * t + (w - 128); } };
struct MapIn { __device__ __forceinline__ int operator()(int n) const {
    if (n < 3072) return n + 512; if (n < 3584) return n - 3072; if (n < 4608) return n; if (n < 5120) return n + 8; if (n < 8192) return n + 460; if (n < 8640) return n - 3064;
    if (n < 8644) return 4608 + (n - 8640); if (n < 8648) return 4612 + (n - 8644); if (n < 8652) return 5576 + (n - 8648); return -1; } };
template <class Map>
__device__ __forceinline__ void conv_item(const float* W, int K, int N, bf16_t* WT, int ldt, int koff, const float* gain, LAS float* scr, int item, int nblk, int lane, Map map) {
    const int kb = item / nblk, nb = item % nblk, k0 = 64 * kb, n0 = 32 * nb;
    const int c = map(n0 + (lane & 31));
    float wv[32];
#pragma unroll
    for (int i = 0; i < 32; ++i) { const int kk = 2 * i + (lane >> 5); wv[i] = (c >= 0) ? W[(size_t)(k0 + kk) * N + c] : 0.f; }
#pragma unroll
    for (int i = 0; i < 32; ++i) { const int kk = 2 * i + (lane >> 5); float v = wv[i]; if (gain) v *= gain[k0 + kk]; scr[kk * 33 + (lane & 31)] = v; }
    asm volatile("s_waitcnt lgkmcnt(0)" ::: "memory");
    const int c8 = lane & 7;
#pragma unroll
    for (int j = 0; j < 4; ++j) { const int n = (lane >> 3) + 8 * j; const LAS float* s = scr + (8 * c8) * 33 + n;
        u32x4 o; o.x = pk2(s[0 * 33], s[1 * 33]); o.y = pk2(s[2 * 33], s[3 * 33]); o.z = pk2(s[4 * 33], s[5 * 33]); o.w = pk2(s[6 * 33], s[7 * 33]);
        *(u32x4*)(WT + (size_t)(n0 + n) * ldt + koff + k0 + 8 * c8) = o; }
    asm volatile("s_waitcnt lgkmcnt(0)" ::: "memory");
}
__device__ __forceinline__ void phase_convert(const Ctx& C, int l) {
    TID_SETUP(); ArgsP A = args_ptr(); const int gw = C.bid * NWAVES + wave, NGW = C.G * NWAVES;
    LAS float* scr = (LAS float*)(C.lds + wave * 16384);
    bf16_t* W = WSP(bf16_t, WS_W);
    constexpr int I_GU = 16 * 176, I_DN = 44 * 32, I_IN = 16 * 272, I_CO = 8 * 32, I_MO = 16 * 32, I_AO = 8 * 32, I_O = 16 * 32, I_PG = 16 * 32, I_PP = 4 * 32;
    constexpr int NIT = 2 * I_GU + 2 * I_DN + I_IN + I_CO + I_MO + I_AO + I_O + I_PG + I_PP;
    for (int it = gw; it < NIT; it += NGW) {
        int r = it;
        if (r < I_GU) { conv_item(A->in[3] + (size_t)l * DM * 2 * DFF, DM, 2 * DFF, W + W_GU1, DM, 0, A->in[2] + (size_t)l * DM, scr, r, 176, lane, MapGU()); continue; } r -= I_GU;
        if (r < I_GU) { conv_item(A->in[16] + (size_t)l * DM * 2 * DFF, DM, 2 * DFF, W + W_GU2, DM, 0, A->in[15] + (size_t)l * DM, scr, r, 176, lane, MapGU()); continue; } r -= I_GU;
        if (r < I_DN) { conv_item(A->in[4] + (size_t)l * DFF * DM, DFF, DM, W + W_DN1, DFF, 0, nullptr, scr, r, 32, lane, MapId()); continue; } r -= I_DN;
        if (r < I_DN) { conv_item(A->in[17] + (size_t)l * DFF * DM, DFF, DM, W + W_DN2, DFF, 0, nullptr, scr, r, 32, lane, MapId()); continue; } r -= I_DN;
        if (r < I_IN) { conv_item(A->in[6] + (size_t)l * DM * 8652, DM, 8652, W + W_IN, DM, 0, A->in[5] + (size_t)l * DM, scr, r, 272, lane, MapIn()); continue; } r -= I_IN;
        if (r < I_CO) { conv_item(A->in[8] + (size_t)l * DCONV * DM, DCONV, DM, W + W_MRG, 2048, 0, nullptr, scr, r, 32, lane, MapId()); continue; } r -= I_CO;
        if (r < I_MO) { conv_item(A->in[12] + (size_t)l * DM * DM, DM, DM, W + W_MRG, 2048, 512, nullptr, scr, r, 32, lane, MapId()); continue; } r -= I_MO;
        if (r < I_AO) { conv_item(A->in[13] + (size_t)l * 512 * DM, 512, DM, W + W_MRG, 2048, 1536, nullptr, scr, r, 32, lane, MapId()); continue; } r -= I_AO;
        if (r < I_O) { conv_item(A->in[14] + (size_t)l * DM * DM, DM, DM, W + W_O, DM, 0, nullptr, scr, r, 32, lane, MapId()); continue; } r -= I_O;
        if (r < I_PG) { conv_item(A->in[19] + (size_t)l * DM * DM, DM, DM, W + W_PG, DM, 0, A->in[18] + (size_t)l * DM, scr, r, 32, lane, MapId()); continue; } r -= I_PG;
        conv_item(A->in[20] + (size_t)l * DPLE * DM, DPLE, DM, W + W_PP, DPLE, 0, nullptr, scr, r, 32, lane, MapId());
    }
}
__device__ __forceinline__ void phase_init_rows(const Ctx& C) {
    TID_SETUP(); ArgsP A = args_ptr(); const int gw = C.bid * NWAVES + wave, NGW = C.G * NWAVES;
    const float* x = A->in[0]; bf16_t* XB = WSP(bf16_t, WS_XB); float* SS0 = WSP(float, WS_SS0);
    for (int m0 = 4 * gw; m0 < MTOK; m0 += 4 * NGW) {
        f32x4 v[4][4];
#pragma unroll
        for (int k = 0; k < 4; ++k) { const int m = m0 + k; const f32x4* xr = (const f32x4*)(x + (size_t)m * DM) + lane;
#pragma unroll
            for (int j = 0; j < 4; ++j) v[k][j] = xr[64 * j]; }
#pragma unroll
        for (int k = 0; k < 4; ++k) { const int m = m0 + k;
            { u32x2* bo = (u32x2*)(XB + (size_t)m * DM) + lane; float s = 0.f;
#pragma unroll
                for (int j = 0; j < 4; ++j) { const f32x4 t = v[k][j]; u32x2 w; w.x = pk2(t[0], t[1]); w.y = pk2(t[2], t[3]); bo[64 * j] = w; s += (t[0] * t[0] + t[1] * t[1]) + (t[2] * t[2] + t[3] * t[3]); }
                s = wave_sum(s);
                if (lane == 0) *(f32x4*)(SS0 + (size_t)m * 4) = (f32x4){s, 0.f, 0.f, 0.f}; } }
    }
}
__device__ __forceinline__ void phase_pb(const Ctx& C, int l) {
    TID_SETUP(); ArgsP A = args_ptr();
    const f32x4* p = (const f32x4*)(A->in[1] + (size_t)l * MTOK * DPLE); u32x2* o = WSP(u32x2, WS_PB);
    const size_t n4 = (size_t)MTOK * DPLE / 4;
    for (size_t i = (size_t)C.bid * NTHR + tid; i < n4; i += (size_t)C.G * NTHR) { const f32x4 v = p[i]; u32x2 w; w.x = pk2(v[0], v[1]); w.y = pk2(v[2], v[3]); o[i] = w; }
}
__device__ __forceinline__ void phase_final(const Ctx& C) {
    TID_SETUP(); ArgsP A = args_ptr(); const int gw = C.bid * NWAVES + wave, NGW = C.G * NWAVES;
    const f32x4* gn = (const f32x4*)A->in[21] + lane; float* X = A->out; const float* SS = WSP(float, WS_SS0);
    f32x4 g4[4];
#pragma unroll
    for (int j = 0; j < 4; ++j) g4[j] = gn[64 * j];
    for (int m0 = 4 * gw; m0 < MTOK; m0 += 4 * NGW) {
        f32x4 v[4][4]; float r[4];
#pragma unroll
        for (int k = 0; k < 4; ++k) { const int m = m0 + k; const f32x4* xr = (const f32x4*)(X + (size_t)m * DM) + lane;
#pragma unroll
            for (int j = 0; j < 4; ++j) v[k][j] = xr[64 * j];
            r[k] = rstd_of(SS + (size_t)m * 4); }
#pragma unroll
        for (int k = 0; k < 4; ++k) { const int m = m0 + k;
            { f32x4* xr = (f32x4*)(X + (size_t)m * DM) + lane;
#pragma unroll
                for (int j = 0; j < 4; ++j) xr[64 * j] = v[k][j] * r[k] * g4[j]; } }
    }
}

__device__ __forceinline__ void prep_conv(const Ctx& C, int l, int b, int part, int nparts, int dry) {
    TID_SETUP(); ArgsP A = args_ptr();
    const float* cw = A->in[7] + (size_t)l * 3 * DCONV; bf16_t* PROJ = WSP(bf16_t, WS_PROJ);
    const int nit = SEQ * 64;
    const int stride = nparts * NTHR;
    for (int i0 = part * NTHR + tid; i0 < nit; i0 += 2 * stride) {
        u32x4 bv[2], cv[2][3], xv[2][3];
#pragma unroll
        for (int k = 0; k < 2; ++k) { const int i = min(i0 + k * stride, nit - 1), ts = i >> 6, ch = (i & 63) * 8;
            bv[k] = *(const u32x4*)(PROJ + (size_t)(b * SEQ + ts) * LDP + O_CB + ch);
#pragma unroll
            for (int d = 0; d < 3; ++d) { const bf16_t* r2 = PROJ + (size_t)(b * SEQ + max(ts - (2 - d), 0)) * LDP; cv[k][d] = *(const u32x4*)(r2 + O_CC + ch); xv[k][d] = *(const u32x4*)(r2 + O_CX + ch); } }
#pragma unroll
        for (int k = 0; k < 2; ++k) { const int i = i0 + k * stride;
            if (i < nit) { const int ts = i >> 6, ch = (i & 63) * 8;
                bf16_t* row = PROJ + (size_t)(b * SEQ + ts) * LDP;
                float u[3][8];
#pragma unroll
                for (int d = 0; d < 3; ++d) { const float on = (ts >= 2 - d) ? 1.0f : 0.0f;
                    const unsigned cwv[4] = {cv[k][d].x, cv[k][d].y, cv[k][d].z, cv[k][d].w}, xwv[4] = {xv[k][d].x, xv[k][d].y, xv[k][d].z, xv[k][d].w};
#pragma unroll
                    for (int j = 0; j < 4; ++j) { u[d][2 * j] = on * (bflo(cwv[j]) * bflo(xwv[j])); u[d][2 * j + 1] = on * (bfhi(cwv[j]) * bfhi(xwv[j])); } }
                const unsigned bw[4] = {bv[k].x, bv[k].y, bv[k].z, bv[k].w}; float o[8];
#pragma unroll
                for (int j = 0; j < 8; ++j) { const float bb = (j & 1) ? bfhi(bw[j >> 1]) : bflo(bw[j >> 1]);
                    o[j] = bb * (u[0][j] * cw[ch + j] + u[1][j] * cw[DCONV + ch + j] + u[2][j] * cw[2 * DCONV + ch + j]); }
                u32x4 w; w.x = pk2(o[0], o[1]); w.y = pk2(o[2], o[3]); w.z = pk2(o[4], o[5]); w.w = pk2(o[6], o[7]);
                if (!dry) *(u32x4*)(row + O_CB + ch) = w; } }
    }
}
__device__ __forceinline__ void prep_gate(const Ctx& C, int l, int part, int nparts, int dry = 0) {
    TID_SETUP(); ArgsP A = args_ptr();
    const float* gn = A->in[11] + (size_t)l * DM; bf16_t* PROJ = WSP(bf16_t, WS_PROJ);
    const int nit = MG * 4, g = lane >> 4, li = lane & 15;
    for (int i = (part * NWAVES + wave) * 4 + g; i < nit; i += nparts * NWAVES * 4) {
        const int tok = i >> 2, hd = i & 3;
        bf16_t* row = PROJ + (size_t)tok * LDP;
        const u32x4 h0 = *(const u32x4*)(row + O_MV + hd * 256 + li * 16), h1 = *(const u32x4*)(row + O_MV + hd * 256 + li * 16 + 8);
        const u32x4 o0 = *(const u32x4*)(row + O_MO + hd * 256 + li * 16), o1 = *(const u32x4*)(row + O_MO + hd * 256 + li * 16 + 8);
        const unsigned hw[8] = {h0.x, h0.y, h0.z, h0.w, h1.x, h1.y, h1.z, h1.w}, ow[8] = {o0.x, o0.y, o0.z, o0.w, o1.x, o1.y, o1.z, o1.w};
        float ssq = 0.f;
#pragma unroll
        for (int j = 0; j < 8; ++j) { const float a = bflo(hw[j]), bb = bfhi(hw[j]); ssq += a * a + bb * bb; }
#pragma unroll
        for (int o = 1; o < 16; o <<= 1) ssq += __shfl_xor(ssq, o);
        const float r = 1.0f / sqrtf(ssq * (1.0f / 256.0f) + EPS);
        const f32x4* gp = (const f32x4*)(gn + hd * 256 + li * 16);
        unsigned w[8];
#pragma unroll
        for (int j = 0; j < 4; ++j) { const f32x4 gv = gp[j];
            w[2 * j] = pk2(fsigmoid(bflo(ow[2 * j])) * bflo(hw[2 * j]) * r * gv[0], fsigmoid(bfhi(ow[2 * j])) * bfhi(hw[2 * j]) * r * gv[1]);
            w[2 * j + 1] = pk2(fsigmoid(bflo(ow[2 * j + 1])) * bflo(hw[2 * j + 1]) * r * gv[2], fsigmoid(bfhi(ow[2 * j + 1])) * bfhi(hw[2 * j + 1]) * r * gv[3]); }
        if (!dry) { *(u32x4*)(row + O_MO + hd * 256 + li * 16) = (u32x4){w[0], w[1], w[2], w[3]}; *(u32x4*)(row + O_MO + hd * 256 + li * 16 + 8) = (u32x4){w[4], w[5], w[6], w[7]}; }
    }
}

namespace ml {
constexpr int QS = 0, KS = 17408, VS = 34816, VW = 44032, PS = 53248, CB = 62464, SC = 97280, NP = 99328, NV = 103424, MS = 103936, LEND = 104704;
constexpr int PQ = 272, PT = 144;
static_assert(LEND <= RING_BYTES, "mlstm LDS");
typedef short s16x4 __attribute__((ext_vector_type(4)));
__device__ __forceinline__ f32x4 mfma16(bf16x8 a, bf16x8 b, f32x4 c) { return __builtin_amdgcn_mfma_f32_16x16x32_bf16(a, b, c, 0, 0, 0); }
__device__ __forceinline__ bf16x8 ldsv(const LAS unsigned char* p) { return *(const LAS bf16x8*)p; }
__device__ __forceinline__ bf16x8 frag_tr(const LAS unsigned char* X, int P, int r0, int c0, int lane) {
    const int g = lane >> 4, li = lane & 15;
    const LAS unsigned char* p = X + (r0 + 8 * g + (li >> 2)) * P + (c0 + 4 * (li & 3)) * 2;
    const s16x4 lo = __builtin_amdgcn_ds_read_tr16_b64_v4i16((LAS s16x4*)p), hi = __builtin_amdgcn_ds_read_tr16_b64_v4i16((LAS s16x4*)(p + 4 * P));
    return __builtin_shufflevector(lo, hi, 0, 1, 2, 3, 4, 5, 6, 7);
}

__device__ __forceinline__ void unit(const Ctx& C, int l, int uidx, int dry) {
    TID_SETUP(); ArgsP A = args_ptr();
    const int b = uidx >> 4, hd = (uidx >> 2) & 3, vq = uidx & 3;
    LAS unsigned char* L = C.lds;
    LAS float* sc = (LAS float*)(L + SC);
    LAS float* npart = (LAS float*)(L + NP);
    LAS float* nv = (LAS float*)(L + NV);
    LAS float* ms = (LAS float*)(L + MS);
    const int w = wave, fr = lane & 15, fq = lane >> 4;
    const float bi = A->in[9][l * 4 + hd], bfg = A->in[10][l * 4 + hd];
    bf16_t* base = WSP(bf16_t, WS_PROJ) + (size_t)b * SEQ * LDP;
    float* scr = WSP(float, WS_SCR) + (size_t)uidx * (64 * 192);
    const int qr = tid >> 4, qc = (tid & 15) * 8;
    const int vr = tid >> 3, vc = (tid & 7) * 8;
    u32x4 rq[2], rk[2], rv; float ra = 0.f, rpm = 0.f, rbt = 0.f;
#define ML_ISSUE_ROWS(cc) do { const bf16_t* rb = base + (size_t)((cc) * 64) * LDP; \
        rq[0] = *(const u32x4*)(rb + (size_t)qr * LDP + O_MQ + hd * 128 + qc); rq[1] = *(const u32x4*)(rb + (size_t)(qr + 32) * LDP + O_MQ + hd * 128 + qc); \
        rk[0] = *(const u32x4*)(rb + (size_t)qr * LDP + O_MK + hd * 128 + qc); rk[1] = *(const u32x4*)(rb + (size_t)(qr + 32) * LDP + O_MK + hd * 128 + qc); \
        rv = *(const u32x4*)(rb + (size_t)vr * LDP + O_MV + hd * 256 + vq * 64 + vc); } while (0)
    ML_ISSUE_ROWS(0);
    for (int c = w; c < SEQ / 64; c += NWAVES) {
        const bf16_t* rb = WSP(bf16_t, WS_SIDE) + (size_t)(b * SEQ + c * 64 + lane) * LDS_;
        const float fv = bf2f(rb[O_MF - O_SIDE + hd]) + bfg, iv = bf2f(rb[O_MI - O_SIDE + hd]) + bi;
        const float lf = fminf(fv, 0.f) - log1pf(__expf(-fabsf(fv)));
#define ML_DPP(old_, src_, ctrl_, rmask_, bc_) __int_as_float(__builtin_amdgcn_update_dpp(__float_as_int(old_), __float_as_int(src_), ctrl_, rmask_, 0xf, bc_))
        float bt = lf;
        bt += ML_DPP(0.f, bt, 0x111, 0xf, true); bt += ML_DPP(0.f, bt, 0x112, 0xf, true); bt += ML_DPP(0.f, bt, 0x114, 0xf, true); bt += ML_DPP(0.f, bt, 0x118, 0xf, true);
        bt += ML_DPP(0.f, bt, 0x142, 0xa, false); bt += ML_DPP(0.f, bt, 0x143, 0xc, false);
        const float a = iv - bt; float pm = a;
        pm = fmaxf(pm, ML_DPP(pm, pm, 0x111, 0xf, false)); pm = fmaxf(pm, ML_DPP(pm, pm, 0x112, 0xf, false)); pm = fmaxf(pm, ML_DPP(pm, pm, 0x114, 0xf, false)); pm = fmaxf(pm, ML_DPP(pm, pm, 0x118, 0xf, false));
        pm = fmaxf(pm, ML_DPP(pm, pm, 0x142, 0xa, false)); pm = fmaxf(pm, ML_DPP(pm, pm, 0x143, 0xc, false));
#undef ML_DPP
        scr[c * 192 + lane] = a; scr[c * 192 + 64 + lane] = pm; scr[c * 192 + 128 + lane] = bt;
        if (lane == 63) { ms[64 + c] = bt; ms[128 + c] = pm; }
    }
    f32x4 cst[4];
#pragma unroll
    for (int i = 0; i < 4; ++i) cst[i] = (f32x4){0.f, 0.f, 0.f, 0.f};
    for (int i = tid; i < 2 * 64 * PQ / 4; i += NTHR) ((LAS unsigned*)(L + CB))[i] = 0u;
    for (int i = tid; i < 8 * 128; i += NTHR) npart[i] = 0.f;
    if (tid < 128) nv[tid] = 0.f;
    __syncthreads();
    if (w == 0) {
        const float bL = ms[64 + lane], p6 = ms[128 + lane]; float m = 0.f, mv = 0.f;
#pragma unroll 8
        for (int c = 0; c < SEQ / 64; ++c) { mv = (lane == c) ? m : mv;
            const float bc = __int_as_float(__builtin_amdgcn_readlane(__float_as_int(bL), c)), pc = __int_as_float(__builtin_amdgcn_readlane(__float_as_int(p6), c));
            m = bc + fmaxf(m, pc); }
        ms[lane] = mv; }
#define ML_ISSUE(cc) do { ML_ISSUE_ROWS(cc); \
        if (w == 0) { ra = scr[(cc) * 192 + lane]; rpm = scr[(cc) * 192 + 64 + lane]; rbt = scr[(cc) * 192 + 128 + lane]; } } while (0)
    __syncthreads();
    if (w == 0) { ra = scr[lane]; rpm = scr[64 + lane]; rbt = scr[128 + lane]; }
    float decay = 0.f;
    int cur = 0;
#pragma unroll 1
    for (int c = 0; c < SEQ / 64; ++c) {
#pragma unroll
        for (int i = 0; i < 2; ++i) {
            *(LAS u32x4*)(L + QS + (qr + 32 * i) * PQ + qc * 2) = rq[i];
            *(LAS u32x4*)(L + KS + (qr + 32 * i) * PQ + qc * 2) = rk[i];
        }
        *(LAS u32x4*)(L + VS + vr * PT + vc * 2) = rv;
        const u32x4 vkeep = rv;
        if (tid < 128) { float pn[8], nold = nv[tid];
#pragma unroll
            for (int j = 0; j < 8; ++j) pn[j] = npart[j * 128 + tid];
            asm volatile("" : "+v"(pn[0]), "+v"(pn[1]), "+v"(pn[2]), "+v"(pn[3]), "+v"(pn[4]), "+v"(pn[5]), "+v"(pn[6]), "+v"(pn[7]), "+v"(nold));
            float sn = 0.f;
#pragma unroll
            for (int j = 0; j < 8; ++j) sn += pn[j];
            nv[tid] = decay * nold + sn; }
        if (w == 0) {
            const float mc = ms[c], p63 = ms[128 + c];
            const float Mt = fmaxf(mc, rpm), M63 = fmaxf(mc, p63);
            sc[lane] = ra; sc[64 + lane] = Mt; sc[128 + lane] = __expf(mc - Mt); sc[192 + lane] = __expf(-(rbt + Mt)); sc[256 + lane] = __expf(ra - M63);
            if (lane == 0) sc[320] = __expf(mc - M63);
        }
        __syncthreads();
        decay = sc[320];
        if (c + 1 < SEQ / 64) ML_ISSUE(c + 1);
        { const float wk = sc[256 + vr]; const unsigned vw[4] = {vkeep.x, vkeep.y, vkeep.z, vkeep.w}; u32x4 o;
          o.x = pk2(bflo(vw[0]) * wk, bfhi(vw[0]) * wk); o.y = pk2(bflo(vw[1]) * wk, bfhi(vw[1]) * wk); o.z = pk2(bflo(vw[2]) * wk, bfhi(vw[2]) * wk); o.w = pk2(bflo(vw[3]) * wk, bfhi(vw[3]) * wk);
          *(LAS u32x4*)(L + VW + vr * PT + vc * 2) = o; }
        {
            const int ti = w >> 1;
            bf16x8 qa[4], kf[2][4];
#pragma unroll
            for (int kk = 0; kk < 4; ++kk) qa[kk] = ldsv(L + QS + (16 * ti + fr) * PQ + (32 * kk + 8 * fq) * 2);
#pragma unroll
            for (int s2 = 0; s2 < 2; ++s2)
#pragma unroll
                for (int kk = 0; kk < 4; ++kk) kf[s2][kk] = ldsv(L + KS + (16 * (2 * (w & 1) + s2) + fr) * PQ + (32 * kk + 8 * fq) * 2);
            f32x4 Mr = *(const LAS f32x4*)(sc + 64 + 16 * ti + 4 * fq);
            float as2[2] = {sc[16 * (2 * (w & 1)) + fr], sc[16 * (2 * (w & 1) + 1) + fr]};
            asm volatile("" : "+v"(qa[0]), "+v"(qa[1]), "+v"(qa[2]), "+v"(qa[3]), "+v"(kf[0][0]), "+v"(kf[0][1]), "+v"(kf[0][2]), "+v"(kf[0][3]),
                              "+v"(kf[1][0]), "+v"(kf[1][1]), "+v"(kf[1][2]), "+v"(kf[1][3]), "+v"(Mr), "+v"(as2[0]), "+v"(as2[1]));
#pragma unroll
            for (int s2 = 0; s2 < 2; ++s2) { const int si = 2 * (w & 1) + s2; f32x4 sa = (f32x4){0.f, 0.f, 0.f, 0.f};
#pragma unroll
                for (int kk = 0; kk < 4; ++kk) sa = mfma16(qa[kk], kf[s2][kk], sa);
                const int scol = 16 * si + fr; const float as = as2[s2];
#pragma unroll
                for (int r = 0; r < 4; ++r) { const int trow = 16 * ti + 4 * fq + r; const float p = (scol <= trow) ? sa[r] * __expf(as - Mr[r]) : 0.f;
                    *(LAS bf16_t*)(L + PS + trow * PT + scol * 2) = f2bf(p); } }
        }
        __syncthreads();
        {
            const int vi = w >> 1;
            bf16x8 va[2], kt[4][2];
#pragma unroll
            for (int kk = 0; kk < 2; ++kk) va[kk] = frag_tr(L + VW, PT, 32 * kk, 16 * vi, lane);
#pragma unroll
            for (int i = 0; i < 4; ++i)
#pragma unroll
                for (int kk = 0; kk < 2; ++kk) kt[i][kk] = frag_tr(L + KS, PQ, 32 * kk, 16 * (4 * (w & 1) + i), lane);
            asm volatile("" : "+v"(va[0]), "+v"(va[1]), "+v"(kt[0][0]), "+v"(kt[0][1]), "+v"(kt[1][0]), "+v"(kt[1][1]), "+v"(kt[2][0]), "+v"(kt[2][1]), "+v"(kt[3][0]), "+v"(kt[3][1]));
#pragma unroll
            for (int i = 0; i < 4; ++i) { const int di = 4 * (w & 1) + i; f32x4 a = cst[i] * decay;
#pragma unroll
                for (int kk = 0; kk < 2; ++kk) a = mfma16(va[kk], kt[i][kk], a);
                cst[i] = a;
#pragma unroll
                for (int r = 0; r < 4; ++r) *(LAS bf16_t*)(L + CB + (cur ^ 1) * 64 * PQ + (16 * vi + 4 * fq + r) * PQ + (16 * di + fr) * 2) = f2bf(a[r]); }
        }
        {
            float p0 = 0.f, p1 = 0.f; unsigned kw[8];
#pragma unroll
            for (int i = 0; i < 8; ++i) kw[i] = *(const LAS unsigned*)(L + KS + (8 * w + i) * PQ + lane * 4);
            f32x4 wk0 = *(const LAS f32x4*)(sc + 256 + 8 * w), wk1 = *(const LAS f32x4*)(sc + 256 + 8 * w + 4);
            asm volatile("" : "+v"(kw[0]), "+v"(kw[1]), "+v"(kw[2]), "+v"(kw[3]), "+v"(kw[4]), "+v"(kw[5]), "+v"(kw[6]), "+v"(kw[7]), "+v"(wk0), "+v"(wk1));
#pragma unroll
            for (int i = 0; i < 8; ++i) { const float wk = (i < 4) ? wk0[i & 3] : wk1[i & 3]; p0 += wk * bflo(kw[i]); p1 += wk * bfhi(kw[i]); }
            npart[w * 128 + 2 * lane] = p0; npart[w * 128 + 2 * lane + 1] = p1;
        }
        {
            const int ti = w >> 1;
            float nq = 0.f, ps = 0.f;
            { const LAS unsigned char* qrow = L + QS + (16 * ti + fr) * PQ + (32 * fq) * 2;
              const LAS unsigned char* prow = L + PS + (16 * ti + fr) * PT + (16 * fq) * 2;
              u32x4 qv[4], pv[2]; f32x4 nvv[8];
#pragma unroll
              for (int h4 = 0; h4 < 4; ++h4) qv[h4] = *(const LAS u32x4*)(qrow + h4 * 16);
#pragma unroll
              for (int i = 0; i < 8; ++i) nvv[i] = *(const LAS f32x4*)(nv + 32 * fq + 4 * i);
#pragma unroll
              for (int h2 = 0; h2 < 2; ++h2) pv[h2] = *(const LAS u32x4*)(prow + h2 * 16);
              asm volatile("" : "+v"(qv[0]), "+v"(qv[1]), "+v"(qv[2]), "+v"(qv[3]), "+v"(pv[0]), "+v"(pv[1]),
                                "+v"(nvv[0]), "+v"(nvv[1]), "+v"(nvv[2]), "+v"(nvv[3]), "+v"(nvv[4]), "+v"(nvv[5]), "+v"(nvv[6]), "+v"(nvv[7]));
#pragma unroll
              for (int h4 = 0; h4 < 4; ++h4) { const unsigned qw[4] = {qv[h4].x, qv[h4].y, qv[h4].z, qv[h4].w};
#pragma unroll
                  for (int j = 0; j < 4; ++j) { const int e0 = 8 * h4 + 2 * j; nq += nvv[e0 >> 2][e0 & 3] * bflo(qw[j]) + nvv[(e0 + 1) >> 2][(e0 + 1) & 3] * bfhi(qw[j]); } }
#pragma unroll
              for (int h2 = 0; h2 < 2; ++h2) { const unsigned pw[4] = {pv[h2].x, pv[h2].y, pv[h2].z, pv[h2].w};
#pragma unroll
                  for (int j = 0; j < 4; ++j) ps += bflo(pw[j]) + bfhi(pw[j]); } }
            { const auto a1 = __builtin_amdgcn_permlane16_swap(__float_as_uint(nq), __float_as_uint(nq), false, false); const auto b1 = __builtin_amdgcn_permlane16_swap(__float_as_uint(ps), __float_as_uint(ps), false, false);
              nq = __uint_as_float(a1[0]) + __uint_as_float(a1[1]); ps = __uint_as_float(b1[0]) + __uint_as_float(b1[1]);
              const auto a2 = __builtin_amdgcn_permlane32_swap(__float_as_uint(nq), __float_as_uint(nq), false, false); const auto b2 = __builtin_amdgcn_permlane32_swap(__float_as_uint(ps), __float_as_uint(ps), false, false);
              nq = __uint_as_float(a2[0]) + __uint_as_float(a2[1]); ps = __uint_as_float(b2[0]) + __uint_as_float(b2[1]); }
            const float den_own = sc[128 + 16 * ti + fr] * nq + ps;
            float wr4[4], em4[4], dn4[4];
#pragma unroll
            for (int r = 0; r < 4; ++r) { wr4[r] = sc[128 + 16 * ti + 4 * fq + r]; em4[r] = sc[192 + 16 * ti + 4 * fq + r]; dn4[r] = __shfl(den_own, 4 * fq + r); }
            asm volatile("" : "+v"(dn4[0]), "+v"(dn4[1]), "+v"(dn4[2]), "+v"(dn4[3]), "+v"(wr4[0]), "+v"(wr4[1]), "+v"(wr4[2]), "+v"(wr4[3]), "+v"(em4[0]), "+v"(em4[1]), "+v"(em4[2]), "+v"(em4[3]));
            bf16x8 qa[4], pa[2], cbf[2][4], vtf[2][2];
#pragma unroll
            for (int kk = 0; kk < 4; ++kk) qa[kk] = ldsv(L + QS + (16 * ti + fr) * PQ + (32 * kk + 8 * fq) * 2);
#pragma unroll
            for (int kk = 0; kk < 2; ++kk) pa[kk] = ldsv(L + PS + (16 * ti + fr) * PT + (32 * kk + 8 * fq) * 2);
#pragma unroll
            for (int v2 = 0; v2 < 2; ++v2) {
#pragma unroll
                for (int kk = 0; kk < 4; ++kk) cbf[v2][kk] = ldsv(L + CB + cur * 64 * PQ + (16 * (2 * (w & 1) + v2) + fr) * PQ + (32 * kk + 8 * fq) * 2);
#pragma unroll
                for (int kk = 0; kk < 2; ++kk) vtf[v2][kk] = frag_tr(L + VS, PT, 32 * kk, 16 * (2 * (w & 1) + v2), lane); }
            asm volatile("" : "+v"(qa[0]), "+v"(qa[1]), "+v"(qa[2]), "+v"(qa[3]), "+v"(pa[0]), "+v"(pa[1]), "+v"(cbf[0][0]), "+v"(cbf[0][1]), "+v"(cbf[0][2]), "+v"(cbf[0][3]),
                              "+v"(cbf[1][0]), "+v"(cbf[1][1]), "+v"(cbf[1][2]), "+v"(cbf[1][3]), "+v"(vtf[0][0]), "+v"(vtf[0][1]), "+v"(vtf[1][0]), "+v"(vtf[1][1]));
            const float kscale = 0.08838834764831845f;
#pragma unroll
            for (int v2 = 0; v2 < 2; ++v2) { const int vi = 2 * (w & 1) + v2; f32x4 a = (f32x4){0.f, 0.f, 0.f, 0.f};
#pragma unroll
                for (int kk = 0; kk < 4; ++kk) a = mfma16(qa[kk], cbf[v2][kk], a);
#pragma unroll
                for (int r = 0; r < 4; ++r) a[r] *= wr4[r];
#pragma unroll
                for (int kk = 0; kk < 2; ++kk) a = mfma16(pa[kk], vtf[v2][kk], a);
#pragma unroll
                for (int r = 0; r < 4; ++r) { const float hval = kscale * a[r] * __builtin_amdgcn_rcpf(fmaxf(kscale * fabsf(dn4[r]), em4[r]));
                    if (!dry) base[(size_t)(c * 64 + 16 * ti + 4 * fq + r) * LDP + O_MV + hd * 256 + vq * 64 + 16 * vi + fr] = f2bf(hval); } }
        }
        __syncthreads();
        cur ^= 1;
    }
#undef ML_ISSUE
#undef ML_ISSUE_ROWS
}
}

namespace dsa {
constexpr int GP = 129;
constexpr int GT = 0, EQ = 32 * GP * 4, QST = 2 * EQ, HIST = QST + 512, HPITCH = 257, LIST = HIST + 32 * HPITCH * 4, LCAP = 64, LPITCH = 68  , CNT = LIST + 32 * LPITCH * 4, KST = HIST, KBUF = 128 * 144, VST = KST + 2 * KBUF, LEND = VST + 2 * KBUF, EMK = LEND, EMKB = 8192;
static_assert(CNT + 512 <= LEND, "dsa LDS");
typedef short s16x4 __attribute__((ext_vector_type(4)));
static_assert(LEND <= RING_BYTES, "dsa LDS");
__device__ __forceinline__ f32x16 mfma32(bf16x8 a, bf16x8 b, f32x16 c) { return __builtin_amdgcn_mfma_f32_32x32x16_bf16(a, b, c, 0, 0, 0); }
__device__ __forceinline__ unsigned fkey(float s) { const unsigned u = __float_as_uint(s); return (u & 0x80000000u) ? ~u : (u | 0x80000000u); }
__device__ __forceinline__ unsigned lowbits(unsigned e, int k) { if (k >= (int)__popc(e)) return e; unsigned r = 0u; for (int i = 0; i < k; ++i) { const unsigned b = e & (0u - e); r |= b; e ^= b; } return r; }

#define DSA_LOADK(dst, tile) do { _Pragma("unroll") for (int kk = 0; kk < 4; ++kk) dst[kk] = *(const bf16x8*)(kbase + (size_t)((tile) * 32 + q) * LDS_ + (O_IK - O_SIDE) + kk * 16 + hf * 8); } while (0)
__device__ __forceinline__ void idx_scores(const bf16x8 (&ka)[4], const bf16x8 (&bq)[4][4], const float (&wq)[4], float (&sc)[16]) {
    f32x16 a[4];
#pragma unroll
    for (int h = 0; h < 4; ++h)
#pragma unroll
        for (int r = 0; r < 16; ++r) a[h][r] = 0.f;
#pragma unroll
    for (int kk = 0; kk < 4; ++kk)
#pragma unroll
        for (int h = 0; h < 4; ++h) a[h] = mfma32(ka[kk], bq[h][kk], a[h]);
#pragma unroll
    for (int r = 0; r < 16; ++r) {
        float v = wq[0] * __builtin_amdgcn_fmed3f(a[0][r], 0.f, 3.0e38f);
        v = fmaf(wq[1], __builtin_amdgcn_fmed3f(a[1][r], 0.f, 3.0e38f), v);
        v = fmaf(wq[2], __builtin_amdgcn_fmed3f(a[2][r], 0.f, 3.0e38f), v);
        sc[r] = fmaf(wq[3], __builtin_amdgcn_fmed3f(a[3][r], 0.f, 3.0e38f), v) + 0.0f; }
}

#define DSA_PRELOAD() do { DSA_LOADK(k0, min(w, tlast)); DSA_LOADK(k1, min(w + NWAVES, tlast)); } while (0)
#define DSA_DIAG_MASK() if (tile == qt) { _Pragma("unroll") for (int r = 0; r < 16; ++r) { const int pos = (r & 3) + 8 * (r >> 2) + 4 * hf; sc[r] = (pos <= q) ? sc[r] : -__builtin_inff(); } }
template <int PASS>
__device__ __forceinline__ void radix_pass(LAS unsigned char* L, int lane, int w, int q, int hf, int qt, int ntile, const bf16_t* kbase, const bf16x8 (&bq)[4][4], const float (&wq)[4],
                                           bf16x8 (&k0)[4], bf16x8 (&k1)[4], u32x4* kc) {
    constexpr int shift = 24 - 8 * PASS;
    LAS unsigned* hist = (LAS unsigned*)(L + HIST); LAS unsigned* qst = (LAS unsigned*)(L + QST);
    const unsigned prefix = qst[q];
    LAS unsigned* hrow = hist + q * HPITCH;
    int tile = w; const int tlast = ntile - 1;
    if constexpr (PASS == 1) {
#pragma unroll 1
        for (; tile < ntile; tile += 4 * NWAVES) {
            u32x4 ca[4], cb[4];
#pragma unroll
            for (int j = 0; j < 4; ++j) { const int tl = min(tile + j * NWAVES, tlast); ca[j] = *(kc + (size_t)(tl * 64 + lane) * 2); cb[j] = *(kc + (size_t)(tl * 64 + lane) * 2 + 1); }
#pragma unroll
            for (int j = 0; j < 4; ++j) if (tile + j * NWAVES < ntile) {
                const unsigned cw[8] = {ca[j].x, ca[j].y, ca[j].z, ca[j].w, cb[j].x, cb[j].y, cb[j].z, cb[j].w};
#pragma unroll
                for (int r = 0; r < 16; ++r) { const unsigned h16 = (r & 1) ? (cw[r >> 1] >> 16) : (cw[r >> 1] & 0xffffu);
                    const bool hit = ((h16 >> 8) == prefix); const unsigned bin = hit ? (h16 & 255u) : 256u;
                    __hip_atomic_fetch_add(&hrow[bin], 1u, __ATOMIC_RELAXED, __HIP_MEMORY_SCOPE_WORKGROUP); } }
        }
    } else {
#define DSA_RSTEP(KB) { \
        float sc[16]; idx_scores(KB, bq, wq, sc); \
        DSA_LOADK(KB, min(tile + 2 * NWAVES, tlast)); \
        DSA_DIAG_MASK() \
        unsigned kh[8], kl[8]; \
        _Pragma("unroll") for (int r = 0; r < 16; ++r) { const unsigned key = fkey(sc[r]); unsigned bin = (key >> shift) & 255u; bool hit = true; \
            if (PASS == 0) { if (r & 1) { kh[r >> 1] |= key & 0xffff0000u; kl[r >> 1] |= key << 16; } else { kh[r >> 1] = key >> 16; kl[r >> 1] = key & 0xffffu; } } \
            if (PASS > 0) { hit = ((key >> ((shift + 8) & 31)) == prefix); bin = hit ? bin : 256u; } \
            if (PASS < 2 || __any(hit)) __hip_atomic_fetch_add(&hrow[bin], 1u, __ATOMIC_RELAXED, __HIP_MEMORY_SCOPE_WORKGROUP); } \
        if (PASS == 0) { *(kc + (size_t)(tile * 64 + lane) * 2) = (u32x4){kh[0], kh[1], kh[2], kh[3]}; *(kc + (size_t)(tile * 64 + lane) * 2 + 1) = (u32x4){kh[4], kh[5], kh[6], kh[7]}; \
            u32x4* kcl_ = kc + (WS_KCL - WS_KC) / 16; *(kcl_ + (size_t)(tile * 64 + lane) * 2) = (u32x4){kl[0], kl[1], kl[2], kl[3]}; *(kcl_ + (size_t)(tile * 64 + lane) * 2 + 1) = (u32x4){kl[4], kl[5], kl[6], kl[7]}; } \
        tile += NWAVES; }
#pragma unroll 1
    while (tile + NWAVES < ntile) { DSA_RSTEP(k0) DSA_RSTEP(k1) }
    if (tile < ntile) DSA_RSTEP(k0)
#undef DSA_RSTEP
    }
    if constexpr (PASS != 1) DSA_PRELOAD();
    __syncthreads();
    { const int g = lane >> 4, li = lane & 15, qq = 4 * w + g; const unsigned need = qst[32 + qq];
        LAS unsigned* hq = hist + qq * HPITCH + 16 * li;
        unsigned t = 0u;
#pragma unroll
        for (int j = 0; j < 16; ++j) t += hq[(j + li) & 15];
        unsigned sfx = t;
        sfx += (unsigned)__builtin_amdgcn_update_dpp(0, (int)sfx, 0x101, 0xf, 0xf, true); sfx += (unsigned)__builtin_amdgcn_update_dpp(0, (int)sfx, 0x102, 0xf, 0xf, true);
        sfx += (unsigned)__builtin_amdgcn_update_dpp(0, (int)sfx, 0x104, 0xf, 0xf, true); sfx += (unsigned)__builtin_amdgcn_update_dpp(0, (int)sfx, 0x108, 0xf, 0xf, true);
        const unsigned cum0 = sfx - t;
        if (cum0 < need && cum0 + t >= need) {
            unsigned cum = cum0, cat = 0u; int found = -1;
#pragma unroll
            for (int j = 15; j >= 0; --j) { const unsigned cj = hq[j]; if (found < 0 && cum + cj >= need) { found = j; cat = cum; } cum += cj; }
            qst[qq] = (qst[qq] << 8) | (unsigned)(16 * li + found); qst[32 + qq] = need - cat; }
#pragma unroll
        for (int j = 0; j < 16; ++j) hq[(j + li) & 15] = 0u;
        if (li == 15) hist[qq * HPITCH + 256] = 0u; }
    __syncthreads();
}
__device__ __forceinline__ void tie_fixup(LAS unsigned* gt, LAS unsigned* eq, int qq, int li, int need) {
    unsigned e[8]; int cn[8]; int t = 0;
#pragma unroll
    for (int j = 0; j < 8; ++j) { e[j] = eq[qq * GP + 8 * li + j]; cn[j] = __popc(e[j]); t += cn[j]; }
    int pre = t;
#pragma unroll
    for (int o = 1; o < 16; o <<= 1) { const int v = __shfl_up(pre, o, 16); if (li >= o) pre += v; }
    int before = pre - t;
#pragma unroll
    for (int j = 0; j < 8; ++j) { const int k = min(cn[j], max(need - before, 0)); if (e[j]) gt[qq * GP + 8 * li + j] |= lowbits(e[j], k); before += cn[j]; }
}

__device__ __forceinline__ void unit(const Ctx& C, int b, int qt, int dry) {
    TID_SETUP(); ArgsP A = args_ptr();
    LAS unsigned char* L = C.lds;
    LAS unsigned* hist = (LAS unsigned*)(L + HIST); LAS unsigned* gt = (LAS unsigned*)(L + GT); LAS unsigned* eq = (LAS unsigned*)(L + EQ); LAS unsigned* qst = (LAS unsigned*)(L + QST);
    LAS unsigned* list = (LAS unsigned*)(L + LIST); LAS unsigned* cnt = (LAS unsigned*)(L + CNT);
    const int w = wave, q = lane & 31, hf = lane >> 5;
    const int t0 = 32 * qt, ntile = qt + 1, tlast = ntile - 1;
    const bf16_t* kbase = WSP(bf16_t, WS_SIDE) + (size_t)b * SEQ * LDS_;
    const bf16_t* srow = kbase + (size_t)(t0 + q) * LDS_;
    bf16_t* qrow = WSP(bf16_t, WS_PROJ) + (size_t)(b * SEQ + t0 + q) * LDP;
    const bool sel = (qt >= 8);
    bf16x8 bq[4][4]; float wq[4]; bf16_t wqr[4]; bf16x8 k0[4], k1[4];
    if (sel) {
#pragma unroll
        for (int h = 0; h < 4; ++h) { wqr[h] = srow[O_IW - O_SIDE + h];
#pragma unroll
            for (int kk = 0; kk < 4; ++kk) bq[h][kk] = *(const bf16x8*)(srow + (O_IQ - O_SIDE) + h * 64 + kk * 16 + hf * 8); }
        DSA_PRELOAD();
    }
    {
        const u32x4 z4 = {0u, 0u, 0u, 0u};
        constexpr int NG16 = (2 * 32 * GP * 4) / 16, NH16 = (32 * HPITCH * 4) / 16;
        static_assert((2 * 32 * GP * 4) % 16 == 0 && (32 * HPITCH * 4) % 16 == 0 && GT % 16 == 0 && HIST % 16 == 0, "16-byte zero fill");
#pragma unroll
        for (int k = 0; k < (NG16 + NTHR - 1) / NTHR; ++k) { const int i = k * NTHR + tid; if (i < NG16) *(LAS u32x4*)(L + GT + i * 16) = z4; }
        if (sel) {
#pragma unroll
            for (int k = 0; k < (NH16 + NTHR - 1) / NTHR; ++k) { const int i = k * NTHR + tid; if (i < NH16) *(LAS u32x4*)(L + HIST + i * 16) = z4; } }
    }
    if (tid < 64) qst[tid] = (tid < 32) ? 0u : 256u;
    if (tid < 128) cnt[tid] = (tid >= 32 && tid < 64) ? 0xffffffffu : 0u;
    __syncthreads();
    if (sel) {
#pragma unroll
        for (int h = 0; h < 4; ++h) wq[h] = bf2f(wqr[h]) * 0.0625f;
        u32x4* kc = WSP(u32x4, WS_KC) + (size_t)C.bid * (128 * 64 * 2);
        radix_pass<0>(L, lane, w, q, hf, qt, ntile, kbase, bq, wq, k0, k1, kc);
        radix_pass<1>(L, lane, w, q, hf, qt, ntile, kbase, bq, wq, k0, k1, kc);
        {
            const unsigned p16 = qst[q]; const u32x4* kcl = kc + (WS_KCL - WS_KC) / 16;
            unsigned lmin = 0xffffffffu, lmax = 0u;
#pragma unroll 1
            for (int tb = w; tb < ntile; tb += 4 * NWAVES) {
                u32x4 ha[4], hb[4];
#pragma unroll
                for (int j = 0; j < 4; ++j) { const size_t o_ = (size_t)(min(tb + j * NWAVES, tlast) * 64 + lane) * 2; ha[j] = *(kc + o_); hb[j] = *(kc + o_ + 1); }
#pragma unroll
                for (int j = 0; j < 4; ++j) { const int tile = tb + j * NWAVES;
                    if (tile < ntile) {
                        const unsigned hw[8] = {ha[j].x, ha[j].y, ha[j].z, ha[j].w, hb[j].x, hb[j].y, hb[j].z, hb[j].w};
                        unsigned gw = 0u, ew = 0u;
#pragma unroll
                        for (int r = 0; r < 16; ++r) { const int pos = (r & 3) + 8 * (r >> 2) + 4 * hf;
                            const unsigned hi = (r & 1) ? (hw[r >> 1] >> 16) : (hw[r >> 1] & 0xffffu);
                            gw |= (hi > p16) ? (1u << pos) : 0u; ew |= (hi == p16) ? (1u << pos) : 0u; }
                        unsigned rem = ew;
                        while (__any(rem != 0u)) {
                            if (rem != 0u) { const int pos = __ffs((int)rem) - 1; rem &= rem - 1u; const int r = 4 * ((pos - 4 * hf) >> 3) + (pos & 3);
                                const unsigned low = *(const unsigned short*)((const char*)(kcl + (size_t)(tile * 64 + lane) * 2) + 2 * r);
                                const unsigned slot = __hip_atomic_fetch_add(&cnt[q], 1u, __ATOMIC_RELAXED, __HIP_MEMORY_SCOPE_WORKGROUP);
                                if (slot < (unsigned)LCAP) list[q * LPITCH + slot] = 0x10000000u | (low << 12) | (unsigned)(4095 - (tile * 32 + pos));
                                lmin = min(lmin, low); lmax = max(lmax, low); } }
                        { const auto g2 = __builtin_amdgcn_permlane32_swap(gw, gw, false, false); gw = g2[0] | g2[1]; const auto e2 = __builtin_amdgcn_permlane32_swap(ew, ew, false, false); ew = e2[0] | e2[1]; }
                        if (hf == 0) { gt[q * GP + tile] = gw; eq[q * GP + tile] = ew; } } }
            }
            if (lmin <= lmax) { __hip_atomic_fetch_min(&cnt[32 + q], lmin, __ATOMIC_RELAXED, __HIP_MEMORY_SCOPE_WORKGROUP); __hip_atomic_fetch_max(&cnt[64 + q], lmax, __ATOMIC_RELAXED, __HIP_MEMORY_SCOPE_WORKGROUP); }
        }
        __syncthreads();
        {
            const int g = lane >> 4, li = lane & 15, qq = 4 * w + g; const int need = (int)qst[32 + qq]; const int n = (int)cnt[qq];
            if (n <= LCAP) {
                unsigned c[4]; int rank[4];
#pragma unroll
                for (int k = 0; k < 4; ++k) { const int idx = li + 16 * k; c[k] = (idx < n) ? list[qq * LPITCH + idx] : 0u; rank[k] = 0; }
                for (int j = 0; j < n; j += 4) { const u32x4 e4 = *(const LAS u32x4*)(list + qq * LPITCH + j);
                    const unsigned ev[4] = {e4.x, (j + 1 < n) ? e4.y : 0u, (j + 2 < n) ? e4.z : 0u, (j + 3 < n) ? e4.w : 0u};
#pragma unroll
                    for (int i = 0; i < 4; ++i)
#pragma unroll
                        for (int k = 0; k < 4; ++k) rank[k] += (ev[i] > c[k]) ? 1 : 0; }
#pragma unroll
                for (int k = 0; k < 4; ++k) if (c[k] != 0u && rank[k] < need) { const int sp = 4095 - (int)(c[k] & 4095u);
                    __hip_atomic_fetch_or(&gt[qq * GP + (sp >> 5)], 1u << (sp & 31), __ATOMIC_RELAXED, __HIP_MEMORY_SCOPE_WORKGROUP); }
            } else if (cnt[32 + qq] == cnt[64 + qq]) {
                tie_fixup(gt, eq, qq, li, need);
            } else if (li == 0) cnt[96] = 1u;
        }
        __syncthreads();
        if (cnt[96] != 0u) {
            DSA_PRELOAD();
            radix_pass<2>(L, lane, w, q, hf, qt, ntile, kbase, bq, wq, k0, k1, kc);
            radix_pass<3>(L, lane, w, q, hf, qt, ntile, kbase, bq, wq, k0, k1, kc);
            const unsigned prefix = qst[q];
            for (int tile = w; tile < ntile; tile += NWAVES) {
                bf16x8 ka[4]; DSA_LOADK(ka, tile);
                float sc[16]; idx_scores(ka, bq, wq, sc);
                DSA_DIAG_MASK()
                unsigned gw = 0u, ew = 0u;
#pragma unroll
                for (int r = 0; r < 16; ++r) { const int pos = (r & 3) + 8 * (r >> 2) + 4 * hf; const unsigned key = fkey(sc[r]);
                    gw |= (key > prefix) ? (1u << pos) : 0u; ew |= (key == prefix) ? (1u << pos) : 0u; }
                gw |= __shfl_xor(gw, 32); ew |= __shfl_xor(ew, 32);
                if (hf == 0) { gt[q * GP + tile] = gw; eq[q * GP + tile] = ew; }
            }
            __syncthreads();
            tie_fixup(gt, eq, 4 * w + (lane >> 4), lane & 15, (int)qst[32 + 4 * w + (lane >> 4)]);
        }
    } else {
        for (int tile = w; tile < ntile; tile += NWAVES) { unsigned gw = 0u; const bool diag = (tile == qt);
#pragma unroll
            for (int r = 0; r < 16; ++r) { const int pos = (r & 3) + 8 * (r >> 2) + 4 * hf; if (!diag || (pos <= q)) gw |= 1u << pos; }
            gw |= __shfl_xor(gw, 32);
            if (hf == 0) gt[q * GP + tile] = gw; }
    }
    {
        const int a = w;
        bf16x8 bqa[4];
#pragma unroll
        for (int kk = 0; kk < 4; ++kk) bqa[kk] = *(const bf16x8*)(qrow + O_AQ + a * 64 + kk * 16 + hf * 8);
        f32x16 o0, o1;
#pragma unroll
        for (int r = 0; r < 16; ++r) { o0[r] = 0.f; o1[r] = 0.f; }
        float mrun = 0.f;
        f32x4 lacc = {0.f, 0.f, 0.f, 0.f};
        u32x4 onesw; onesw.x = onesw.y = onesw.z = onesw.w = ((lane & 15) == ((lane >> 4) & 1)) ? 0x3F803F80u : 0u;
        const bf16x8 onesA = __builtin_bit_cast(bf16x8, onesw);
#define DSA_EMASK(c, buf) do { const int mw_ = (int)(gt[q * GP + 4 * (c) + (w >> 1)] >> (4 * hf + 16 * (w & 1))); u32x4 em_; \
            em_.x = __builtin_amdgcn_perm((unsigned)__builtin_amdgcn_sbfe(mw_, 1, 1), (unsigned)__builtin_amdgcn_sbfe(mw_, 0, 1), 0x07060100u); \
            em_.y = __builtin_amdgcn_perm((unsigned)__builtin_amdgcn_sbfe(mw_, 3, 1), (unsigned)__builtin_amdgcn_sbfe(mw_, 2, 1), 0x07060100u); \
            em_.z = __builtin_amdgcn_perm((unsigned)__builtin_amdgcn_sbfe(mw_, 9, 1), (unsigned)__builtin_amdgcn_sbfe(mw_, 8, 1), 0x07060100u); \
            em_.w = __builtin_amdgcn_perm((unsigned)__builtin_amdgcn_sbfe(mw_, 11, 1), (unsigned)__builtin_amdgcn_sbfe(mw_, 10, 1), 0x07060100u); \
            *(LAS u32x4*)(L + EMK + (buf) * EMKB + (w * 64 + lane) * 16) = em_; } while (0)
        const int nch = (ntile + 3) >> 2;
        const int kr0 = tid >> 3, ks0 = tid & 7;
        u32x4 rkA[2], rvA[2], rkB[2], rvB[2];
#define DSA_ISSUE(c, RK, RV) do { _Pragma("unroll") for (int i = 0; i < 2; ++i) { const bf16_t* rp_ = kbase + (size_t)((c) * 128 + kr0 + 64 * i) * LDS_ + ks0 * 8; \
            RK[i] = *(const u32x4*)(rp_ + (O_AK - O_SIDE)); RV[i] = *(const u32x4*)(rp_ + (O_AV - O_SIDE)); } } while (0)
#define DSA_WRITE(buf, RK, RV) do { _Pragma("unroll") for (int i = 0; i < 2; ++i) { \
            *(LAS u32x4*)(L + KST + (buf) * KBUF + (kr0 + 64 * i) * 144 + ks0 * 16) = RK[i]; \
            *(LAS u32x4*)(L + VST + (buf) * KBUF + (kr0 + 64 * i) * 144 + ks0 * 16) = RV[i]; } } while (0)
        const int g16 = lane >> 4, li = lane & 15;
        const int vtoff = (4 * hf + (li >> 2)) * 144 + (16 * (g16 & 1) + 4 * (li & 3)) * 2;
#ifndef ATTN_REPS
#define ATTN_REPS 1
#endif
#pragma unroll 1
        for (int rep = 0; rep < ATTN_REPS; ++rep) {
        if (ATTN_REPS > 1) { mrun = 0.f; lacc[0] = lacc[1] = lacc[2] = lacc[3] = 0.f;
#pragma unroll
            for (int r = 0; r < 16; ++r) { o0[r] = 0.f; o1[r] = 0.f; } }
        DSA_ISSUE(0, rkA, rvA); DSA_ISSUE(min(1, nch - 1), rkB, rvB);
        __syncthreads();
        DSA_WRITE(0, rkA, rvA); DSA_EMASK(0, 0);
        __syncthreads();
        asm volatile("" :: "v"(bqa[0]), "v"(bqa[1]), "v"(bqa[2]), "v"(bqa[3]));
        f32x16 nmv;
#pragma unroll
        for (int r = 0; r < 16; ++r) nmv[r] = -mrun;
#define DSA_KREAD(dst, tt_) do { const LAS unsigned char* kp_ = L + KST + buf * KBUF + (32 * (tt_) + q) * 144 + 16 * hf; \
            _Pragma("unroll") for (int kk = 0; kk < 4; ++kk) dst[kk] = *(const LAS bf16x8*)(kp_ + 32 * kk); } while (0)
#define DSA_STEP(tt, CUR, NXT, KFN, HASN) do { \
            s16x4 vlo[2][2], vhi[2][2]; \
            _Pragma("unroll") for (int ks = 0; ks < 2; ++ks) \
            _Pragma("unroll") for (int dt = 0; dt < 2; ++dt) { const LAS unsigned char* vp = L + VST + buf * KBUF + (32 * (tt) + 16 * ks) * 144 + 64 * dt + vtoff; \
                vlo[ks][dt] = __builtin_amdgcn_ds_read_tr16_b64_v4i16((LAS s16x4*)vp); vhi[ks][dt] = __builtin_amdgcn_ds_read_tr16_b64_v4i16((LAS s16x4*)(vp + 8 * 144)); } \
            u32x4 em[2]; \
            _Pragma("unroll") for (int ks = 0; ks < 2; ++ks) em[ks] = *(const LAS u32x4*)(L + EMK + buf * EMKB + ((2 * (tt) + ks) * 64 + lane) * 16); \
            float mx = CUR[0]; \
            _Pragma("unroll") for (int r = 1; r < 16; ++r) mx = fmaxf(mx, CUR[r]); \
            { const auto rr = __builtin_amdgcn_permlane32_swap(__float_as_uint(mx), __float_as_uint(mx), false, false); mx = fmaxf(__uint_as_float(rr[0]), __uint_as_float(rr[1])); } \
            const bool first = (c == 0) && ((tt) == 0); \
            if (first || __any(mx > 8.0f)) {              \
                const float d = first ? mx : fmaxf(mx, 0.f), alpha = first ? 1.0f : __builtin_amdgcn_exp2f(-d); mrun += d; \
                lacc[0] *= __shfl(alpha, lane & 15); lacc[1] *= __shfl(alpha, (lane & 15) + 16); \
                _Pragma("unroll") for (int r = 0; r < 16; ++r) { o0[r] *= alpha; o1[r] *= alpha; CUR[r] -= d; nmv[r] = -mrun; } } \
            __builtin_amdgcn_sched_barrier(0); \
            float p[16]; \
            _Pragma("unroll") for (int g = 0; g < 4; ++g) { \
                if (HASN) NXT = mfma32(KFN[g], bqa[g], (g == 0) ? nmv : NXT); \
                _Pragma("unroll") for (int r = 4 * g; r < 4 * g + 4; ++r) p[r] = __builtin_amdgcn_exp2f(CUR[r]); \
                __builtin_amdgcn_sched_barrier(0); } \
            _Pragma("unroll") for (int ks = 0; ks < 2; ++ks) { \
                u32x4 pw; pw.x = pk2(p[8 * ks], p[8 * ks + 1]) & em[ks].x; pw.y = pk2(p[8 * ks + 2], p[8 * ks + 3]) & em[ks].y; pw.z = pk2(p[8 * ks + 4], p[8 * ks + 5]) & em[ks].z; pw.w = pk2(p[8 * ks + 6], p[8 * ks + 7]) & em[ks].w; \
                const bf16x8 pb = __builtin_bit_cast(bf16x8, pw); \
                o0 = mfma32(__builtin_shufflevector(vlo[ks][0], vhi[ks][0], 0, 1, 2, 3, 4, 5, 6, 7), pb, o0); \
                o1 = mfma32(__builtin_shufflevector(vlo[ks][1], vhi[ks][1], 0, 1, 2, 3, 4, 5, 6, 7), pb, o1); \
                lacc = __builtin_amdgcn_mfma_f32_16x16x32_bf16(onesA, pb, lacc, 0, 0, 0); } \
        } while (0)
#define DSA_CHUNK(RKY, RVY, RKX, RVX) do { \
            const int buf = c & 1; \
            DSA_ISSUE(min(c + 2, nch - 1), RKY, RVY);         \
            bf16x8 kfa[4], kfb[4]; f32x16 sA, sB; \
            DSA_KREAD(kfa, 0); DSA_KREAD(kfb, 1); __builtin_amdgcn_sched_barrier(0); \
            _Pragma("unroll") for (int kk = 0; kk < 4; ++kk) sA = mfma32(kfa[kk], bqa[kk], (kk == 0) ? nmv : sA); \
            DSA_KREAD(kfa, 2); __builtin_amdgcn_sched_barrier(0); \
            DSA_STEP(0, sA, sB, kfb, true); \
            DSA_KREAD(kfb, 3); __builtin_amdgcn_sched_barrier(0); \
            DSA_STEP(1, sB, sA, kfa, true); \
            DSA_STEP(2, sA, sB, kfb, true); \
            DSA_STEP(3, sB, sA, kfa, false); \
            if (c + 1 < nch) { DSA_WRITE(buf ^ 1, RKX, RVX); DSA_EMASK(c + 1, buf ^ 1); } \
            __syncthreads(); } while (0)
#pragma unroll 1
        for (int c = 0; c < nch; ++c) {
            DSA_CHUNK(rkA, rvA, rkB, rvB);
            if (++c >= nch) break;
            DSA_CHUNK(rkB, rvB, rkA, rvA);
        }
        }
#undef DSA_CHUNK
#undef DSA_EMASK
#undef DSA_STEP
#undef DSA_KREAD
        const float l0 = __shfl(lacc[0], lane & 15), l1 = __shfl(lacc[1], lane & 15);
        const float lt = (lane & 16) ? l1 : l0, inv = 1.0f / lt;
#pragma unroll
        for (int g = 0; g < 4; ++g) {
            u32x2 w0, w1; w0.x = pk2(o0[4 * g] * inv, o0[4 * g + 1] * inv); w0.y = pk2(o0[4 * g + 2] * inv, o0[4 * g + 3] * inv);
            w1.x = pk2(o1[4 * g] * inv, o1[4 * g + 1] * inv); w1.y = pk2(o1[4 * g + 2] * inv, o1[4 * g + 3] * inv);
            if (!dry) { *(u32x2*)(qrow + O_AQ + a * 64 + 8 * g + 4 * hf) = w0; *(u32x2*)(qrow + O_AQ + a * 64 + 32 + 8 * g + 4 * hf) = w1; } }
    }
    __syncthreads();
}
}

#ifdef NO_ML
#define ML_CALL(x)
#else
#define ML_CALL(x) x
#endif
#ifdef NO_DSA
#define DSA_CALL(x)
#else
#define DSA_CALL(x) x
#endif
#if defined(NO_GEMM)
#define GEMM_CALL(k, x)
#elif defined(ONLY_GEMM)
#define GEMM_CALL(k, x) do { if ((k) == ONLY_GEMM) { x; } } while (0)
#else
#define GEMM_CALL(k, x) x
#endif
#ifndef PROBE_MIX
#define PROBE_MIX 0
#endif
constexpr int PH_PER_LAYER = 20, N_PHASES = DEPTH * PH_PER_LAYER + 1;
__global__ void __launch_bounds__(NTHR, 2) mk_fwd(Args Aval) {
    extern __shared__ __attribute__((aligned(16))) unsigned char lds_raw[];
    Ctx C;
    C.lds = (LAS unsigned char*)lds_raw;
    C.G = gridDim.x; C.bid = blockIdx.x;
    volatile LAS unsigned* MISC = (volatile LAS unsigned*)(C.lds + MISC_OFF);
    for (int u = threadIdx.x; u < (LDS_BYTES - LDSCTL_OFF) / 4; u += NTHR) ((LAS unsigned*)(C.lds + LDSCTL_OFF))[u] = 0u;
    __syncthreads();
    unsigned* barw = (unsigned*)(Aval.ws + WS_CTL) + CW_BAR;
    XcdBarrier bar; bar.bar = barw; bar.x = 0; bar.st = nullptr;
    const int lo = Aval.ph_lo, hi = Aval.ph_hi;
    if ((hi - lo) > 1) bar = xcd_barrier_post(barw, MISC + 8);
#define IN(k) (lo <= (k) && (k) < hi)
#define SEAM(k) do { if (IN((k) + 1)) xcd_barrier(bar); } while (0)
#pragma unroll 1
    for (int l = 0; l < DEPTH; ++l) {
        const int P0 = l * PH_PER_LAYER;
        if (IN(P0 + 0)) { phase_convert(C, l); phase_pb(C, l); if (l == 0) phase_init_rows(C); SEAM(P0 + 0); }
        if (IN(P0 + 1)) {
            ArgsP A = args_ptr(); bf16_t* const W = WSP(bf16_t, WS_W); pg8::Gemm g{WSP(bf16_t, WS_XB), W + W_GU1, DM, MTOK, 2 * DFF, DM}; pg8::StaticOrder S; S.init(MTOK, 2 * DFF, C.G, C.bid);
            pg8::EpiSwiglu E{WSP(bf16_t, WS_HID), WSP(float, WS_SS0)}; GEMM_CALL(0, pg8::gemm_phase(C.lds, g, S, E)); SEAM(P0 + 1); }
        if (IN(P0 + 2)) {
            ArgsP A = args_ptr(); bf16_t* const W = WSP(bf16_t, WS_W); pg8::Gemm g{WSP(bf16_t, WS_HID), W + W_DN1, DFF, MTOK, DM, DFF}; pg8::StaticOrder S; S.init(MTOK, DM, C.G, C.bid);
            pg8::EpiResid E{(l == 0) ? A->in[0] : A->out, A->out, WSP(bf16_t, WS_XB), 0.5f, WSP(float, WS_SS1), (LAS float*)(C.lds + LDS_SSQ)}; GEMM_CALL(1, pg8::gemm_phase(C.lds, g, S, E)); SEAM(P0 + 2); }
#pragma unroll 1
        for (int gi = 0; gi < NGRP; ++gi) {
            const int PG = P0 + 4 + 5 * gi; const size_t r0 = (size_t)gi * MG;
            if (IN(PG + 0)) {
                ArgsP A = args_ptr(); bf16_t* const W = WSP(bf16_t, WS_W); pg8::Gemm g{WSP(bf16_t, WS_XB) + r0 * DM, W + W_IN, DM, MG, LDP, DM}; pg8::StaticOrder S; S.init(MG, LDP, C.G, C.bid);
                pg8::EpiProj E{WSP(bf16_t, WS_PROJ), WSP(float, WS_SS1) + r0 * 4, WSP(bf16_t, WS_SIDE)}; GEMM_CALL(2, pg8::gemm_phase(C.lds, g, S, E)); SEAM(PG + 0); }
            if (IN(PG + 1)) {
                constexpr int NMLB = 16, NDSAB = 128, NCVB = 32, NITEMB = NMLB + NDSAB + NCVB;
                unsigned* qbase = (unsigned*)(Aval.ws + WS_CTL) + CW_Q + 64 * (8 * (2 * l + gi));
                const int xq = (int)(xb_xcc_id() & 7u);
                for (int hop = 0; hop < GB; ++hop) {
                    const int bq_ = (xq + hop) & (GB - 1);
                    unsigned* qhead = qbase + 64 * bq_;
                    for (;;) {
                        __syncthreads();
                        if (threadIdx.x == 0) MISC[16] = __hip_atomic_fetch_add(qhead, 1u, __ATOMIC_RELAXED, __HIP_MEMORY_SCOPE_AGENT);
                        __syncthreads();
                        const int item = (int)MISC[16];
                        if (item >= NITEMB) break;
                        if (item < NMLB) { ML_CALL(ml::unit(C, l, bq_ * 16 + item, 0)); }
                        else if (item < NMLB + NDSAB) { DSA_CALL(dsa::unit(C, bq_, 127 - (item - NMLB), 0)); }
                        else prep_conv(C, l, bq_, item - NMLB - NDSAB, NCVB, 0);
                    }
                }
                SEAM(PG + 1); }
            if (IN(PG + 2)) { prep_gate(C, l, C.bid, C.G); SEAM(PG + 2); }
            if (IN(PG + 3)) {
                ArgsP A = args_ptr(); bf16_t* const W = WSP(bf16_t, WS_W); bf16_t* PROJ = WSP(bf16_t, WS_PROJ);
                pg8::Gemm g{PROJ + O_CB, W + W_MRG, LDP, MG, DM, 2 * DM}; pg8::StaticOrder S; S.init(MG, DM, C.G, C.bid);
                pg8::EpiMerge E{WSP(bf16_t, WS_GCAT), PROJ + O_G + 2 * DM}; pg8::MergeHook H{PROJ + O_G};
                GEMM_CALL(3, (pg8::gemm_phase<pg8::EpiMerge, pg8::MergeHook>(C.lds, g, S, E, H)));
                SEAM(PG + 3); }
            if (IN(PG + 4)) {
                ArgsP A = args_ptr(); bf16_t* const W = WSP(bf16_t, WS_W); pg8::Gemm g{WSP(bf16_t, WS_GCAT), W + W_O, DM, MG, DM, DM}; pg8::StaticOrder S; S.init(MG, DM, C.G, C.bid);
                pg8::EpiResid E{A->out + r0 * DM, A->out + r0 * DM, WSP(bf16_t, WS_XB) + r0 * DM, 1.0f, WSP(float, WS_SS0) + r0 * 4, (LAS float*)(C.lds + LDS_SSQ)}; GEMM_CALL(6, pg8::gemm_phase(C.lds, g, S, E));
                if (gi == NGRP - 1) SEAM(PG + 4); }
        }
        if (IN(P0 + 15)) {
            ArgsP A = args_ptr(); bf16_t* const W = WSP(bf16_t, WS_W); pg8::Gemm g{WSP(bf16_t, WS_XB), W + W_GU2, DM, MTOK, 2 * DFF, DM}; pg8::StaticOrder S; S.init(MTOK, 2 * DFF, C.G, C.bid);
            pg8::EpiSwiglu E{WSP(bf16_t, WS_HID), WSP(float, WS_SS0)}; GEMM_CALL(7, pg8::gemm_phase(C.lds, g, S, E)); SEAM(P0 + 15); }
        if (IN(P0 + 16)) {
            ArgsP A = args_ptr(); bf16_t* const W = WSP(bf16_t, WS_W); pg8::Gemm g{WSP(bf16_t, WS_HID), W + W_DN2, DFF, MTOK, DM, DFF}; pg8::StaticOrder S; S.init(MTOK, DM, C.G, C.bid);
            pg8::EpiResid E{A->out, A->out, WSP(bf16_t, WS_XB), 0.5f, WSP(float, WS_SS1), (LAS float*)(C.lds + LDS_SSQ)}; GEMM_CALL(8, pg8::gemm_phase(C.lds, g, S, E)); SEAM(P0 + 16); }
        if (IN(P0 + 18)) {
            ArgsP A = args_ptr(); bf16_t* const W = WSP(bf16_t, WS_W); pg8::Gemm g{WSP(bf16_t, WS_PB), W + W_PP, DPLE, MTOK, DM, DPLE}; pg8::StaticOrder S; S.init(MTOK, DM, C.G, C.bid);
            pg8::EpiBf16 E{WSP(bf16_t, WS_PP), DM, nullptr}; GEMM_CALL(9, pg8::gemm_phase(C.lds, g, S, E)); __syncthreads(); }
        if (IN(P0 + 19)) {
            ArgsP A = args_ptr(); bf16_t* const W = WSP(bf16_t, WS_W); pg8::Gemm g{WSP(bf16_t, WS_XB), W + W_PG, DM, MTOK, DM, DM}; pg8::StaticOrder S; S.init(MTOK, DM, C.G, C.bid);
            pg8::EpiPle E{A->out, WSP(bf16_t, WS_XB), WSP(bf16_t, WS_PP), WSP(float, WS_SS1), WSP(float, WS_SS0), (LAS float*)(C.lds + LDS_SSQ), (l + 1 < DEPTH) ? 1 : 0}; GEMM_CALL(10, pg8::gemm_phase(C.lds, g, S, E)); SEAM(P0 + 19); }
    }
    if (IN(N_PHASES - 1)) phase_final(C);
#undef IN
#undef SEAM
}

extern "C" void kernel_launch(void* const* d_in, const int* in_sizes, int n_in, void* d_out, int out_size, void* d_ws, size_t ws_size, hipStream_t stream) {
    static int grid = 0;
    if (grid == 0) {
        if (n_in != 22 || out_size != MTOK * DM || ws_size < WS_END) { fprintf(stderr, "kernel_launch: unexpected shapes (n_in %d out %d ws %zu, need %zu)\n", n_in, out_size, ws_size, (size_t)WS_END); grid = -1; return; }
        int dev = 0, cus = 0, per_cu = 0;
        if (hipGetDevice(&dev) != hipSuccess || hipDeviceGetAttribute(&cus, hipDeviceAttributeMultiprocessorCount, dev) != hipSuccess) { grid = -1; return; }
        if (hipFuncSetAttribute((const void*)mk_fwd, hipFuncAttributeMaxDynamicSharedMemorySize, LDS_BYTES) != hipSuccess) { fprintf(stderr, "kernel_launch: hipFuncSetAttribute failed\n"); grid = -1; return; }
        if (hipOccupancyMaxActiveBlocksPerMultiprocessor(&per_cu, (const void*)mk_fwd, NTHR, LDS_BYTES) != hipSuccess || per_cu < 1) { fprintf(stderr, "kernel_launch: occupancy query says %d\n", per_cu); (void)hipGetLastError(); grid = -1; return; }
        grid = cus;
    }
    if (grid < 0) return;
    if (hipMemsetAsync((char*)d_ws + WS_CTL, 0, CTL_ZERO_BYTES, stream) != hipSuccess) return;
    Args a{};
    for (int i = 0; i < 22; ++i) a.in[i] = (const float*)d_in[i];
    a.out = (float*)d_out; a.ws = (unsigned char*)d_ws;
#if MK_N_LAUNCHES == 1
    a.ph_lo = 0; a.ph_hi = N_PHASES;
    hipLaunchKernelGGL(mk_fwd, dim3(grid), dim3(NTHR), LDS_BYTES, stream, a);
#else
    for (int p = 0; p < N_PHASES; ++p) { a.ph_lo = p; a.ph_hi = p + 1; hipLaunchKernelGGL(mk_fwd, dim3(grid), dim3(NTHR), LDS_BYTES, stream, a); }
#endif
}
```
